# Optimizing an MI355X kernel written in HIP

```python
import math
import jax, jax.numpy as jnp
from jax import lax
import numpy as np

D_MODEL = 1024
BATCH = 4
SEQ = 4096
DEPTH = 1
DEC_BATCH = 128
DEC_SEQ = 8
PAST_LEN = 2048
PAGE_SIZE = 128

HEAD_DIM = 64
SB_HEADS = 8
SB_WIDTH = SB_HEADS * HEAD_DIM
RW_HEADS = 8
RW_WIDTH = RW_HEADS * HEAD_DIM
D_MIX = SB_WIDTH + RW_WIDTH
LORA_W = 64
LORA_A = 64
SB_COLS = 4 * SB_WIDTH
RW_COLS = 4 * RW_WIDTH + LORA_W + LORA_A
IN_COLS = SB_COLS + RW_COLS
Q_BLOCK = 128
RMS_EPS = 1e-6
GN_EPS = 64e-5
DECAY_OFFSET = 0.5
L2_EPS = 1e-12
SB_BIAS_INIT = -8.0

kernel_name = 'hymba_stickbreak_rwkv7_step'


def _rmsnorm(x, g):
    xf = x.astype(jnp.float32)
    y = xf * lax.rsqrt(jnp.mean(xf * xf, axis=-1, keepdims=True) + RMS_EPS)
    return (y * g.astype(jnp.float32)).astype(x.dtype)


def _project(h, norm_in, w_in):
    B, T, _ = h.shape
    p = _rmsnorm(h, norm_in) @ w_in
    q, k, v, g = jnp.split(p[..., :SB_COLS], 4, axis=-1)
    hd = lambda t: t.reshape(B, T, SB_HEADS, HEAD_DIM)
    return hd(q), hd(k), hd(v), g, p[..., SB_COLS:]


def _sb_attend(q, k, v, q_pos, k_pos, sb_bias):
    z = jnp.einsum('bqhd,bkhd->bhqk', q.astype(jnp.float32), k.astype(jnp.float32)) * (HEAD_DIM ** -0.5)
    z = z + sb_bias.astype(jnp.float32)[None, :, None, None]
    mask = (k_pos[None, :] < q_pos[:, None])[None, None]
    log_keep = jnp.where(mask, jax.nn.log_sigmoid(-z), 0.0)
    between = lax.cumsum(log_keep, axis=3, reverse=True) - log_keep
    a = jnp.where(mask, jnp.exp(jax.nn.log_sigmoid(z) + between), 0.0)
    return jnp.einsum('bhqk,bkhd->bqhd', a, v.astype(jnp.float32)).astype(q.dtype)


def _wkv_scan(r, w, k, v, a, b, s0):
    def step(S, inp):
        r_t, w_t, k_t, v_t, a_t, b_t = inp
        sa = jnp.einsum('bhvk,bhk->bhv', S, a_t)
        S = S * w_t[:, :, None, :] + sa[..., None] * b_t[:, :, None, :] + v_t[..., None] * k_t[:, :, None, :]
        return S, jnp.einsum('bhvk,bhk->bhv', S, r_t)
    xs = tuple(jnp.swapaxes(t.astype(jnp.float32), 0, 1) for t in (r, w, k, v, a, b))
    s_last, ys = lax.scan(step, s0.astype(jnp.float32), xs)
    return jnp.swapaxes(ys, 0, 1), s_last


def _rwkv_branch(p, prev, s0, mu, w0, w_up, a0, a_up, k_k, k_a, r_k, ln_w, ln_b):
    B, T, _ = p.shape
    shifted = jnp.concatenate([prev[:, None, :].astype(p.dtype), p[:, :-1]], axis=1)
    zc = p + (shifted - p) * mu
    r, k, v, g, wd, ad = jnp.split(zc, [RW_WIDTH, 2 * RW_WIDTH, 3 * RW_WIDTH, 4 * RW_WIDTH, 4 * RW_WIDTH + LORA_W], axis=-1)
    w_log = -jax.nn.softplus(-(w0 + jnp.tanh(wd) @ w_up)) - DECAY_OFFSET
    decay = jnp.exp(-jnp.exp(w_log.astype(jnp.float32)))
    alr = jax.nn.sigmoid((a0 + ad @ a_up).astype(jnp.float32))
    hd = lambda t: t.astype(jnp.float32).reshape(B, T, RW_HEADS, HEAD_DIM)
    kk = hd(k * k_k)
    kk = kk / jnp.maximum(jnp.sqrt(jnp.sum(kk * kk, axis=-1, keepdims=True)), L2_EPS)
    k_eff = k.astype(jnp.float32) * (1.0 + (alr - 1.0) * k_a.astype(jnp.float32))
    rh, kh, vh, ah = hd(r), hd(k_eff), hd(v), hd(alr)
    y, s_last = _wkv_scan(rh, hd(decay), kh, vh, -kk, kk * ah, s0)
    mean = jnp.mean(y, axis=-1, keepdims=True)
    var = jnp.mean(jnp.square(y - mean), axis=-1, keepdims=True)
    yn = ((y - mean) * lax.rsqrt(var + GN_EPS)).reshape(B, T, RW_WIDTH) * ln_w.astype(jnp.float32) + ln_b.astype(jnp.float32)
    bonus = (jnp.sum(rh * kh * r_k.astype(jnp.float32), axis=-1, keepdims=True) * vh).reshape(B, T, RW_WIDTH)
    out = (yn + bonus) * jax.nn.silu(g.astype(jnp.float32))
    return out.astype(p.dtype), s_last, p[:, -1]


def _layer(h_p, h_s, cache_k, cache_v, page_table, s_wkv, s_shift,
           norm_in, w_in, sb_bias, mu, w0, w_up, a0, a_up, k_k, k_a, r_k, ln_w, ln_b, w_out):
    rw = (mu, w0, w_up, a0, a_up, k_k, k_a, r_k, ln_w, ln_b)
    B, S, _ = h_p.shape
    q, k, v, g, p_rw = _project(h_p, norm_in, w_in)
    nb = S // Q_BLOCK
    pos = jnp.arange(S)
    q_blocks = jnp.swapaxes(q.reshape(B, nb, Q_BLOCK, SB_HEADS, HEAD_DIM), 0, 1)
    o = lax.map(lambda qp: _sb_attend(qp[0], k, v, qp[1], pos, sb_bias), (q_blocks, pos.reshape(nb, Q_BLOCK)))
    o_sb = jnp.swapaxes(o, 0, 1).reshape(B, S, SB_WIDTH) * jax.nn.silu(g)
    o_rw, wkv_p, shift_p = _rwkv_branch(
        p_rw, jnp.zeros((B, RW_COLS), p_rw.dtype),
        jnp.zeros((B, RW_HEADS, HEAD_DIM, HEAD_DIM), jnp.float32), *rw)
    h_p = h_p + jnp.concatenate([o_sb, o_rw], axis=-1) @ w_out
    Bd, T, _ = h_s.shape
    past = page_table.shape[1] * cache_k.shape[1]
    qs, ks, vs, gs, ps_rw = _project(h_s, norm_in, w_in)
    k_past = cache_k[page_table].reshape(Bd, past, SB_HEADS, HEAD_DIM).astype(ks.dtype)
    v_past = cache_v[page_table].reshape(Bd, past, SB_HEADS, HEAD_DIM).astype(vs.dtype)
    k_all = jnp.concatenate([k_past, ks], axis=1)
    v_all = jnp.concatenate([v_past, vs], axis=1)
    os_ = _sb_attend(qs, k_all, v_all, past + jnp.arange(T), jnp.arange(past + T), sb_bias)
    os_sb = os_.reshape(Bd, T, SB_WIDTH) * jax.nn.silu(gs)
    os_rw, wkv_s, shift_s = _rwkv_branch(ps_rw, s_shift, s_wkv, *rw)
    h_s = h_s + jnp.concatenate([os_sb, os_rw], axis=-1) @ w_out
    return (h_p, h_s, k, v, wkv_p.astype(s_wkv.dtype), shift_p.astype(s_shift.dtype),
            ks, vs, wkv_s.astype(s_wkv.dtype), shift_s.astype(s_shift.dtype))


def setup_inputs(seed: int = 0) -> dict:
    key = jax.random.key(seed)
    ks = jax.random.split(key, 24)
    f32 = jnp.float32
    n_pages = PAST_LEN // PAGE_SIZE
    n_used = DEC_BATCH * n_pages
    n_phys = n_used + max(1, n_used // 4)
    nrm = lambda i, shape, s: jax.random.normal(ks[i], shape, f32) * s
    page_table = jax.random.permutation(ks[5], n_phys)[:n_used].reshape(DEC_BATCH, n_pages).astype(jnp.int32)
    return {
        'x_prompt': nrm(0, (BATCH, SEQ, D_MODEL), 1.0),
        'x_sample': nrm(1, (DEC_BATCH, DEC_SEQ, D_MODEL), 1.0),
        'cache_k': nrm(2, (DEPTH, n_phys, PAGE_SIZE, SB_HEADS, HEAD_DIM), 1.0),
        'cache_v': nrm(3, (DEPTH, n_phys, PAGE_SIZE, SB_HEADS, HEAD_DIM), 1.0),
        'page_table': page_table,
        'state_wkv': nrm(4, (DEPTH, DEC_BATCH, RW_HEADS, HEAD_DIM, HEAD_DIM), 0.1),
        'state_shift': nrm(6, (DEPTH, DEC_BATCH, RW_COLS), 1.0),
        'norm_in': 1.0 + nrm(7, (DEPTH, D_MODEL), 0.02),
        'w_in': nrm(8, (DEPTH, D_MODEL, IN_COLS), D_MODEL ** -0.5),
        'sb_bias': SB_BIAS_INIT + nrm(21, (DEPTH, SB_HEADS), 0.1),
        'tshift_mu': jax.random.uniform(ks[9], (DEPTH, RW_COLS), f32),
        'w0': nrm(10, (DEPTH, RW_WIDTH), 0.5),
        'w_up': nrm(11, (DEPTH, LORA_W, RW_WIDTH), LORA_W ** -0.5),
        'a0': nrm(12, (DEPTH, RW_WIDTH), 0.5),
        'a_up': nrm(13, (DEPTH, LORA_A, RW_WIDTH), LORA_A ** -0.5),
        'k_k': 0.85 + nrm(14, (DEPTH, RW_WIDTH), 0.05),
        'k_a': 1.0 + nrm(15, (DEPTH, RW_WIDTH), 0.05),
        'r_k': nrm(16, (DEPTH, RW_HEADS, HEAD_DIM), 0.1),
        'ln_w': 1.0 + nrm(17, (DEPTH, RW_WIDTH), 0.02),
        'ln_b': nrm(18, (DEPTH, RW_WIDTH), 0.02),
        'w_out': nrm(19, (DEPTH, D_MIX, D_MODEL), D_MIX ** -0.5),
        'norm_f': 1.0 + nrm(20, (D_MODEL,), 0.02),
    }


def reference(x_prompt, x_sample, cache_k, cache_v, page_table, state_wkv, state_shift,
              norm_in, w_in, sb_bias, tshift_mu, w0, w_up, a0, a_up, k_k, k_a, r_k, ln_w, ln_b, w_out, norm_f):
    h_p, h_s = x_prompt, x_sample
    kp, vp, wp, sp, kd, vd, wd, sd = [], [], [], [], [], [], [], []
    for l in range(DEPTH):
        out = _layer(h_p, h_s, cache_k[l], cache_v[l], page_table, state_wkv[l], state_shift[l],
                     norm_in[l], w_in[l], sb_bias[l], tshift_mu[l], w0[l], w_up[l], a0[l], a_up[l],
                     k_k[l], k_a[l], r_k[l], ln_w[l], ln_b[l], w_out[l])
        h_p, h_s = out[0], out[1]
        for lst, t in zip((kp, vp, wp, sp, kd, vd, wd, sd), out[2:]):
            lst.append(t)
    y_prompt = _rmsnorm(h_p, norm_f)
    y_sample = _rmsnorm(h_s, norm_f)
    return (y_prompt, y_sample, jnp.stack(kp), jnp.stack(vp), jnp.stack(wp), jnp.stack(sp),
            jnp.stack(kd), jnp.stack(vd), jnp.stack(wd), jnp.stack(sd))
```

```cpp
#include <hip/hip_runtime.h>
#include <stdint.h>
#include <stdio.h>
namespace pg8 {
#define PG8_LAS __attribute__((address_space(3)))
typedef unsigned short bf16_t;
typedef short bf16x8 __attribute__((ext_vector_type(8)));
typedef float f32x4 __attribute__((ext_vector_type(4)));
typedef unsigned u32x4 __attribute__((ext_vector_type(4)));
constexpr int BM = 256, BK = 64, HALF = 128, HTB = HALF * BK * 2  , STAGE_BYTES = 8 * HTB, NXCD = 8, WGM = 8;

__host__ __device__ __forceinline__ int lds_byte(int r, int c) { const int st = (r >> 4) * 2 + (c >> 5), rr = r & 15, cc = c & 31, ob = rr * 64 + cc * 2; return st * 1024 + (ob ^ (((ob >> 9) & 1) << 5)); }
__host__ __device__ __forceinline__ void stage_rc(int b, int& R, int& C) { const int st = b / 1024, sb = b % 1024, swz = sb ^ (((sb >> 9) & 1) << 5); R = (st >> 1) * 16 + swz / 64; C = (st & 1) * 32 + (swz % 64) / 2; }
__host__ __device__ __forceinline__ int perm32(int rho) { const int n = rho >> 4, i = rho & 15; return 8 * (i >> 2) + 4 * n + (i & 3); }

struct Unit { int pm, pn; };
struct Gemm { const bf16_t* A; const bf16_t* Bt; int M, N, K; };

struct StaticOrder {
    int nM, nN, nwg, G, c;
    __host__ __device__ void init(int M, int N, int G_, int c_) { nM = M / BM; nN = N / BM; nwg = nM * nN; G = G_; c = c_; }
    __host__ __device__ bool next(int i, Unit& u) const {
        const long L = (long)i * G + c; if (L >= nwg) return false;
        int wgid = (int)L; { const int q = nwg / NXCD, r = nwg % NXCD, xcd = wgid % NXCD, off = wgid / NXCD; wgid = (xcd < r ? xcd * (q + 1) : r * (q + 1) + (xcd - r) * q) + off; }
        const int nig = WGM * nN, gid = wgid / nig, fm = gid * WGM, gsz = (nM - fm) < WGM ? (nM - fm) : WGM;
        u.pm = fm + ((wgid % nig) % gsz); u.pn = (wgid % nig) / gsz; return true;
    }
    __device__ __forceinline__ void a_ready(const Unit&) const {}
    __device__ __forceinline__ void done(const Unit&) const {}
};
struct CountedOrder : StaticOrder {
    const unsigned* ready; unsigned need; unsigned* tmo;
    __device__ __forceinline__ void a_ready(const Unit& u) const {
        if (threadIdx.x < 64) {
            const unsigned long long t0 = __builtin_amdgcn_s_memrealtime(); unsigned polls = 0;
            while ((unsigned)__builtin_amdgcn_readfirstlane(__hip_atomic_load(ready + 64 * u.pm, __ATOMIC_RELAXED, __HIP_MEMORY_SCOPE_AGENT)) < need) {
                if ((++polls & 255u) == 0u && __builtin_amdgcn_readfirstlane(__hip_atomic_load(tmo, __ATOMIC_RELAXED, __HIP_MEMORY_SCOPE_AGENT)) != 0u) break;
                if (__builtin_amdgcn_s_memrealtime() - t0 > 2000000ull) {
                    if (threadIdx.x == 0) { unsigned expect = 0u; __hip_atomic_compare_exchange_strong(tmo + 1, &expect, 0x600u | (unsigned)(u.pm & 0xff), __ATOMIC_RELAXED, __ATOMIC_RELAXED, __HIP_MEMORY_SCOPE_AGENT); __hip_atomic_store(tmo, 1u, __ATOMIC_RELAXED, __HIP_MEMORY_SCOPE_AGENT); }
                    break; }
                __builtin_amdgcn_s_sleep(2); }
            __builtin_amdgcn_fence(__ATOMIC_ACQUIRE, "agent");
            asm volatile("s_waitcnt vmcnt(0)" ::: "memory");
        }
#if !defined(BROKEN_HOOK_NO_BARRIER)
        asm volatile("" ::: "memory"); __builtin_amdgcn_s_barrier(); asm volatile("" ::: "memory");
#endif
    }
};

__device__ __forceinline__ unsigned cvt_pk_bf16(float lo, float hi) { unsigned r; asm volatile("v_cvt_pk_bf16_f32 %0, %1, %2" : "=v"(r) : "v"(lo), "v"(hi)); return r; }
typedef float f32x2 __attribute__((ext_vector_type(2)));
__device__ __forceinline__ f32x2 gelu_pk(f32x2 v) {
    const f32x2 av = __builtin_elementwise_abs(v), d = av * 0.2316418882f + 1.0f;
    f32x2 t; t.x = __builtin_amdgcn_rcpf(d.x); t.y = __builtin_amdgcn_rcpf(d.y);
    f32x2 q = t * 0.5307027145f + (-0.7265760135f); q = q * t + 0.7107068705f; q = q * t + (-0.142248368f); q = q * t + 0.127414796f; q = q * t;
    const f32x2 s = (v * v) * (-0.72134752044f);
    f32x2 e; e.x = __builtin_amdgcn_exp2f(s.x); e.y = __builtin_amdgcn_exp2f(s.y);
    const f32x2 m = v * (q * e), r = v - m;
    f32x2 o; o.x = v.x < 0.f ? m.x : r.x; o.y = v.y < 0.f ? m.y : r.y; return o;
}

struct EpiF32 {
    static constexpr bool PERM = false, AFTER_DRAIN = false;
    float* C; int ldc; const float* bias;
    __device__ __forceinline__ void operator()(const f32x4 (&acc)[2][2][4][2], const Unit& u, int wr, int wc, int fr, int fq) const {
        const int row0 = u.pm * BM + wr * 64 + fr, col0 = u.pn * BM + wc * 32 + 4 * fq;
        f32x4 bv[2][2];
#pragma unroll
        for (int bj = 0; bj < 2; ++bj)
#pragma unroll
            for (int n = 0; n < 2; ++n) bv[bj][n] = bias ? *(const f32x4*)(bias + col0 + bj * HALF + n * 16) : (f32x4){0.f, 0.f, 0.f, 0.f};
#pragma unroll
        for (int ai = 0; ai < 2; ++ai)
#pragma unroll
            for (int m = 0; m < 4; ++m) { float* rowp = C + (size_t)(row0 + ai * HALF + m * 16) * ldc + col0;
#pragma unroll
                for (int bj = 0; bj < 2; ++bj)
#pragma unroll
                    for (int n = 0; n < 2; ++n) *(f32x4*)(rowp + bj * HALF + n * 16) = acc[ai][bj][m][n] + bv[bj][n]; }
    }
};
template <class Epi, class Sched, bool STAMP = false>
__device__ __forceinline__ void gemm_phase(PG8_LAS unsigned char* lds, const Gemm g, const Sched& S, const Epi& E, unsigned long long* stamps) {
    const int tid = threadIdx.x, wid = __builtin_amdgcn_readfirstlane(tid >> 6), lane = tid & 63, wr = wid >> 2, wc = wid & 3, fr = lane & 15, fq = lane >> 4;
    const int K = g.K, nt = K / BK;
    int ts_lo = 0, ts_hi = 0, nts = 0; const unsigned long long rt_entry = STAMP ? (unsigned long long)wall_clock64() : 0ull;
#define PG8_STAMP() do { if (STAMP && wid == 0 && nts < 64) { const unsigned long long _c = (unsigned long long)clock64(); \
        ts_lo = (lane == nts) ? (int)(unsigned)_c : ts_lo; ts_hi = (lane == nts) ? (int)(unsigned)(_c >> 32) : ts_hi; ++nts; } } while (0)
    PG8_STAMP();
    unsigned voffA[2], voffB[2];
#pragma unroll
    for (int i = 0; i < 2; ++i) { int R, C; stage_rc(tid * 16 + i * 8192, R, C); const int Rb = Epi::PERM ? ((R & ~31) + perm32(R & 31)) : R;
        voffA[i] = (unsigned)(R * K + C) * 2u; voffB[i] = (unsigned)(Rb * K + C) * 2u; }
    const size_t kstep = (size_t)(BK * 2);
    const size_t hstep = (size_t)HALF * K * 2;
    const size_t tstep = 2 * hstep;
    const unsigned ldsw = (unsigned)wid * 1024u;
    const int aoff = lds_byte(wr * 64 + fr, fq * 8), boff = lds_byte(wc * 32 + fr, fq * 8);
#define PG8_SA(b, h) (((b) * 2 + (h)) * HTB)
#define PG8_SB(b, h) ((4 + (b) * 2 + (h)) * HTB)
#define PG8_STAGE(bufoff, gbase, voff) do { _Pragma("unroll") for (int _i = 0; _i < 2; ++_i) \
        __builtin_amdgcn_global_load_lds((const unsigned*)((const char*)(gbase) + (voff)[_i]), (PG8_LAS unsigned*)(lds + (bufoff) + ldsw + _i * 8192), 16, 0, 0); } while (0)
#define PG8_LDA(dst, b, h) do { _Pragma("unroll") for (int m = 0; m < 4; ++m) _Pragma("unroll") for (int k = 0; k < 2; ++k) dst[m][k] = *(const PG8_LAS bf16x8*)(lds + PG8_SA(b, h) + aoff + m * 2048 + k * 1024); } while (0)
#define PG8_LDB(dst, b, h) do { _Pragma("unroll") for (int n = 0; n < 2; ++n) _Pragma("unroll") for (int k = 0; k < 2; ++k) dst[n][k] = *(const PG8_LAS bf16x8*)(lds + PG8_SB(b, h) + boff + n * 2048 + k * 1024); } while (0)
#define PG8_MMA(ai, bj, At, Bt) do { __builtin_amdgcn_s_setprio(1); _Pragma("unroll") for (int m = 0; m < 4; ++m) _Pragma("unroll") for (int n = 0; n < 2; ++n) _Pragma("unroll") for (int k = 0; k < 2; ++k) \
        acc[ai][bj][m][n] = __builtin_amdgcn_mfma_f32_16x16x32_bf16(Bt[n][k], At[m][k], acc[ai][bj][m][n], 0, 0, 0); __builtin_amdgcn_s_setprio(0); } while (0)
#define PG8_WAIT_V(n) asm volatile("s_waitcnt vmcnt(" #n ")" ::: "memory")
#define PG8_WAIT_L(n) asm volatile("s_waitcnt lgkmcnt(" #n ")" ::: "memory")
#define PG8_BAR __builtin_amdgcn_s_barrier()
#define PG8_SCHED __builtin_amdgcn_sched_barrier(0)
    Unit cur, nxt; int ui = 0;
    if (!S.next(0, cur)) return;
    f32x4 acc[2][2][4][2];
#pragma unroll
    for (int a = 0; a < 2; ++a)
#pragma unroll
        for (int b = 0; b < 2; ++b)
#pragma unroll
            for (int m = 0; m < 4; ++m)
#pragma unroll
                for (int n = 0; n < 2; ++n) acc[a][b][m][n] = (f32x4){0.f, 0.f, 0.f, 0.f};
    bf16x8 At[4][2], B0[2][2], B1[2][2];
    const char* cA = (const char*)g.A + (size_t)cur.pm * tstep; const char* cB = (const char*)g.Bt + (size_t)cur.pn * tstep;
    S.a_ready(cur);
    PG8_STAGE(PG8_SB(0, 0), cB, voffB); PG8_STAGE(PG8_SA(0, 0), cA, voffA); PG8_STAGE(PG8_SB(0, 1), cB + hstep, voffB); PG8_STAGE(PG8_SA(0, 1), cA + hstep, voffA);
    if (wr == 1) PG8_BAR;
    PG8_WAIT_V(4); PG8_BAR;
    PG8_STAGE(PG8_SB(1, 0), cB + kstep, voffB); PG8_STAGE(PG8_SA(1, 0), cA + kstep, voffA); PG8_STAGE(PG8_SB(1, 1), cB + hstep + kstep, voffB);
    PG8_WAIT_V(6); PG8_BAR;
    PG8_STAMP();
    for (;;) {
        const bool has_next = S.next(ui + 1, nxt);
        const char* nA = has_next ? (const char*)g.A + (size_t)nxt.pm * tstep : cA; const char* nB = has_next ? (const char*)g.Bt + (size_t)nxt.pn * tstep : cB;
        for (int t = 0; t < nt; t += 2) {
            const bool last = (t == nt - 2);
            const char* a1 = cA + (size_t)(t + 1) * kstep;
            const char* a2 = last ? nA : cA + (size_t)(t + 2) * kstep; const char* b2 = last ? nB : cB + (size_t)(t + 2) * kstep;
            const char* a3 = a2 + kstep; const char* b3 = b2 + kstep;
            if (last && has_next) S.a_ready(nxt);
            PG8_LDB(B0, 0, 0); PG8_SCHED; PG8_LDA(At, 0, 0); PG8_STAGE(PG8_SA(1, 1), a1 + hstep, voffA);
            PG8_WAIT_L(8); PG8_BAR; PG8_WAIT_L(0); PG8_MMA(0, 0, At, B0); PG8_BAR; PG8_SCHED;
            PG8_LDB(B1, 0, 1); PG8_STAGE(PG8_SB(0, 0), b2, voffB);
            PG8_BAR; PG8_WAIT_L(0); PG8_MMA(0, 1, At, B1); PG8_BAR;
            PG8_LDA(At, 0, 1); PG8_STAGE(PG8_SA(0, 0), a2, voffA);
            PG8_BAR; PG8_WAIT_L(0); PG8_MMA(1, 0, At, B0); PG8_BAR; PG8_SCHED;
            PG8_STAGE(PG8_SB(0, 1), b2 + hstep, voffB);
            PG8_WAIT_V(6); PG8_BAR; PG8_MMA(1, 1, At, B1); PG8_BAR;
            PG8_LDB(B0, 1, 0); PG8_SCHED; PG8_LDA(At, 1, 0); PG8_STAGE(PG8_SA(0, 1), a2 + hstep, voffA);
            PG8_WAIT_L(8); PG8_BAR; PG8_WAIT_L(0); PG8_MMA(0, 0, At, B0); PG8_BAR; PG8_SCHED;
            PG8_LDB(B1, 1, 1); PG8_STAGE(PG8_SB(1, 0), b3, voffB);
            PG8_BAR; PG8_WAIT_L(0); PG8_MMA(0, 1, At, B1); PG8_BAR;
            PG8_LDA(At, 1, 1); PG8_STAGE(PG8_SA(1, 0), a3, voffA);
            PG8_BAR; PG8_WAIT_L(0); PG8_MMA(1, 0, At, B0); PG8_BAR; PG8_SCHED;
            PG8_STAGE(PG8_SB(1, 1), b3 + hstep, voffB);
            PG8_WAIT_V(6); PG8_BAR; PG8_MMA(1, 1, At, B1); PG8_BAR;
        }
        PG8_STAMP();
        if constexpr (!Epi::AFTER_DRAIN) { E(acc, cur, wr, wc, fr, fq); S.done(cur); }
        PG8_STAMP();
        if (!has_next) break;
#pragma unroll
        for (int a = 0; a < 2; ++a)
#pragma unroll
            for (int b = 0; b < 2; ++b)
#pragma unroll
                for (int m = 0; m < 4; ++m)
#pragma unroll
                    for (int n = 0; n < 2; ++n) acc[a][b][m][n] = (f32x4){0.f, 0.f, 0.f, 0.f};
        cur = nxt; cA = nA; cB = nB; ++ui;
    }
    PG8_WAIT_V(0);
    if (wr == 0) PG8_BAR;
    PG8_BAR;
    if constexpr (Epi::AFTER_DRAIN) { E.fused(acc, cur, wr, wc, fr, fq, lds, wid, lane); S.done(cur); }
    PG8_STAMP();
    if (STAMP && wid == 0) { stamps[lane] = lane < nts ? (((unsigned long long)(unsigned)ts_hi << 32) | (unsigned)ts_lo) : 0ull;
        if (lane == 62) stamps[62] = rt_entry; if (lane == 63) stamps[63] = (unsigned long long)wall_clock64(); }
#undef PG8_STAMP
#undef PG8_SA
#undef PG8_SB
#undef PG8_STAGE
#undef PG8_LDA
#undef PG8_LDB
#undef PG8_MMA
#undef PG8_WAIT_V
#undef PG8_WAIT_L
#undef PG8_BAR
#undef PG8_SCHED
}
}

typedef unsigned short u16;
typedef short bf16x8 __attribute__((ext_vector_type(8)));
typedef short s16x4 __attribute__((ext_vector_type(4)));
typedef float f32x16 __attribute__((ext_vector_type(16)));
typedef float f32x4 __attribute__((ext_vector_type(4)));
typedef unsigned u32x4 __attribute__((ext_vector_type(4)));
typedef unsigned u32x2 __attribute__((ext_vector_type(2)));

constexpr int NROWS = 17408, NPROW = 16384, DM = 1024, NIN = 4224, NINP = 4352, SEQ = 4096;
constexpr int RWC = 2176;
constexpr size_t OUT_Y = 0, OUT_KP = 17825792, OUT_VP = 26214400, OUT_WKVP = 34603008, OUT_SHP = 34734080,
                 OUT_KS = 34742784, OUT_VS = 35267072, OUT_WKVS = 35791360, OUT_SHS = 39985664;
constexpr size_t WS_BAR = 0;
constexpr size_t WS_XB = 16384;
constexpr size_t WS_WINT = WS_XB + (size_t)NROWS * DM * 2;
constexpr size_t WS_WOUTT = WS_WINT + (size_t)NINP * DM * 2;
constexpr size_t WS_P = WS_WOUTT + (size_t)DM * DM * 2;
constexpr size_t WS_QB = WS_P + (size_t)NROWS * NINP * 4;
constexpr size_t WS_KB = WS_QB + (size_t)NROWS * 512 * 2;
constexpr size_t WS_VB = WS_KB + (size_t)NROWS * 512 * 2;
constexpr size_t WS_SR = WS_VB + (size_t)NROWS * 512 * 2;
constexpr size_t SARR = (size_t)NROWS * 512 * 4;
constexpr size_t WS_SW = WS_SR + SARR, WS_SK = WS_SW + SARR, WS_SV = WS_SK + SARR, WS_SA = WS_SV + SARR, WS_SB = WS_SA + SARR, WS_SG = WS_SB + SARR;
constexpr size_t WS_O = WS_SG + SARR;
constexpr size_t WS_END = WS_O + (size_t)NROWS * DM * 2;

struct Params {
    const float* x_prompt; const float* x_sample; const float* cache_k; const float* cache_v; const int* page_table;
    const float* state_wkv; const float* state_shift; const float* norm_in; const float* w_in; const float* sb_bias;
    const float* mu; const float* w0; const float* w_up; const float* a0; const float* a_up; const float* k_k; const float* k_a;
    const float* r_k; const float* ln_w; const float* ln_b; const float* w_out; const float* norm_f;
    float* out; unsigned char* ws;
};

#define LOG2E 1.4426950408889634f

__device__ __forceinline__ unsigned cvtpk(float lo, float hi) { unsigned r; asm("v_cvt_pk_bf16_f32 %0, %1, %2" : "=v"(r) : "v"(lo), "v"(hi)); return r; }
__device__ __forceinline__ u16 f2bf(float f) { return (u16)(cvtpk(f, 0.f) & 0xffffu); }
template <int CTRL> __device__ __forceinline__ float dppf(float x) { return __builtin_bit_cast(float, __builtin_amdgcn_update_dpp(0, __builtin_bit_cast(int, x), CTRL, 0xf, 0xf, true)); }
__device__ __forceinline__ float reduce8(float x) { x += dppf<0xB1>(x); x += dppf<0x4E>(x); x += dppf<0x141>(x); return x; }
__device__ __forceinline__ float wave_sum(float x) { x = reduce8(x); x += dppf<0x140>(x); x += __shfl_xor(x, 16); x += __shfl_xor(x, 32); return x; }
__device__ __forceinline__ float silu_f(float g) { return g / (1.0f + __expf(-g)); }

__device__ __forceinline__ void phase_prologue(const Params& p, int bid, int nb, unsigned char* smem) {
    const int tid = threadIdx.x, lane = tid & 63, w = tid >> 6;
    u16* Xb = (u16*)(p.ws + WS_XB);
    for (int row = bid * 8 + w; row < NROWS; row += nb * 8) {
        const float* src = row < NPROW ? p.x_prompt + (size_t)row * DM : p.x_sample + (size_t)(row - NPROW) * DM;
        f32x4 v[4]; float ss = 0.f;
#pragma unroll
        for (int i = 0; i < 4; ++i) { v[i] = *(const f32x4*)(src + lane * 4 + i * 256); ss += v[i][0] * v[i][0] + v[i][1] * v[i][1] + v[i][2] * v[i][2] + v[i][3] * v[i][3]; }
        ss = wave_sum(ss);
        const float rs = rsqrtf(ss * (1.0f / 1024.0f) + 1e-6f);
#pragma unroll
        for (int i = 0; i < 4; ++i) { u32x2 o; o.x = cvtpk(v[i][0] * rs, v[i][1] * rs); o.y = cvtpk(v[i][2] * rs, v[i][3] * rs); *(u32x2*)(Xb + (size_t)row * DM + lane * 4 + i * 256) = o; }
    }
    float* tile = (float*)smem;
    u16* WinT = (u16*)(p.ws + WS_WINT); u16* WoutT = (u16*)(p.ws + WS_WOUTT);
    const int NT1 = (NINP / 64) * 16, NT2 = 16 * 16;
    for (int id = bid; id < NT1 + NT2; id += nb) {
        const bool first = id < NT1; const int id2 = first ? id : id - NT1;
        const int nt = id2 / 16, kt = id2 % 16, n0 = nt * 64, k0 = kt * 64;
#pragma unroll
        for (int j = 0; j < 8; ++j) { const int e = tid + 512 * j, kr = e >> 6, nc = e & 63; float val;
            if (first) val = (n0 + nc < NIN) ? p.w_in[(size_t)(k0 + kr) * NIN + n0 + nc] * p.norm_in[k0 + kr] : 0.f;
            else val = p.w_out[(size_t)(k0 + kr) * DM + n0 + nc];
            tile[kr * 65 + nc] = val; }
        __syncthreads();
        u16* dst = first ? WinT : WoutT;
#pragma unroll
        for (int j = 0; j < 8; ++j) { const int e = tid + 512 * j, nr = e >> 6, kc = e & 63; dst[(size_t)(n0 + nr) * DM + k0 + kc] = f2bf(tile[kc * 65 + nr]); }
        __syncthreads();
    }
}

__device__ __forceinline__ void phase_prep(const Params& p, int bid, int nb, unsigned char* smem) {
    const int c = threadIdx.x, lane = c & 63;
    float* lbuf = (float*)smem;
    const float* P = (const float*)(p.ws + WS_P);
    u16* Qb = (u16*)(p.ws + WS_QB); u16* Kb = (u16*)(p.ws + WS_KB); u16* Vb = (u16*)(p.ws + WS_VB);
    float* SR = (float*)(p.ws + WS_SR); float* SW = (float*)(p.ws + WS_SW); float* SK = (float*)(p.ws + WS_SK); float* SV = (float*)(p.ws + WS_SV);
    float* SA = (float*)(p.ws + WS_SA); float* SBb = (float*)(p.ws + WS_SB); float* SG = (float*)(p.ws + WS_SG);
    float wu[64], au[64];
#pragma unroll
    for (int i = 0; i < 64; ++i) { wu[i] = p.w_up[i * 512 + c]; au[i] = p.a_up[i * 512 + c]; }
    const float mu_r = p.mu[c], mu_k = p.mu[512 + c], mu_v = p.mu[1024 + c], mu_g = p.mu[1536 + c], mu_l = c < 128 ? p.mu[2048 + c] : 0.f;
    const float w0c = p.w0[c], a0c = p.a0[c], kkc = p.k_k[c], kac = p.k_a[c];
    const int h = c >> 6, d = c & 63;
    for (int u = bid; u < 384; u += nb) {
        int row0, ntok, t0, seqlen; bool prompt = u < 256; int bd = 0;
        if (prompt) { const int b = u >> 6, seg = u & 63; t0 = seg * 64; row0 = b * SEQ + t0; ntok = 64; seqlen = SEQ; }
        else { bd = u - 256; t0 = 0; row0 = NPROW + bd * 8; ntok = 8; seqlen = 8; }
        float pr, pk, pv, pg, pl;
        if (t0 > 0) { const float* q = P + (size_t)(row0 - 1) * NINP + 2048; pr = q[c]; pk = q[512 + c]; pv = q[1024 + c]; pg = q[1536 + c]; pl = c < 128 ? q[2048 + c] : 0.f; }
        else if (prompt) { pr = pk = pv = pg = pl = 0.f; }
        else { const float* q = p.state_shift + (size_t)bd * RWC; pr = q[c]; pk = q[512 + c]; pv = q[1024 + c]; pg = q[1536 + c]; pl = c < 128 ? q[2048 + c] : 0.f; }
        for (int t = 0; t < ntok; ++t) {
            const int R = row0 + t; const float* prow = P + (size_t)R * NINP;
            const float q_ = prow[c], k_ = prow[512 + c], v_ = prow[1024 + c];
            if (prompt) { p.out[OUT_KP + (size_t)R * 512 + c] = k_; p.out[OUT_VP + (size_t)R * 512 + c] = v_;
                const int b = R >> 12, s = R & 4095; const size_t idx = ((size_t)((b * 8 + h) * SEQ + s)) * 64 + d;
                Qb[idx] = f2bf(q_ * (0.125f * LOG2E)); Kb[idx] = f2bf(k_); Vb[idx] = f2bf(v_); }
            else { const int rr = R - NPROW; p.out[OUT_KS + (size_t)rr * 512 + c] = k_; p.out[OUT_VS + (size_t)rr * 512 + c] = v_;
                const int b2 = rr >> 3, tt = rr & 7; const size_t idx = (size_t)NPROW * 512 + ((size_t)((b2 * 8 + h) * 8 + tt)) * 64 + d;
                Qb[idx] = f2bf(q_ * (0.125f * LOG2E)); Kb[idx] = f2bf(k_); Vb[idx] = f2bf(v_); }
            const float xr = prow[2048 + c], xk = prow[2560 + c], xv = prow[3072 + c], xg = prow[3584 + c], xl = c < 128 ? prow[4096 + c] : 0.f;
            const float zr = xr + (pr - xr) * mu_r, zk = xk + (pk - xk) * mu_k, zv = xv + (pv - xv) * mu_v, zg = xg + (pg - xg) * mu_g, zl = xl + (pl - xl) * mu_l;
            float* lb = lbuf + (t & 1) * 128;
            if (c < 64) { const float e2 = __expf(2.0f * zl); lb[c] = 1.0f - 2.0f / (e2 + 1.0f); }
            else if (c < 128) lb[c] = zl;
            __syncthreads();
            float lw = 0.f, la = 0.f;
#pragma unroll
            for (int i = 0; i < 16; ++i) { const f32x4 a = *(const f32x4*)(lb + 4 * i), b = *(const f32x4*)(lb + 64 + 4 * i);
                lw += a[0] * wu[4 * i] + a[1] * wu[4 * i + 1] + a[2] * wu[4 * i + 2] + a[3] * wu[4 * i + 3];
                la += b[0] * au[4 * i] + b[1] * au[4 * i + 1] + b[2] * au[4 * i + 2] + b[3] * au[4 * i + 3]; }
            const float xw = -(w0c + lw);
            const float sp = fmaxf(xw, 0.f) + log1pf(__expf(-fabsf(xw)));
            const float decay = __expf(-__expf(-sp - 0.5f));
            const float alr = 1.0f / (1.0f + __expf(-(a0c + la)));
            float kk = zk * kkc; const float ss = wave_sum(kk * kk); kk = kk / fmaxf(sqrtf(ss), 1e-12f);
            const float keff = zk * (1.0f + (alr - 1.0f) * kac);
            const size_t o = (size_t)R * 512 + c;
            SR[o] = zr; SW[o] = decay; SK[o] = keff; SV[o] = zv; SA[o] = kk; SBb[o] = kk * alr; SG[o] = silu_f(zg);
            if (t0 + t == seqlen - 1) {
                float* sh = prompt ? p.out + OUT_SHP + (size_t)(R >> 12) * RWC : p.out + OUT_SHS + (size_t)bd * RWC;
                sh[c] = xr; sh[512 + c] = xk; sh[1024 + c] = xv; sh[1536 + c] = xg; if (c < 128) sh[2048 + c] = xl; }
            pr = xr; pk = xk; pv = xv; pg = xg; pl = xl;
        }
        __syncthreads();
    }
}

constexpr int SCH = 32;
__device__ __forceinline__ void phase_scan(const Params& p, int bid, int nb, unsigned char* smem) {
    const int tid = threadIdx.x, lane = tid & 63, w = tid >> 6;
    float* L = (float*)smem;
    float* ybuf = L + 6 * SCH * 64;
    const float* SRC[6] = {(const float*)(p.ws + WS_SR), (const float*)(p.ws + WS_SW), (const float*)(p.ws + WS_SK), (const float*)(p.ws + WS_SV), (const float*)(p.ws + WS_SA), (const float*)(p.ws + WS_SB)};
    const float* SG = (const float*)(p.ws + WS_SG);
    u16* O = (u16*)(p.ws + WS_O);
    const int rw = w * 8 + (lane >> 3), cc = lane & 7;
    for (int u = bid; u < 32 + 1024; u += nb) {
        int h, row0, T; const float* sin; float* sout;
        if (u < 32) { h = u & 7; row0 = (u >> 3) * SEQ; T = SEQ; sin = nullptr; sout = p.out + OUT_WKVP + (size_t)u * 4096; }
        else { const int idx = u - 32; h = idx & 7; row0 = NPROW + (idx >> 3) * 8; T = 8; sin = p.state_wkv + (size_t)idx * 4096; sout = p.out + OUT_WKVS + (size_t)idx * 4096; }
        float s[8];
        if (sin) { const f32x4 a = *(const f32x4*)(sin + rw * 64 + cc * 8), b = *(const f32x4*)(sin + rw * 64 + cc * 8 + 4); s[0] = a[0]; s[1] = a[1]; s[2] = a[2]; s[3] = a[3]; s[4] = b[0]; s[5] = b[1]; s[6] = b[2]; s[7] = b[3]; }
        else {
#pragma unroll
            for (int e = 0; e < 8; ++e) s[e] = 0.f; }
        const int CH = T < SCH ? T : SCH, nch = T / CH;
        const int ptok = tid >> 4, pf4 = tid & 15; const bool pact = ptok < CH;
        f32x4 pf[6];
        if (pact) {
#pragma unroll
            for (int j = 0; j < 6; ++j) pf[j] = *(const f32x4*)(SRC[j] + (size_t)(row0 + ptok) * 512 + h * 64 + pf4 * 4); }
        for (int ch = 0; ch < nch; ++ch) {
            if (pact) {
#pragma unroll
                for (int j = 0; j < 6; ++j) *(f32x4*)(L + j * SCH * 64 + ptok * 64 + pf4 * 4) = pf[j]; }
            __syncthreads();
            if (pact && ch + 1 < nch) {
#pragma unroll
                for (int j = 0; j < 6; ++j) pf[j] = *(const f32x4*)(SRC[j] + (size_t)(row0 + (ch + 1) * CH + ptok) * 512 + h * 64 + pf4 * 4); }
            for (int t = 0; t < CH; ++t) {
                const float* base = L + t * 64 + cc * 8;
                const f32x4 r0 = *(const f32x4*)(base), r1 = *(const f32x4*)(base + 4);
                const f32x4 w0 = *(const f32x4*)(base + SCH * 64), w1 = *(const f32x4*)(base + SCH * 64 + 4);
                const f32x4 k0 = *(const f32x4*)(base + 2 * SCH * 64), k1 = *(const f32x4*)(base + 2 * SCH * 64 + 4);
                const float vv = L[3 * SCH * 64 + t * 64 + rw];
                const f32x4 a0 = *(const f32x4*)(base + 4 * SCH * 64), a1 = *(const f32x4*)(base + 4 * SCH * 64 + 4);
                const f32x4 b0 = *(const f32x4*)(base + 5 * SCH * 64), b1 = *(const f32x4*)(base + 5 * SCH * 64 + 4);
                float dot = (s[0] * a0[0] + s[1] * a0[1]) + (s[2] * a0[2] + s[3] * a0[3]) + (s[4] * a1[0] + s[5] * a1[1]) + (s[6] * a1[2] + s[7] * a1[3]);
                dot = reduce8(dot);
                const float sa = -dot;
                s[0] = s[0] * w0[0] + (sa * b0[0] + vv * k0[0]); s[1] = s[1] * w0[1] + (sa * b0[1] + vv * k0[1]);
                s[2] = s[2] * w0[2] + (sa * b0[2] + vv * k0[2]); s[3] = s[3] * w0[3] + (sa * b0[3] + vv * k0[3]);
                s[4] = s[4] * w1[0] + (sa * b1[0] + vv * k1[0]); s[5] = s[5] * w1[1] + (sa * b1[1] + vv * k1[1]);
                s[6] = s[6] * w1[2] + (sa * b1[2] + vv * k1[2]); s[7] = s[7] * w1[3] + (sa * b1[3] + vv * k1[3]);
                float yp = (s[0] * r0[0] + s[1] * r0[1]) + (s[2] * r0[2] + s[3] * r0[3]) + (s[4] * r1[0] + s[5] * r1[1]) + (s[6] * r1[2] + s[7] * r1[3]);
                yp = reduce8(yp);
                if (cc == 0) ybuf[t * 64 + rw] = yp;
            }
            __syncthreads();
            for (int tt = w; tt < CH; tt += 8) {
                const int R = row0 + ch * CH + tt;
                const float y = ybuf[tt * 64 + lane];
                const float mean = wave_sum(y) * (1.0f / 64.0f); const float dd = y - mean;
                const float var = wave_sum(dd * dd) * (1.0f / 64.0f);
                const float yn = dd * rsqrtf(var + 64e-5f) * p.ln_w[h * 64 + lane] + p.ln_b[h * 64 + lane];
                const float rr = L[tt * 64 + lane], ke = L[2 * SCH * 64 + tt * 64 + lane], vv = L[3 * SCH * 64 + tt * 64 + lane];
                const float bs = wave_sum(rr * ke * p.r_k[h * 64 + lane]);
                const float outv = (yn + bs * vv) * SG[(size_t)R * 512 + h * 64 + lane];
                O[(size_t)R * DM + 512 + h * 64 + lane] = f2bf(outv);
            }
            __syncthreads();
        }
        { f32x4 a = {s[0], s[1], s[2], s[3]}, b = {s[4], s[5], s[6], s[7]}; *(f32x4*)(sout + rw * 64 + cc * 8) = a; *(f32x4*)(sout + rw * 64 + cc * 8 + 4) = b; }
    }
}

#define MFMA32(a, b, c) __builtin_amdgcn_mfma_f32_32x32x16_bf16(a, b, c, 0, 0, 0)
typedef __attribute__((address_space(3))) const char* lds_cptr;
typedef short v4i16_t __attribute__((ext_vector_type(4)));
__device__ __forceinline__ s16x4 vtr(lds_cptr ptr) { return __builtin_bit_cast(s16x4, __builtin_amdgcn_ds_read_tr16_b64_v4i16((__attribute__((address_space(3))) v4i16_t*)ptr)); }
__device__ __forceinline__ int crow(int r, int hi) { return (r & 3) + 8 * (r >> 2) + 4 * hi; }

__device__ __forceinline__ void sb_sub(f32x16& x, float& carry, int hi) {
    float e[16], s[16];
#pragma unroll
    for (int r = 0; r < 16; ++r) { e[r] = __builtin_amdgcn_exp2f(fminf(x[r], 100.0f)); s[r] = __builtin_amdgcn_rcpf(1.0f + e[r]); }
    float g[4], hh[4], cm[4];
#pragma unroll
    for (int m = 0; m < 4; ++m) { s[4 * m + 2] *= s[4 * m + 3]; s[4 * m + 1] *= s[4 * m + 2]; s[4 * m] *= s[4 * m + 1]; g[m] = s[4 * m]; }
#pragma unroll
    for (int m = 0; m < 4; ++m) { hh[m] = __shfl_xor(g[m], 32); cm[m] = g[m] * hh[m]; }
    float D[4]; D[3] = carry; D[2] = cm[3] * D[3]; D[1] = cm[2] * D[2]; D[0] = cm[1] * D[1]; carry = cm[0] * D[0];
#pragma unroll
    for (int m = 0; m < 4; ++m) { const float Lm = D[m] * (hi ? 1.0f : hh[m]);
#pragma unroll
        for (int i = 0; i < 4; ++i) x[4 * m + i] = e[4 * m + i] * s[4 * m + i] * Lm; }
}

__device__ __forceinline__ void sb_tile(lds_cptr ldsK, lds_cptr ldsV, const bf16x8 (&qr)[4], float bias2, int qrel, int lane, float& carry, f32x16 (&o)[2]) {
    const int r32 = lane & 31, hi = lane >> 5;
    const lds_cptr kp0 = ldsK + hi * 1024 + r32 * 16;
    bf16x8 kf[8];
#pragma unroll
    for (int d0 = 0; d0 < 4; ++d0) { kf[2 * d0] = *(const __attribute__((address_space(3))) bf16x8*)(kp0 + d0 * 2048); kf[2 * d0 + 1] = *(const __attribute__((address_space(3))) bf16x8*)(kp0 + d0 * 2048 + 512); }
    f32x16 C0, C1;
#pragma unroll
    for (int r = 0; r < 16; ++r) { C0[r] = bias2; C1[r] = bias2; }
#pragma unroll
    for (int d0 = 0; d0 < 4; ++d0) { C0 = MFMA32(kf[2 * d0], qr[d0], C0); C1 = MFMA32(kf[2 * d0 + 1], qr[d0], C1); }
    if (qrel >= 0) {
#pragma unroll
        for (int r = 0; r < 16; ++r) { const int kv = crow(r, hi); if (kv >= qrel) C0[r] = -INFINITY; if (kv + 32 >= qrel) C1[r] = -INFINITY; }
    }
    sb_sub(C1, carry, hi); sb_sub(C0, carry, hi);
    u32x4 pw[4];
#pragma unroll
    for (int i = 0; i < 4; ++i) { pw[0][i] = cvtpk(C0[2 * i], C0[2 * i + 1]); pw[1][i] = cvtpk(C0[8 + 2 * i], C0[8 + 2 * i + 1]); pw[2][i] = cvtpk(C1[2 * i], C1[2 * i + 1]); pw[3][i] = cvtpk(C1[8 + 2 * i], C1[8 + 2 * i + 1]); }
    const lds_cptr vp0 = ldsV + ((lane >> 4) & 1) * 32 + (lane & 3) * 8 + (4 * hi + ((lane & 15) >> 2)) * 64;
#pragma unroll
    for (int i = 0; i < 8; ++i) {
        const s16x4 lo = vtr(vp0 + ((i >> 2) * 4096 + (i & 3) * 1024)), hi4 = vtr(vp0 + ((i >> 2) * 4096 + (i & 3) * 1024 + 512));
        const bf16x8 vf = {lo[0], lo[1], lo[2], lo[3], hi4[0], hi4[1], hi4[2], hi4[3]};
        o[i >> 2] = MFMA32(__builtin_bit_cast(bf16x8, pw[i & 3]), vf, o[i >> 2]);
    }
}

__device__ __forceinline__ void phase_attn_prompt(const Params& p, int bid, int nb, unsigned char* smem) {
    const int tid = threadIdx.x, lane = tid & 63, r32 = lane & 31, hi = lane >> 5; const int w = __builtin_amdgcn_readfirstlane(tid >> 6);
    unsigned char* ldsK = smem; unsigned char* ldsV = smem + 8192;
    const u16* Qb = (const u16*)(p.ws + WS_QB); const u16* Kb = (const u16*)(p.ws + WS_KB); const u16* Vb = (const u16*)(p.ws + WS_VB);
    const float* P = (const float*)(p.ws + WS_P); u16* O = (u16*)(p.ws + WS_O);
    for (int u = bid; u < 512; u += nb) {
        const int qb = 15 - (u >> 5), bh = u & 31, b = bh >> 3, h = bh & 7, q0 = qb * 256, NT = 4 * qb + 4;
        const float bias2 = p.sb_bias[h] * LOG2E;
        const u16* Qw = Qb + ((size_t)bh * SEQ + q0 + w * 32) * 64;
        bf16x8 qr[4];
#pragma unroll
        for (int d0 = 0; d0 < 4; ++d0) qr[d0] = *(const bf16x8*)(Qw + r32 * 64 + d0 * 16 + hi * 8);
        const u16* ksrc = Kb + (size_t)bh * SEQ * 64 + (size_t)lane * 64 + w * 8;
        const u16* vsrc = Vb + (size_t)bh * SEQ * 64 + (size_t)(16 * (w & 3) + (lane >> 2)) * 64 + (w >> 2) * 32 + (lane & 3) * 8;
        const int jw = 4 * qb + (w >> 1), qrel = 32 * (w & 1) + r32;
        float carry = 1.0f; f32x16 o[2];
#pragma unroll
        for (int r = 0; r < 16; ++r) { o[0][r] = 0.f; o[1][r] = 0.f; }
        u32x4 kreg = *(const u32x4*)(ksrc + (size_t)(NT - 1) * 64 * 64), vreg = *(const u32x4*)(vsrc + (size_t)(NT - 1) * 64 * 64);
        for (int j = NT - 1; j >= 0; --j) {
            *(u32x4*)(ldsK + w * 1024 + lane * 16) = kreg; *(u32x4*)(ldsV + w * 1024 + lane * 16) = vreg;
            __syncthreads();
            if (j > 0) { kreg = *(const u32x4*)(ksrc + (size_t)(j - 1) * 64 * 64); vreg = *(const u32x4*)(vsrc + (size_t)(j - 1) * 64 * 64); }
            if (j <= jw) sb_tile((lds_cptr)ldsK, (lds_cptr)ldsV, qr, bias2, j == jw ? qrel : -1, lane, carry, o);
            __syncthreads();
        }
#pragma unroll
        for (int dh = 0; dh < 2; ++dh)
#pragma unroll
            for (int r = 0; r < 16; ++r) { const int R = b * SEQ + q0 + w * 32 + crow(r, hi), dcol = h * 64 + dh * 32 + r32;
                const float g = P[(size_t)R * NINP + 1536 + dcol]; O[(size_t)R * DM + dcol] = f2bf(o[dh][r] * silu_f(g)); }
    }
}

__device__ __forceinline__ void phase_attn_sample(const Params& p, int bid, int nb, unsigned char* smem) {
    const int tid = threadIdx.x, lane = tid & 63, r32 = lane & 31, hi = lane >> 5; const int w = __builtin_amdgcn_readfirstlane(tid >> 6);
    unsigned char* ldsK = smem; unsigned char* ldsV = smem + 8192;
    const u16* Qb = (const u16*)(p.ws + WS_QB) + (size_t)NPROW * 512; const u16* Kb = (const u16*)(p.ws + WS_KB) + (size_t)NPROW * 512; const u16* Vb = (const u16*)(p.ws + WS_VB) + (size_t)NPROW * 512;
    const float* P = (const float*)(p.ws + WS_P); u16* O = (u16*)(p.ws + WS_O);
    const int krow = lane, kd = w * 8;
    const int vrow = 16 * (w & 3) + (lane >> 2), vd = (w >> 2) * 32 + (lane & 3) * 8;
    for (int u = bid; u < 1024; u += nb) {
        const int bd = u >> 3, h = u & 7;
        const float bias2 = p.sb_bias[h] * LOG2E;
        bf16x8 qr[4];
#pragma unroll
        for (int d0 = 0; d0 < 4; ++d0) qr[d0] = *(const bf16x8*)(Qb + ((size_t)u * 8 + (r32 & 7)) * 64 + d0 * 16 + hi * 8);
        float carry = 1.0f; f32x16 o[2];
#pragma unroll
        for (int r = 0; r < 16; ++r) { o[0][r] = 0.f; o[1][r] = 0.f; }
        u32x4 kreg = {0u, 0u, 0u, 0u}, vreg = {0u, 0u, 0u, 0u};
        if (krow < 8) kreg = *(const u32x4*)(Kb + ((size_t)u * 8 + krow) * 64 + kd);
        if (vrow < 8) vreg = *(const u32x4*)(Vb + ((size_t)u * 8 + vrow) * 64 + vd);
        f32x4 ka, kb, va, vb;
        for (int j = 32; j >= 0; --j) {
            *(u32x4*)(ldsK + w * 1024 + lane * 16) = kreg; *(u32x4*)(ldsV + w * 1024 + lane * 16) = vreg;
            __syncthreads();
            if (j > 0) { const int jj = j - 1; const int page = p.page_table[bd * 16 + (jj >> 1)]; const size_t rb = (size_t)page * 128 + (jj & 1) * 64;
                const float* kp = p.cache_k + ((rb + krow) * 8 + h) * 64 + kd; const float* vp = p.cache_v + ((rb + vrow) * 8 + h) * 64 + vd;
                ka = *(const f32x4*)kp; kb = *(const f32x4*)(kp + 4); va = *(const f32x4*)vp; vb = *(const f32x4*)(vp + 4); }
            if (w == 0) sb_tile((lds_cptr)ldsK, (lds_cptr)ldsV, qr, bias2, j == 32 ? r32 : -1, lane, carry, o);
            if (j > 0) { kreg.x = cvtpk(ka[0], ka[1]); kreg.y = cvtpk(ka[2], ka[3]); kreg.z = cvtpk(kb[0], kb[1]); kreg.w = cvtpk(kb[2], kb[3]);
                vreg.x = cvtpk(va[0], va[1]); vreg.y = cvtpk(va[2], va[3]); vreg.z = cvtpk(vb[0], vb[1]); vreg.w = cvtpk(vb[2], vb[3]); }
            __syncthreads();
        }
        if (w == 0) {
#pragma unroll
            for (int dh = 0; dh < 2; ++dh)
#pragma unroll
                for (int r = 0; r < 4; ++r) { const int R = NPROW + bd * 8 + 4 * hi + r, dcol = h * 64 + dh * 32 + r32;
                    const float g = P[(size_t)R * NINP + 1536 + dcol]; O[(size_t)R * DM + dcol] = f2bf(o[dh][r] * silu_f(g)); }
        }
    }
}

struct EpiRes {
    static constexpr bool PERM = false, AFTER_DRAIN = false;
    float* C; const float* xp; const float* xs;
    __device__ __forceinline__ void operator()(const pg8::f32x4 (&acc)[2][2][4][2], const pg8::Unit& u, int wr, int wc, int fr, int fq) const {
        const int row0 = u.pm * 256 + wr * 64 + fr, col0 = u.pn * 256 + wc * 32 + 4 * fq;
#pragma unroll
        for (int ai = 0; ai < 2; ++ai)
#pragma unroll
            for (int m = 0; m < 4; ++m) { const int row = row0 + ai * 128 + m * 16; float* rowp = C + (size_t)row * DM + col0;
                const float* xr = (row < NPROW ? xp + (size_t)row * DM : xs + (size_t)(row - NPROW) * DM) + col0;
#pragma unroll
                for (int bj = 0; bj < 2; ++bj)
#pragma unroll
                    for (int n = 0; n < 2; ++n) *(pg8::f32x4*)(rowp + bj * 128 + n * 16) = acc[ai][bj][m][n] + *(const pg8::f32x4*)(xr + bj * 128 + n * 16); }
    }
};

__device__ __forceinline__ void phase_final(const Params& p, int bid, int nb) {
    const int tid = threadIdx.x, lane = tid & 63, w = tid >> 6;
    f32x4 g[4];
#pragma unroll
    for (int i = 0; i < 4; ++i) g[i] = *(const f32x4*)(p.norm_f + lane * 4 + i * 256);
    for (int row = bid * 8 + w; row < NROWS; row += nb * 8) {
        float* src = p.out + (size_t)row * DM;
        f32x4 v[4]; float ss = 0.f;
#pragma unroll
        for (int i = 0; i < 4; ++i) { v[i] = *(const f32x4*)(src + lane * 4 + i * 256); ss += v[i][0] * v[i][0] + v[i][1] * v[i][1] + v[i][2] * v[i][2] + v[i][3] * v[i][3]; }
        ss = wave_sum(ss);
        const float rs = rsqrtf(ss * (1.0f / 1024.0f) + 1e-6f);
#pragma unroll
        for (int i = 0; i < 4; ++i) *(f32x4*)(src + lane * 4 + i * 256) = v[i] * rs * g[i];
    }
}

constexpr int LDS_BYTES = 131072 + 16;
template <int PH> __global__ __launch_bounds__(512, 2) void k_phase(Params p) {
    extern __shared__ __attribute__((aligned(16))) unsigned char shm[];
    const int bid = blockIdx.x, nb = gridDim.x;
    if constexpr (PH == 0) phase_prologue(p, bid, nb, shm);
    if constexpr (PH == 1) { pg8::Gemm g{(const pg8::bf16_t*)(p.ws + WS_XB), (const pg8::bf16_t*)(p.ws + WS_WINT), NROWS, NINP, DM}; pg8::StaticOrder S; S.init(NROWS, NINP, nb, bid);
        pg8::EpiF32 E{(float*)(p.ws + WS_P), NINP, nullptr}; pg8::gemm_phase<pg8::EpiF32, pg8::StaticOrder, false>((PG8_LAS unsigned char*)shm, g, S, E, nullptr); }
    if constexpr (PH == 2) phase_prep(p, bid, nb, shm);
    if constexpr (PH == 3) phase_scan(p, bid, nb, shm);
    if constexpr (PH == 4) phase_attn_prompt(p, bid, nb, shm);
    if constexpr (PH == 5) phase_attn_sample(p, bid, nb, shm);
    if constexpr (PH == 6) { pg8::Gemm g{(const pg8::bf16_t*)(p.ws + WS_O), (const pg8::bf16_t*)(p.ws + WS_WOUTT), NROWS, DM, DM}; pg8::StaticOrder S; S.init(NROWS, DM, nb, bid);
        EpiRes E{p.out, p.x_prompt, p.x_sample}; pg8::gemm_phase<EpiRes, pg8::StaticOrder, false>((PG8_LAS unsigned char*)shm, g, S, E, nullptr); }
    if constexpr (PH == 7) phase_final(p, bid, nb);
}

template <int PH> static void launch_phase(const Params& p, hipStream_t stream) {
    static bool attr = false;
    if (!attr) { (void)hipFuncSetAttribute((const void*)k_phase<PH>, hipFuncAttributeMaxDynamicSharedMemorySize, LDS_BYTES); attr = true; }
    hipLaunchKernelGGL((k_phase<PH>), dim3(256), dim3(512), LDS_BYTES, stream, p);
}

extern "C" void kernel_launch(void* const* d_in, const int* in_sizes, int n_in, void* d_out, int out_size, void* d_ws, size_t ws_size, hipStream_t stream) {
    if (ws_size < WS_END) { fprintf(stderr, "kernel_launch: workspace too small (%zu < %zu)\n", ws_size, (size_t)WS_END); return; }
    Params p{};
    p.x_prompt = (const float*)d_in[0]; p.x_sample = (const float*)d_in[1]; p.cache_k = (const float*)d_in[2]; p.cache_v = (const float*)d_in[3]; p.page_table = (const int*)d_in[4];
    p.state_wkv = (const float*)d_in[5]; p.state_shift = (const float*)d_in[6]; p.norm_in = (const float*)d_in[7]; p.w_in = (const float*)d_in[8]; p.sb_bias = (const float*)d_in[9];
    p.mu = (const float*)d_in[10]; p.w0 = (const float*)d_in[11]; p.w_up = (const float*)d_in[12]; p.a0 = (const float*)d_in[13]; p.a_up = (const float*)d_in[14];
    p.k_k = (const float*)d_in[15]; p.k_a = (const float*)d_in[16]; p.r_k = (const float*)d_in[17]; p.ln_w = (const float*)d_in[18]; p.ln_b = (const float*)d_in[19];
    p.w_out = (const float*)d_in[20]; p.norm_f = (const float*)d_in[21];
    p.out = (float*)d_out; p.ws = (unsigned char*)d_ws;
    launch_phase<0>(p, stream); launch_phase<1>(p, stream); launch_phase<2>(p, stream); launch_phase<3>(p, stream);
    launch_phase<4>(p, stream); launch_phase<5>(p, stream); launch_phase<6>(p, stream); launch_phase<7>(p, stream);
}
```

```cpp
#include <hip/hip_runtime.h>
#include <stdint.h>
#include <stdio.h>
__device__ __forceinline__ void mk_sync() { __builtin_amdgcn_fence(__ATOMIC_RELEASE, "workgroup"); __builtin_amdgcn_s_barrier(); __builtin_amdgcn_fence(__ATOMIC_ACQUIRE, "workgroup"); }
#define __syncthreads() mk_sync()
namespace pg8 {
#define PG8_LAS __attribute__((address_space(3)))
typedef unsigned short bf16_t;
typedef short bf16x8 __attribute__((ext_vector_type(8)));
typedef float f32x4 __attribute__((ext_vector_type(4)));
typedef unsigned u32x4 __attribute__((ext_vector_type(4)));
constexpr int BM = 256, BK = 64, HALF = 128, HTB = HALF * BK * 2  , STAGE_BYTES = 8 * HTB, NXCD = 8, WGM = 8;

__host__ __device__ __forceinline__ int lds_byte(int r, int c) { const int st = (r >> 4) * 2 + (c >> 5), rr = r & 15, cc = c & 31, ob = rr * 64 + cc * 2; return st * 1024 + (ob ^ (((ob >> 9) & 1) << 5)); }
__host__ __device__ __forceinline__ void stage_rc(int b, int& R, int& C) { const int st = b / 1024, sb = b % 1024, swz = sb ^ (((sb >> 9) & 1) << 5); R = (st >> 1) * 16 + swz / 64; C = (st & 1) * 32 + (swz % 64) / 2; }
__host__ __device__ __forceinline__ int perm32(int rho) { const int n = rho >> 4, i = rho & 15; return 8 * (i >> 2) + 4 * n + (i & 3); }

struct Unit { int pm, pn; };
struct Gemm { const bf16_t* A; const bf16_t* Bt; int M, N, K; };

struct StaticOrder {
    int nM, nN, nwg, G, c;
    __host__ __device__ __forceinline__ void init(int M, int N, int G_, int c_) { nM = M / BM; nN = N / BM; nwg = nM * nN; G = G_; c = c_; }
    __host__ __device__ __forceinline__ bool next(int i, Unit& u) const {
        const long L = (long)i * G + c; if (L >= nwg) return false;
        int wgid = (int)L; { const int q = nwg / NXCD, r = nwg % NXCD, xcd = wgid % NXCD, off = wgid / NXCD; wgid = (xcd < r ? xcd * (q + 1) : r * (q + 1) + (xcd - r) * q) + off; }
        const int nig = WGM * nN, gid = wgid / nig, fm = gid * WGM, gsz = (nM - fm) < WGM ? (nM - fm) : WGM;
        u.pm = fm + ((wgid % nig) % gsz); u.pn = (wgid % nig) / gsz; return true;
    }
    __device__ __forceinline__ void a_ready(const Unit&) const {}
    __device__ __forceinline__ void done(const Unit&) const {}
};
struct CountedOrder : StaticOrder {
    const unsigned* ready; unsigned need; unsigned* tmo;
    __device__ __forceinline__ void a_ready(const Unit& u) const {
        if (threadIdx.x < 64) {
            const unsigned long long t0 = __builtin_amdgcn_s_memrealtime(); unsigned polls = 0;
            while ((unsigned)__builtin_amdgcn_readfirstlane(__hip_atomic_load(ready + 64 * u.pm, __ATOMIC_RELAXED, __HIP_MEMORY_SCOPE_AGENT)) < need) {
                if ((++polls & 255u) == 0u && __builtin_amdgcn_readfirstlane(__hip_atomic_load(tmo, __ATOMIC_RELAXED, __HIP_MEMORY_SCOPE_AGENT)) != 0u) break;
                if (__builtin_amdgcn_s_memrealtime() - t0 > 2000000ull) {
                    if (threadIdx.x == 0) { unsigned expect = 0u; __hip_atomic_compare_exchange_strong(tmo + 1, &expect, 0x600u | (unsigned)(u.pm & 0xff), __ATOMIC_RELAXED, __ATOMIC_RELAXED, __HIP_MEMORY_SCOPE_AGENT); __hip_atomic_store(tmo, 1u, __ATOMIC_RELAXED, __HIP_MEMORY_SCOPE_AGENT); }
                    break; }
                __builtin_amdgcn_s_sleep(2); }
            __builtin_amdgcn_fence(__ATOMIC_ACQUIRE, "agent");
            asm volatile("s_waitcnt vmcnt(0)" ::: "memory");
        }
#if !defined(BROKEN_HOOK_NO_BARRIER)
        asm volatile("" ::: "memory"); __builtin_amdgcn_s_barrier(); asm volatile("" ::: "memory");
#endif
    }
};

__device__ __forceinline__ unsigned cvt_pk_bf16(float lo, float hi) { unsigned r; asm volatile("v_cvt_pk_bf16_f32 %0, %1, %2" : "=v"(r) : "v"(lo), "v"(hi)); return r; }
typedef float f32x2 __attribute__((ext_vector_type(2)));
__device__ __forceinline__ f32x2 gelu_pk(f32x2 v) {
    const f32x2 av = __builtin_elementwise_abs(v), d = av * 0.2316418882f + 1.0f;
    f32x2 t; t.x = __builtin_amdgcn_rcpf(d.x); t.y = __builtin_amdgcn_rcpf(d.y);
    f32x2 q = t * 0.5307027145f + (-0.7265760135f); q = q * t + 0.7107068705f; q = q * t + (-0.142248368f); q = q * t + 0.127414796f; q = q * t;
    const f32x2 s = (v * v) * (-0.72134752044f);
    f32x2 e; e.x = __builtin_amdgcn_exp2f(s.x); e.y = __builtin_amdgcn_exp2f(s.y);
    const f32x2 m = v * (q * e), r = v - m;
    f32x2 o; o.x = v.x < 0.f ? m.x : r.x; o.y = v.y < 0.f ? m.y : r.y; return o;
}

struct EpiF32 {
    static constexpr bool PERM = false, AFTER_DRAIN = false;
    float* C; int ldc; const float* bias;
    __device__ __forceinline__ void operator()(const f32x4 (&acc)[2][2][4][2], const Unit& u, int wr, int wc, int fr, int fq) const {
        const int row0 = u.pm * BM + wr * 64 + fr, col0 = u.pn * BM + wc * 32 + 4 * fq;
        f32x4 bv[2][2];
#pragma unroll
        for (int bj = 0; bj < 2; ++bj)
#pragma unroll
            for (int n = 0; n < 2; ++n) bv[bj][n] = bias ? *(const f32x4*)(bias + col0 + bj * HALF + n * 16) : (f32x4){0.f, 0.f, 0.f, 0.f};
#pragma unroll
        for (int ai = 0; ai < 2; ++ai)
#pragma unroll
            for (int m = 0; m < 4; ++m) { float* rowp = C + (size_t)(row0 + ai * HALF + m * 16) * ldc + col0;
#pragma unroll
                for (int bj = 0; bj < 2; ++bj)
#pragma unroll
                    for (int n = 0; n < 2; ++n) *(f32x4*)(rowp + bj * HALF + n * 16) = acc[ai][bj][m][n] + bv[bj][n]; }
    }
};
template <class Epi, class Sched, bool STAMP = false>
__device__ __forceinline__ void gemm_phase(PG8_LAS unsigned char* lds, const Gemm g, const Sched& S, const Epi& E, unsigned long long* stamps) {
    int tid_ = threadIdx.x; asm volatile("" : "+v"(tid_));
    const int tid = tid_, wid = __builtin_amdgcn_readfirstlane(tid >> 6), lane = tid & 63, wr = wid >> 2, wc = wid & 3, fr = lane & 15, fq = lane >> 4;
    const int K = g.K, nt = K / BK;
    int ts_lo = 0, ts_hi = 0, nts = 0; const unsigned long long rt_entry = STAMP ? (unsigned long long)wall_clock64() : 0ull;
#define PG8_STAMP() do { if (STAMP && wid == 0 && nts < 64) { const unsigned long long _c = (unsigned long long)clock64(); \
        ts_lo = (lane == nts) ? (int)(unsigned)_c : ts_lo; ts_hi = (lane == nts) ? (int)(unsigned)(_c >> 32) : ts_hi; ++nts; } } while (0)
    PG8_STAMP();
    unsigned voffA[2], voffB[2];
#pragma unroll
    for (int i = 0; i < 2; ++i) { int R, C; stage_rc(tid * 16 + i * 8192, R, C); const int Rb = Epi::PERM ? ((R & ~31) + perm32(R & 31)) : R;
        voffA[i] = (unsigned)(R * K + C) * 2u; voffB[i] = (unsigned)(Rb * K + C) * 2u; }
    const size_t kstep = (size_t)(BK * 2);
    const size_t hstep = (size_t)HALF * K * 2;
    const size_t tstep = 2 * hstep;
    const unsigned ldsw = (unsigned)wid * 1024u;
    const int aoff = lds_byte(wr * 64 + fr, fq * 8), boff = lds_byte(wc * 32 + fr, fq * 8);
#define PG8_SA(b, h) (((b) * 2 + (h)) * HTB)
#define PG8_SB(b, h) ((4 + (b) * 2 + (h)) * HTB)
#define PG8_STAGE(bufoff, gbase, voff) do { _Pragma("unroll") for (int _i = 0; _i < 2; ++_i) \
        __builtin_amdgcn_global_load_lds((const unsigned*)((const char*)(gbase) + (voff)[_i]), (PG8_LAS unsigned*)(lds + (bufoff) + ldsw + _i * 8192), 16, 0, 0); } while (0)
#define PG8_LDA(dst, b, h) do { _Pragma("unroll") for (int m = 0; m < 4; ++m) _Pragma("unroll") for (int k = 0; k < 2; ++k) dst[m][k] = *(const PG8_LAS bf16x8*)(lds + PG8_SA(b, h) + aoff + m * 2048 + k * 1024); } while (0)
#define PG8_LDB(dst, b, h) do { _Pragma("unroll") for (int n = 0; n < 2; ++n) _Pragma("unroll") for (int k = 0; k < 2; ++k) dst[n][k] = *(const PG8_LAS bf16x8*)(lds + PG8_SB(b, h) + boff + n * 2048 + k * 1024); } while (0)
#define PG8_MMA(ai, bj, At, Bt) do { __builtin_amdgcn_s_setprio(1); _Pragma("unroll") for (int m = 0; m < 4; ++m) _Pragma("unroll") for (int n = 0; n < 2; ++n) _Pragma("unroll") for (int k = 0; k < 2; ++k) \
        acc[ai][bj][m][n] = __builtin_amdgcn_mfma_f32_16x16x32_bf16(Bt[n][k], At[m][k], acc[ai][bj][m][n], 0, 0, 0); __builtin_amdgcn_s_setprio(0); } while (0)
#define PG8_WAIT_V(n) asm volatile("s_waitcnt vmcnt(" #n ")" ::: "memory")
#define PG8_WAIT_L(n) asm volatile("s_waitcnt lgkmcnt(" #n ")" ::: "memory")
#define PG8_BAR __builtin_amdgcn_s_barrier()
#define PG8_SCHED __builtin_amdgcn_sched_barrier(0)
    Unit cur, nxt; int ui = 0;
    if (!S.next(0, cur)) return;
    f32x4 acc[2][2][4][2];
#pragma unroll
    for (int a = 0; a < 2; ++a)
#pragma unroll
        for (int b = 0; b < 2; ++b)
#pragma unroll
            for (int m = 0; m < 4; ++m)
#pragma unroll
                for (int n = 0; n < 2; ++n) acc[a][b][m][n] = (f32x4){0.f, 0.f, 0.f, 0.f};
    bf16x8 At[4][2], B0[2][2], B1[2][2];
    const char* cA = (const char*)g.A + (size_t)cur.pm * tstep; const char* cB = (const char*)g.Bt + (size_t)cur.pn * tstep;
    S.a_ready(cur);
    PG8_STAGE(PG8_SB(0, 0), cB, voffB); PG8_STAGE(PG8_SA(0, 0), cA, voffA); PG8_STAGE(PG8_SB(0, 1), cB + hstep, voffB); PG8_STAGE(PG8_SA(0, 1), cA + hstep, voffA);
    if (wr == 1) PG8_BAR;
    PG8_WAIT_V(4); PG8_BAR;
    PG8_STAGE(PG8_SB(1, 0), cB + kstep, voffB); PG8_STAGE(PG8_SA(1, 0), cA + kstep, voffA); PG8_STAGE(PG8_SB(1, 1), cB + hstep + kstep, voffB);
    PG8_WAIT_V(6); PG8_BAR;
    PG8_STAMP();
    for (;;) {
        const bool has_next = S.next(ui + 1, nxt);
        const char* nA = has_next ? (const char*)g.A + (size_t)nxt.pm * tstep : cA; const char* nB = has_next ? (const char*)g.Bt + (size_t)nxt.pn * tstep : cB;
        for (int t = 0; t < nt; t += 2) {
            const bool last = (t == nt - 2);
            const char* a1 = cA + (size_t)(t + 1) * kstep;
            const char* a2 = last ? nA : cA + (size_t)(t + 2) * kstep; const char* b2 = last ? nB : cB + (size_t)(t + 2) * kstep;
            const char* a3 = a2 + kstep; const char* b3 = b2 + kstep;
            if (last && has_next) S.a_ready(nxt);
            PG8_LDB(B0, 0, 0); PG8_SCHED; PG8_LDA(At, 0, 0); PG8_STAGE(PG8_SA(1, 1), a1 + hstep, voffA);
            PG8_WAIT_L(8); PG8_BAR; PG8_WAIT_L(0); PG8_MMA(0, 0, At, B0); PG8_BAR; PG8_SCHED;
            PG8_LDB(B1, 0, 1); PG8_STAGE(PG8_SB(0, 0), b2, voffB);
            PG8_BAR; PG8_WAIT_L(0); PG8_MMA(0, 1, At, B1); PG8_BAR;
            PG8_LDA(At, 0, 1); PG8_STAGE(PG8_SA(0, 0), a2, voffA);
            PG8_BAR; PG8_WAIT_L(0); PG8_MMA(1, 0, At, B0); PG8_BAR; PG8_SCHED;
            PG8_STAGE(PG8_SB(0, 1), b2 + hstep, voffB);
            PG8_WAIT_V(6); PG8_BAR; PG8_MMA(1, 1, At, B1); PG8_BAR;
            PG8_LDB(B0, 1, 0); PG8_SCHED; PG8_LDA(At, 1, 0); PG8_STAGE(PG8_SA(0, 1), a2 + hstep, voffA);
            PG8_WAIT_L(8); PG8_BAR; PG8_WAIT_L(0); PG8_MMA(0, 0, At, B0); PG8_BAR; PG8_SCHED;
            PG8_LDB(B1, 1, 1); PG8_STAGE(PG8_SB(1, 0), b3, voffB);
            PG8_BAR; PG8_WAIT_L(0); PG8_MMA(0, 1, At, B1); PG8_BAR;
            PG8_LDA(At, 1, 1); PG8_STAGE(PG8_SA(1, 0), a3, voffA);
            PG8_BAR; PG8_WAIT_L(0); PG8_MMA(1, 0, At, B0); PG8_BAR; PG8_SCHED;
            PG8_STAGE(PG8_SB(1, 1), b3 + hstep, voffB);
            PG8_WAIT_V(6); PG8_BAR; PG8_MMA(1, 1, At, B1); PG8_BAR;
        }
        PG8_STAMP();
        if constexpr (!Epi::AFTER_DRAIN) { E(acc, cur, wr, wc, fr, fq); S.done(cur); }
        PG8_STAMP();
        if (!has_next) break;
#pragma unroll
        for (int a = 0; a < 2; ++a)
#pragma unroll
            for (int b = 0; b < 2; ++b)
#pragma unroll
                for (int m = 0; m < 4; ++m)
#pragma unroll
                    for (int n = 0; n < 2; ++n) acc[a][b][m][n] = (f32x4){0.f, 0.f, 0.f, 0.f};
        cur = nxt; cA = nA; cB = nB; ++ui;
    }
    PG8_WAIT_V(0);
    if (wr == 0) PG8_BAR;
    PG8_BAR;
    if constexpr (Epi::AFTER_DRAIN) { E.fused(acc, cur, wr, wc, fr, fq, lds, wid, lane); S.done(cur); }
    PG8_STAMP();
    if (STAMP && wid == 0) { stamps[lane] = lane < nts ? (((unsigned long long)(unsigned)ts_hi << 32) | (unsigned)ts_lo) : 0ull;
        if (lane == 62) stamps[62] = rt_entry; if (lane == 63) stamps[63] = (unsigned long long)wall_clock64(); }
#undef PG8_STAMP
#undef PG8_SA
#undef PG8_SB
#undef PG8_STAGE
#undef PG8_LDA
#undef PG8_LDB
#undef PG8_MMA
#undef PG8_WAIT_V
#undef PG8_WAIT_L
#undef PG8_BAR
#undef PG8_SCHED
}
}

#define XB_TMO      128
#define XB_XCNT(j)  (256  + 64 * (j))
#define XB_XSUB(j)  (1280 + 64 * (j))
#define XB_XGEN(j)  (2304 + 64 * (j))
#define XB_TOP      3328
#define XB_TOPGEN   3392
#define XCD_BAR_WORDS 3456
#define XB_SPIN_CAP (1u << 18)
#define LAS __attribute__((address_space(3)))

__device__ __forceinline__ unsigned xb_ld(unsigned* p)              { return __hip_atomic_load(p, __ATOMIC_RELAXED, __HIP_MEMORY_SCOPE_AGENT); }
__device__ __forceinline__ unsigned xb_add(unsigned* p, unsigned v) { return __hip_atomic_fetch_add(p, v, __ATOMIC_RELAXED, __HIP_MEMORY_SCOPE_AGENT); }
__device__ __forceinline__ unsigned xb_xcc_id() { return (unsigned)__builtin_amdgcn_s_getreg((3 << 11) | 20) & 0xFu; }
#define XB_SPIN(cond, bar) do { unsigned _sp = 0; while (cond) { __builtin_amdgcn_s_sleep(1); \
    if ((++_sp & 255u) == 0u) { if (xb_ld(&(bar)[XB_TMO])) break; if (_sp > XB_SPIN_CAP) { atomicAdd(&(bar)[XB_TMO], 1u); break; } } } } while (0)

struct XcdBarrier {
    unsigned* bar; unsigned x;
    volatile LAS unsigned* st;
};

__device__ __forceinline__ XcdBarrier xcd_barrier_post(unsigned* bar, volatile LAS unsigned* st) {
    XcdBarrier b; b.bar = bar; b.x = xb_xcc_id(); b.st = st;
    if (threadIdx.x == 0) (void)xb_add(&bar[XB_XCNT(b.x)], 1u);
    return b;
}
__device__ __forceinline__ void xcd_barrier_complete(unsigned* bar, unsigned x, unsigned& nloc, unsigned& nx) {
    const unsigned G = gridDim.x * gridDim.y * gridDim.z;
    unsigned sum, cnt, mine, sp = 0u;
    for (;;) {
        sum = 0u; cnt = 0u; mine = 0u;
#pragma unroll
        for (unsigned j = 0; j < 16; ++j) { const unsigned c = xb_ld(&bar[XB_XCNT(j)]); sum += c; cnt += (c > 0u) ? 1u : 0u; mine = (j == x) ? c : mine; }
        if (sum == G) break;
        __builtin_amdgcn_s_sleep(1);
        if ((++sp & 255u) == 0u) { if (xb_ld(&bar[XB_TMO])) break; if (sp > XB_SPIN_CAP) { atomicAdd(&bar[XB_TMO], 1u); break; } }
    }
    nloc = mine > 0u ? mine : 1u; nx = cnt > 0u ? cnt : 1u;
}

__device__ __forceinline__ void xcd_barrier(const XcdBarrier& b) {
    asm volatile("s_waitcnt vmcnt(0)" ::: "memory");
    __syncthreads();
    if (threadIdx.x == 0) {
        unsigned* bar = b.bar;
        __builtin_amdgcn_s_waitcnt(0);
        unsigned nloc = b.st[0], nx = b.st[1];
        if (nloc == 0u) { xcd_barrier_complete(bar, b.x, nloc, nx); b.st[0] = nloc; b.st[1] = nx; }
        const unsigned old = xb_add(&bar[XB_XSUB(b.x)], 1u);
        const unsigned gen = old / nloc;
        if (old + 1u == (gen + 1u) * nloc) {
            __builtin_amdgcn_fence(__ATOMIC_RELEASE, "agent");
            asm volatile("s_waitcnt vmcnt(0)" ::: "memory");
            const unsigned og = xb_add(&bar[XB_TOP], 1u);
            const unsigned tg = og / nx;
            if (og + 1u == (tg + 1u) * nx) xb_add(&bar[XB_TOPGEN], 1u);
            else XB_SPIN(xb_ld(&bar[XB_TOPGEN]) == tg, bar);
            __builtin_amdgcn_fence(__ATOMIC_ACQUIRE, "agent");
            xb_add(&bar[XB_XGEN(b.x)], 1u);
            asm volatile("s_waitcnt vmcnt(0)" ::: "memory");
        } else {
            XB_SPIN(xb_ld(&bar[XB_XGEN(b.x)]) == gen, bar);
            __builtin_amdgcn_fence(__ATOMIC_ACQUIRE, "agent");
            asm volatile("s_waitcnt vmcnt(0)" ::: "memory");
        }
    }
    __syncthreads();
}

typedef unsigned short u16;
typedef short bf16x8 __attribute__((ext_vector_type(8)));
typedef short s16x4 __attribute__((ext_vector_type(4)));
typedef float f32x16 __attribute__((ext_vector_type(16)));
typedef float f32x4 __attribute__((ext_vector_type(4)));
typedef unsigned u32x4 __attribute__((ext_vector_type(4)));
typedef unsigned u32x2 __attribute__((ext_vector_type(2)));

constexpr int NROWS = 17408, NPROW = 16384, DM = 1024, NIN = 4224, NINP = 4352, SEQ = 4096;
constexpr int RWC = 2176;
constexpr size_t OUT_Y = 0, OUT_KP = 17825792, OUT_VP = 26214400, OUT_WKVP = 34603008, OUT_SHP = 34734080,
                 OUT_KS = 34742784, OUT_VS = 35267072, OUT_WKVS = 35791360, OUT_SHS = 39985664;
constexpr size_t WS_BAR = 0;
constexpr size_t WS_XB = 32768;
constexpr size_t WS_WINT = WS_XB + (size_t)NROWS * DM * 2;
constexpr size_t WS_WOUTT = WS_WINT + (size_t)NINP * DM * 2;
constexpr size_t WS_P = WS_WOUTT + (size_t)DM * DM * 2;
constexpr size_t WS_QB = WS_P + (size_t)NROWS * NINP * 4;
constexpr size_t WS_KB = WS_QB + (size_t)NROWS * 512 * 2;
constexpr size_t WS_VB = WS_KB + (size_t)NROWS * 512 * 2;
constexpr size_t WS_SR = WS_VB + (size_t)NROWS * 512 * 2;
constexpr size_t SARR = (size_t)NROWS * 512 * 4;
constexpr size_t WS_SW = WS_SR + SARR, WS_SK = WS_SW + SARR, WS_SV = WS_SK + SARR, WS_SA = WS_SV + SARR, WS_SB = WS_SA + SARR, WS_SG = WS_SB + SARR, WS_S2 = WS_SG + SARR;
constexpr size_t WS_O = WS_S2 + SARR;
constexpr size_t WS_PM = WS_O + (size_t)NROWS * DM * 2;
constexpr size_t WS_QM = WS_PM + (size_t)2048 * 4096 * 2;
constexpr size_t WS_WH = WS_QM + (size_t)2048 * 4096 * 4;
constexpr size_t WS_Y0 = WS_WH + (size_t)2048 * 4096 * 2;
constexpr size_t WS_SC = WS_Y0 + (size_t)2048 * 4096 * 4;
constexpr size_t WS_WUPT = WS_SC + (size_t)2048 * 4096 * 2;
constexpr size_t WS_AUPT = WS_WUPT + 65536;
constexpr size_t WS_STATS = WS_AUPT + 65536;
constexpr size_t WS_END = WS_STATS + (size_t)68 * 1024 * 4;

struct Params {
    const float* x_prompt; const float* x_sample; const float* cache_k; const float* cache_v; const int* page_table;
    const float* state_wkv; const float* state_shift; const float* norm_in; const float* w_in; const float* sb_bias;
    const float* mu; const float* w0; const float* w_up; const float* a0; const float* a_up; const float* k_k; const float* k_a;
    const float* r_k; const float* ln_w; const float* ln_b; const float* w_out; const float* norm_f;
    float* out; unsigned char* ws;
};

#define LOG2E 1.4426950408889634f
#define MFMA32(a, b, c) __builtin_amdgcn_mfma_f32_32x32x16_bf16(a, b, c, 0, 0, 0)

typedef float f32x2_t __attribute__((ext_vector_type(2)));
typedef __bf16 bf16x2_t __attribute__((ext_vector_type(2)));
__device__ __forceinline__ unsigned cvtpk(float lo, float hi) { const f32x2_t v = {lo, hi}; return __builtin_bit_cast(unsigned, __builtin_convertvector(v, bf16x2_t)); }
__device__ __forceinline__ u16 f2bf(float f) { return (u16)(cvtpk(f, 0.f) & 0xffffu); }
template <int CTRL> __device__ __forceinline__ float dppf(float x) { return __builtin_bit_cast(float, __builtin_amdgcn_update_dpp(0, __builtin_bit_cast(int, x), CTRL, 0xf, 0xf, true)); }
__device__ __forceinline__ float reduce8(float x) { x += dppf<0xB1>(x); x += dppf<0x4E>(x); x += dppf<0x141>(x); return x; }
__device__ __forceinline__ float wave_sum(float x) { x = reduce8(x); x += dppf<0x140>(x); x += __shfl_xor(x, 16); x += __shfl_xor(x, 32); return x; }
__device__ __forceinline__ int otid() { int t = threadIdx.x; asm volatile("" : "+v"(t)); return t; }
__device__ __forceinline__ float frcp(float x) { return __builtin_amdgcn_rcpf(x); }
__device__ __forceinline__ float silu_f(float g) { return g * frcp(1.0f + __expf(-g)); }
__device__ __forceinline__ float softplus_f(float x) { return fmaxf(x, 0.f) + __logf(1.0f + __expf(-fabsf(x))); }

__device__ __forceinline__ void phase_prologue(const Params& p, int bid, int nb, unsigned char* smem) {
    const int tid = otid(), lane = tid & 63, w = tid >> 6;
    u16* Xb = (u16*)(p.ws + WS_XB);
    u16* WupT = (u16*)(p.ws + WS_WUPT); u16* AupT = (u16*)(p.ws + WS_AUPT);
    const int e0 = bid * 512 + tid; float up0 = 0.f;
    if (e0 < 65536) { const int which = e0 >> 15, idx = e0 & 32767, cc = idx >> 6, ii = idx & 63; up0 = (which ? p.a_up : p.w_up)[ii * 512 + cc]; }
    float* tileb = (float*)smem;
    u16* WinT = (u16*)(p.ws + WS_WINT); u16* WoutT = (u16*)(p.ws + WS_WOUTT);
    const int NT1 = (NINP / 64) * 16, NT2 = 16 * 16;
    float tv[8], tn[8]; int buf = 0;
    auto tload = [&](int id) {
        const bool first = id < NT1; const int id2 = first ? id : id - NT1; const int nt = id2 / 16, kt = id2 % 16, n0 = nt * 64, k0 = kt * 64;
#pragma unroll
        for (int j = 0; j < 8; ++j) { const int e = tid + 512 * j, kr = e >> 6, nc = e & 63;
            if (first) { tv[j] = (n0 + nc < NIN) ? p.w_in[(size_t)(k0 + kr) * NIN + n0 + nc] : 0.f; tn[j] = p.norm_in[k0 + kr]; }
            else { tv[j] = p.w_out[(size_t)(k0 + kr) * DM + n0 + nc]; tn[j] = 1.0f; } } };
    if (bid < NT1) tload(bid);
    constexpr int NR = 5;
    for (int row = bid * 8 + w; row < NROWS; row += nb * 8 * NR) {
        f32x4 v[NR][4];
#pragma unroll
        for (int k = 0; k < NR; ++k) { const int rk = row + k * nb * 8;
            if (rk < NROWS) { const float* src = rk < NPROW ? p.x_prompt + (size_t)rk * DM : p.x_sample + (size_t)(rk - NPROW) * DM;
#pragma unroll
                for (int i = 0; i < 4; ++i) v[k][i] = *(const f32x4*)(src + lane * 4 + i * 256); }
            else {
#pragma unroll
                for (int i = 0; i < 4; ++i) { const f32x4 z = {0.f, 0.f, 0.f, 0.f}; v[k][i] = z; } } }
#pragma unroll
        for (int k = 0; k < NR; ++k) { const int rk = row + k * nb * 8;
            float ss = 0.f;
#pragma unroll
            for (int i = 0; i < 4; ++i) ss += v[k][i][0] * v[k][i][0] + v[k][i][1] * v[k][i][1] + v[k][i][2] * v[k][i][2] + v[k][i][3] * v[k][i][3];
            ss = wave_sum(ss);
            const float rs = rsqrtf(ss * (1.0f / 1024.0f) + 1e-6f);
            if (rk < NROWS) {
#pragma unroll
                for (int i = 0; i < 4; ++i) { u32x2 o; o.x = cvtpk(v[k][i][0] * rs, v[k][i][1] * rs); o.y = cvtpk(v[k][i][2] * rs, v[k][i][3] * rs); *(u32x2*)(Xb + (size_t)rk * DM + lane * 4 + i * 256) = o; } } }
    }
    if (e0 < 65536) { const int which = e0 >> 15, idx = e0 & 32767, cc = idx >> 6, ii = idx & 63; (which ? AupT : WupT)[cc * 64 + ii] = f2bf(up0); }
    for (int e = e0 + nb * 512; e < 65536; e += nb * 512) { const int which = e >> 15, idx = e & 32767, cc = idx >> 6, ii = idx & 63;
        const float val = (which ? p.a_up : p.w_up)[ii * 512 + cc]; (which ? AupT : WupT)[cc * 64 + ii] = f2bf(val); }
    for (int id = bid; id < NT1; id += nb) {
        const bool first = id < NT1; const int id2 = first ? id : id - NT1; const int nt = id2 / 16, kt = id2 % 16, n0 = nt * 64, k0 = kt * 64;
        float* tile = tileb + buf * (64 * 65);
#pragma unroll
        for (int j = 0; j < 8; ++j) { const int e = tid + 512 * j; tile[(e >> 6) * 65 + (e & 63)] = tv[j] * tn[j]; }
        __syncthreads();
        if (id + nb < NT1) tload(id + nb);
        u16* dst = first ? WinT : WoutT;
#pragma unroll
        for (int j = 0; j < 4; ++j) { const int e = tid + 512 * j, nr = e >> 5, kc = (e & 31) * 2; *(unsigned*)(dst + (size_t)(n0 + nr) * DM + k0 + kc) = cvtpk(tile[kc * 65 + nr], tile[(kc + 1) * 65 + nr]); }
        buf ^= 1;
    }
    __syncthreads();
}

__device__ __forceinline__ void phase_wout_tiles(const Params& p, int idx, int stride, unsigned char* smem) {
    const int tid = otid();
    float* tileb = (float*)smem;
    u16* WoutT = (u16*)(p.ws + WS_WOUTT);
    float tv[8]; int buf = 0;
    auto tload = [&](int id) { const int nt = id / 16, kt = id % 16, n0 = nt * 64, k0 = kt * 64;
#pragma unroll
        for (int j = 0; j < 8; ++j) { const int e = tid + 512 * j, kr = e >> 6, nc = e & 63; tv[j] = p.w_out[(size_t)(k0 + kr) * DM + n0 + nc]; } };
    if (idx < 256) tload(idx);
    __syncthreads();
    for (int id = idx; id < 256; id += stride) {
        const int nt = id / 16, kt = id % 16, n0 = nt * 64, k0 = kt * 64;
        float* tile = tileb + buf * (64 * 65);
#pragma unroll
        for (int j = 0; j < 8; ++j) { const int e = tid + 512 * j; tile[(e >> 6) * 65 + (e & 63)] = tv[j]; }
        __syncthreads();
        if (id + stride < 256) tload(id + stride);
#pragma unroll
        for (int j = 0; j < 4; ++j) { const int e = tid + 512 * j, nr = e >> 5, kc = (e & 31) * 2; *(unsigned*)(WoutT + (size_t)(n0 + nr) * DM + k0 + kc) = cvtpk(tile[kc * 65 + nr], tile[(kc + 1) * 65 + nr]); }
        buf ^= 1;
    }
    __syncthreads();
}

constexpr int PREP_TW = 0, PREP_TA = 32 * 144, PREP_LW = 2 * 32 * 144, PREP_LP = 516, PREP_LA = PREP_LW + 32 * PREP_LP * 4, PREP_END = PREP_LA + 32 * PREP_LP * 4;
struct PrepRow { float xr, xk, xv, xg; };
__device__ __forceinline__ void prep_load(PrepRow& o, const float* prow, int c) { o.xr = prow[2048 + c]; o.xk = prow[2560 + c]; o.xv = prow[3072 + c]; o.xg = prow[3584 + c]; }
__device__ __forceinline__ void phase_prep_unit(const Params& p, int u, unsigned char* smem) {
    const int c = otid(), lane = c & 63, r32 = lane & 31, hi = lane >> 5; const int w = __builtin_amdgcn_readfirstlane(c >> 6);
    const float* P = (const float*)(p.ws + WS_P);
    u16* Qb = (u16*)(p.ws + WS_QB); u16* Kb = (u16*)(p.ws + WS_KB); u16* Vb = (u16*)(p.ws + WS_VB);
    float* SR = (float*)(p.ws + WS_SR); float* SW = (float*)(p.ws + WS_SW); float* SK = (float*)(p.ws + WS_SK); float* SV = (float*)(p.ws + WS_SV);
    float* SA = (float*)(p.ws + WS_SA); float* SBb = (float*)(p.ws + WS_SB); float* SG = (float*)(p.ws + WS_SG); float* S2 = (float*)(p.ws + WS_S2);
    const bool prompt = u < 512; const int bd = u - 512;
    const int t0 = prompt ? (u & 127) * 32 : 0, n = prompt ? 32 : 8;
    const int row0 = prompt ? (u >> 7) * SEQ + t0 : NPROW + bd * 8;
    const bool has_prev_row = prompt && t0 > 0;
    {
        const int j = c & 127, tq = c >> 7, tb = tq * 8;
        if (tb < n) {
            const float mul = p.mu[2048 + j];
            float raw[8], prev;
#pragma unroll
            for (int k = 0; k < 8; ++k) raw[k] = P[(size_t)(row0 + tb + k) * NINP + 4096 + j];
            if (tb > 0 || has_prev_row) prev = P[(size_t)(row0 + tb - 1) * NINP + 4096 + j];
            else prev = prompt ? 0.f : p.state_shift[(size_t)bd * RWC + 2048 + j];
#pragma unroll
            for (int k = 0; k < 8; ++k) { const float zl = raw[k] + (prev - raw[k]) * mul; prev = raw[k];
                float val = zl; if (j < 64) { const float e2 = __expf(2.0f * zl); val = 1.0f - 2.0f / (e2 + 1.0f); }
                *(u16*)(smem + (j < 64 ? PREP_TW : PREP_TA) + (tb + k) * 144 + (j & 63) * 2) = f2bf(val); }
        }
    }
    __syncthreads();
    {
        const u16* WupT = (const u16*)(p.ws + WS_WUPT); const u16* AupT = (const u16*)(p.ws + WS_AUPT);
        float* LW = (float*)(smem + PREP_LW); float* LA = (float*)(smem + PREP_LA);
#pragma unroll
        for (int mt = 0; mt < 2; ++mt) {
            const int crow0 = (2 * w + mt) * 32;
            f32x16 accw, acca;
#pragma unroll
            for (int r = 0; r < 16; ++r) { accw[r] = 0.f; acca[r] = 0.f; }
#pragma unroll
            for (int ks = 0; ks < 4; ++ks) {
                const bf16x8 wa = *(const bf16x8*)(WupT + (crow0 + r32) * 64 + ks * 16 + hi * 8), aa = *(const bf16x8*)(AupT + (crow0 + r32) * 64 + ks * 16 + hi * 8);
                const bf16x8 tw = *(const bf16x8*)(smem + PREP_TW + r32 * 144 + ks * 32 + hi * 16), ta = *(const bf16x8*)(smem + PREP_TA + r32 * 144 + ks * 32 + hi * 16);
                accw = MFMA32(wa, tw, accw); acca = MFMA32(aa, ta, acca);
            }
#pragma unroll
            for (int g4 = 0; g4 < 4; ++g4) { const int cc = crow0 + 8 * g4 + 4 * hi;
                const f32x4 v1 = {accw[4 * g4], accw[4 * g4 + 1], accw[4 * g4 + 2], accw[4 * g4 + 3]}, v2 = {acca[4 * g4], acca[4 * g4 + 1], acca[4 * g4 + 2], acca[4 * g4 + 3]};
                *(f32x4*)(LW + r32 * PREP_LP + cc) = v1; *(f32x4*)(LA + r32 * PREP_LP + cc) = v2; }
        }
    }
    __syncthreads();
    {
        const float* LW = (const float*)(smem + PREP_LW); const float* LA = (const float*)(smem + PREP_LA);
        const float mu_r = p.mu[c], mu_k = p.mu[512 + c], mu_v = p.mu[1024 + c], mu_g = p.mu[1536 + c];
        const float w0c = p.w0[c], a0c = p.a0[c], kkc = p.k_k[c], kac = p.k_a[c], lnwc = p.ln_w[c], lnbc = p.ln_b[c], rkc = p.r_k[c];
        float pr, pk, pv, pg;
        if (has_prev_row) { const float* q = P + (size_t)(row0 - 1) * NINP + 2048; pr = q[c]; pk = q[512 + c]; pv = q[1024 + c]; pg = q[1536 + c]; }
        else if (prompt) { pr = pk = pv = pg = 0.f; }
        else { const float* q = p.state_shift + (size_t)bd * RWC; pr = q[c]; pk = q[512 + c]; pv = q[1024 + c]; pg = q[1536 + c]; }
        PrepRow cur[4], nxt[4];
#pragma unroll
        for (int e = 0; e < 4; ++e) { prep_load(cur[e], P + (size_t)(row0 + e) * NINP, c); nxt[e] = cur[e]; }
        for (int tg = 0; tg < n; tg += 4) {
            if (tg + 4 < n) {
#pragma unroll
                for (int e = 0; e < 4; ++e) prep_load(nxt[e], P + (size_t)(row0 + tg + 4 + e) * NINP, c); }
#pragma unroll
            for (int e = 0; e < 4; ++e) {
            const int t = tg + e; const int R = row0 + t;
            const float xr = cur[e].xr, xk = cur[e].xk, xv = cur[e].xv, xg = cur[e].xg;
            const float zr = xr + (pr - xr) * mu_r, zk = xk + (pk - xk) * mu_k, zv = xv + (pv - xv) * mu_v, zg = xg + (pg - xg) * mu_g;
            const float lw = LW[t * PREP_LP + c], la = LA[t * PREP_LP + c];
            const float xw = -(w0c + lw);
            const float sp = softplus_f(xw);
            const float decay = __expf(-__expf(-sp - 0.5f));
            const float alr = frcp(1.0f + __expf(-(a0c + la)));
            float kk = zk * kkc; const float ss = wave_sum(kk * kk); kk = kk * __builtin_amdgcn_rsqf(fmaxf(ss, 1e-24f));
            const float keff = zk * (1.0f + (alr - 1.0f) * kac);
            const size_t o = (size_t)R * 512 + c;
            const float bsum = wave_sum(zr * keff * rkc); const float sg = silu_f(zg);
            SR[o] = zr; SW[o] = decay; SK[o] = keff; SV[o] = zv; SA[o] = -kk; SBb[o] = kk * alr; SG[o] = lnwc * sg; S2[o] = (lnbc + bsum * zv) * sg;
            if ((prompt && t0 + t == SEQ - 1) || (!prompt && t == 7)) {
                float* sh = prompt ? p.out + OUT_SHP + (size_t)(R >> 12) * RWC : p.out + OUT_SHS + (size_t)bd * RWC;
                sh[c] = xr; sh[512 + c] = xk; sh[1024 + c] = xv; sh[1536 + c] = xg; if (c < 128) sh[2048 + c] = P[(size_t)R * NINP + 4096 + c]; }
            pr = xr; pk = xk; pv = xv; pg = xg;
            }
#pragma unroll
            for (int e = 0; e < 4; ++e) cur[e] = nxt[e];
        }
    }
    __syncthreads();
}

constexpr int SCH = 32;
constexpr int SARRF = SCH * 64 + 64;
constexpr int SBUFF = 6 * SARRF + SCH * 64;
struct ScanOps { f32x4 r, w, k, a, b; float v0, v1; };
__device__ __forceinline__ float allred16(float x) { x += dppf<0xB1>(x); x += dppf<0x4E>(x); x += dppf<0x124>(x); x += dppf<0x128>(x); return x; }
__device__ __forceinline__ void scan_load(ScanOps& o, const float* L, int t, int cg, int rowp) {
    const float* base = L + t * 64 + cg * 4;
    o.r = *(const f32x4*)(base); o.w = *(const f32x4*)(base + SARRF); o.k = *(const f32x4*)(base + 2 * SARRF);
    o.a = *(const f32x4*)(base + 4 * SARRF); o.b = *(const f32x4*)(base + 5 * SARRF);
    const float* vp = L + 3 * SARRF + t * 64 + rowp; o.v0 = vp[0]; o.v1 = vp[1];
}
__device__ __forceinline__ void scan_step(const ScanOps& o, float (&s0)[4], float (&s1)[4], float* ybuf, int t, int cg, int rowp) {
    float d0 = (s0[0] * o.a[0] + s0[1] * o.a[1]) + (s0[2] * o.a[2] + s0[3] * o.a[3]);
    float d1 = (s1[0] * o.a[0] + s1[1] * o.a[1]) + (s1[2] * o.a[2] + s1[3] * o.a[3]);
    float sw0[4], sw1[4];
#pragma unroll
    for (int e = 0; e < 4; ++e) { sw0[e] = __builtin_fmaf(s0[e], o.w[e], o.v0 * o.k[e]); sw1[e] = __builtin_fmaf(s1[e], o.w[e], o.v1 * o.k[e]); }
    d0 = allred16(d0); d1 = allred16(d1);
#pragma unroll
    for (int e = 0; e < 4; ++e) { s0[e] = __builtin_fmaf(d0, o.b[e], sw0[e]); s1[e] = __builtin_fmaf(d1, o.b[e], sw1[e]); }
    float y0 = (s0[0] * o.r[0] + s0[1] * o.r[1]) + (s0[2] * o.r[2] + s0[3] * o.r[3]);
    float y1 = (s1[0] * o.r[0] + s1[1] * o.r[1]) + (s1[2] * o.r[2] + s1[3] * o.r[3]);
    y0 = allred16(y0); y1 = allred16(y1);
    if (cg == 0) { ybuf[t * 64 + rowp] = y0; ybuf[t * 64 + rowp + 1] = y1; }
}
__device__ __forceinline__ void phase_scan(const Params& p, int bid, int nb, unsigned char* smem, int ulo, int uhi) {
    const int tid = otid(), lane = tid & 63, w = tid >> 6;
    float* LB = (float*)smem;
    const float* SRC[6] = {(const float*)(p.ws + WS_SR), (const float*)(p.ws + WS_SW), (const float*)(p.ws + WS_SK), (const float*)(p.ws + WS_SV), (const float*)(p.ws + WS_SA), (const float*)(p.ws + WS_SB)};
    const float* SG = (const float*)(p.ws + WS_SG); const float* S2 = (const float*)(p.ws + WS_S2);
    u16* O = (u16*)(p.ws + WS_O);
    const int cg = lane & 15, rowp = w * 8 + 2 * (lane >> 4);
    for (int u = ulo + bid; u < uhi; u += nb) {
        int h, row0, T; const float* sin; float* sout;
        if (u < 32) { h = u & 7; row0 = (u >> 3) * SEQ; T = SEQ; sin = nullptr; sout = p.out + OUT_WKVP + (size_t)u * 4096; }
        else { const int idx = u - 32; h = idx & 7; row0 = NPROW + (idx >> 3) * 8; T = 8; sin = p.state_wkv + (size_t)idx * 4096; sout = p.out + OUT_WKVS + (size_t)idx * 4096; }
        float s0[4], s1[4];
        if (sin) { const f32x4 a = *(const f32x4*)(sin + rowp * 64 + cg * 4), b = *(const f32x4*)(sin + (rowp + 1) * 64 + cg * 4);
#pragma unroll
            for (int e = 0; e < 4; ++e) { s0[e] = a[e]; s1[e] = b[e]; } }
        else {
#pragma unroll
            for (int e = 0; e < 4; ++e) { s0[e] = 0.f; s1[e] = 0.f; } }
        const int CH = T < SCH ? T : SCH, nch = T / CH;
        const int ptok = tid >> 4, pf4 = tid & 15; const bool pact = ptok < CH;
        f32x4 pf[6];
        if (pact) {
#pragma unroll
            for (int j = 0; j < 6; ++j) pf[j] = *(const f32x4*)(SRC[j] + (size_t)(row0 + ptok) * 512 + h * 64 + pf4 * 4); }
        __syncthreads();
        for (int ch = 0; ch < nch; ++ch) {
            float* L = LB + (ch & 1) * SBUFF; float* ybuf = L + 6 * SARRF;
            if (pact) {
#pragma unroll
                for (int j = 0; j < 6; ++j) *(f32x4*)(L + j * SARRF + ptok * 64 + pf4 * 4) = pf[j]; }
            __syncthreads();
            if (pact && ch + 1 < nch) {
#pragma unroll
                for (int j = 0; j < 6; ++j) pf[j] = *(const f32x4*)(SRC[j] + (size_t)(row0 + (ch + 1) * CH + ptok) * 512 + h * 64 + pf4 * 4); }
            ScanOps oa, ob;
            scan_load(oa, L, 0, cg, rowp);
            for (int t = 0; t < CH; t += 2) {
                scan_load(ob, L, t + 1, cg, rowp);
                scan_step(oa, s0, s1, ybuf, t, cg, rowp);
                scan_load(oa, L, t + 2, cg, rowp);
                scan_step(ob, s0, s1, ybuf, t + 1, cg, rowp);
            }
            __syncthreads();
            for (int tt = w; tt < CH; tt += 8) {
                const int R = row0 + ch * CH + tt;
                const float y = ybuf[tt * 64 + lane];
                const float mean = wave_sum(y) * (1.0f / 64.0f); const float dd = y - mean;
                const float var = wave_sum(dd * dd) * (1.0f / 64.0f);
                const size_t og = (size_t)R * 512 + h * 64 + lane;
                const float outv = dd * rsqrtf(var + 64e-5f) * SG[og] + S2[og];
                O[(size_t)R * DM + 512 + h * 64 + lane] = f2bf(outv);
            }
        }
        { f32x4 a = {s0[0], s0[1], s0[2], s0[3]}, b = {s1[0], s1[1], s1[2], s1[3]}; *(f32x4*)(sout + rowp * 64 + cg * 4) = a; *(f32x4*)(sout + (rowp + 1) * 64 + cg * 4) = b; }
    }
}

typedef __attribute__((address_space(3))) const char* lds_cptr;
typedef short v4i16_t __attribute__((ext_vector_type(4)));
__device__ __forceinline__ s16x4 vtr(lds_cptr ptr) { return __builtin_bit_cast(s16x4, __builtin_amdgcn_ds_read_tr16_b64_v4i16((__attribute__((address_space(3))) v4i16_t*)ptr)); }
__device__ __forceinline__ int crow(int r, int hi) { return (r & 3) + 8 * (r >> 2) + 4 * hi; }

__device__ __forceinline__ void sb_sub(f32x16& x, float& carry, int hi) {
    float t[16], g[4];
#pragma unroll
    for (int r = 0; r < 16; ++r) t[r] = __builtin_amdgcn_exp2f(fminf(x[r], 30.0f));
#pragma unroll
    for (int m = 0; m < 4; ++m) { const float F1 = 1.0f + t[4 * m], F2 = __builtin_fmaf(t[4 * m + 1], F1, F1), F3 = __builtin_fmaf(t[4 * m + 2], F2, F2), F4 = __builtin_fmaf(t[4 * m + 3], F3, F3);
        g[m] = __builtin_amdgcn_rcpf(F4); t[4 * m + 1] = F2 - F1; t[4 * m + 2] = F3 - F2; t[4 * m + 3] = F4 - F3; }
    float cm[4];
#pragma unroll
    for (int m = 0; m < 4; ++m) { auto rr = __builtin_amdgcn_permlane32_swap(__float_as_uint(g[m]), __float_as_uint(g[m]), false, false);
        cm[m] = __uint_as_float(rr[0]) * __uint_as_float(rr[1]); }
    float D[5]; D[4] = carry; D[3] = cm[3] * D[4]; D[2] = cm[2] * D[3]; D[1] = cm[1] * D[2]; D[0] = cm[0] * D[1]; carry = D[0];
#pragma unroll
    for (int m = 0; m < 4; ++m) { const float gH = g[m] * D[m + 1]; const float gL = hi ? gH : D[m];
#pragma unroll
        for (int i = 0; i < 4; ++i) x[4 * m + i] = t[4 * m + i] * gL; }
}

__device__ __forceinline__ void sb_tile(lds_cptr ldsK, lds_cptr ldsV, const bf16x8 (&qr)[4], float bias2, int qrel, int lane, float& carry, f32x16 (&o)[2]) {
    const int r32 = lane & 31, hi = lane >> 5;
    const lds_cptr kp0 = ldsK + hi * 1024 + r32 * 16;
    bf16x8 kf[8];
#pragma unroll
    for (int d0 = 0; d0 < 4; ++d0) { kf[2 * d0] = *(const __attribute__((address_space(3))) bf16x8*)(kp0 + d0 * 2048); kf[2 * d0 + 1] = *(const __attribute__((address_space(3))) bf16x8*)(kp0 + d0 * 2048 + 512); }
    f32x16 C0, C1;
#pragma unroll
    for (int r = 0; r < 16; ++r) { C0[r] = bias2; C1[r] = bias2; }
#pragma unroll
    for (int d0 = 0; d0 < 4; ++d0) { C0 = MFMA32(kf[2 * d0], qr[d0], C0); C1 = MFMA32(kf[2 * d0 + 1], qr[d0], C1); }
    if (qrel >= 0) {
#pragma unroll
        for (int r = 0; r < 16; ++r) { const int kv = crow(r, hi); if (kv >= qrel) C0[r] = -INFINITY; if (kv + 32 >= qrel) C1[r] = -INFINITY; }
    }
    sb_sub(C1, carry, hi); sb_sub(C0, carry, hi);
    u32x4 pw[4];
#pragma unroll
    for (int i = 0; i < 4; ++i) { pw[0][i] = cvtpk(C0[2 * i], C0[2 * i + 1]); pw[1][i] = cvtpk(C0[8 + 2 * i], C0[8 + 2 * i + 1]); pw[2][i] = cvtpk(C1[2 * i], C1[2 * i + 1]); pw[3][i] = cvtpk(C1[8 + 2 * i], C1[8 + 2 * i + 1]); }
    const lds_cptr vp0 = ldsV + ((lane >> 4) & 1) * 32 + (lane & 3) * 8 + (4 * hi + ((lane & 15) >> 2)) * 64;
#pragma unroll
    for (int i = 0; i < 8; ++i) {
        const s16x4 lo = vtr(vp0 + ((i >> 2) * 4096 + (i & 3) * 1024)), hi4 = vtr(vp0 + ((i >> 2) * 4096 + (i & 3) * 1024 + 512));
        const bf16x8 vf = {lo[0], lo[1], lo[2], lo[3], hi4[0], hi4[1], hi4[2], hi4[3]};
        o[i >> 2] = MFMA32(__builtin_bit_cast(bf16x8, pw[i & 3]), vf, o[i >> 2]);
    }
}

constexpr int CP = 144;
constexpr int CMAT = 64 * CP;
constexpr int C_AH = 0, C_BH = CMAT, C_KH = 2 * CMAT, C_RH = 3 * CMAT, C_BBT = 4 * CMAT, C_KBT = 5 * CMAT, C_VT = 6 * CMAT,
              C_AAK = 7 * CMAT, C_ARB = 8 * CMAT, C_ARK = 9 * CMAT, C_N = 10 * CMAT;
constexpr int NPITCH = 68;
constexpr int C_RHS = C_N + 64 * NPITCH * 4;
constexpr int RPITCH = 132;
constexpr int C_GT = C_ARK;
constexpr int C_GC = C_RHS + 64 * RPITCH * 4;
constexpr int C_END = C_GC + 256;
constexpr int C_TW = C_END, C_TA = C_TW + CMAT, C_FEND = C_TA + CMAT;
constexpr int C_LWH = C_N, C_LAH = C_AAK;
constexpr int LWP = 68;
constexpr int C_W1T = C_AH, C_U0T = C_BH;

__device__ __forceinline__ void mm_tile(f32x16& acc, const unsigned char* Lp, const unsigned char* Rp, int lane) {
    const int off = (lane & 31) * CP + (lane >> 5) * 16;
#pragma unroll
    for (int ks = 0; ks < 4; ++ks) {
        const bf16x8 af = *(const bf16x8*)(Lp + off + ks * 32), bf = *(const bf16x8*)(Rp + off + ks * 32);
        acc = MFMA32(af, bf, acc);
    }
}
__device__ __forceinline__ u32x2 pack4(float a, float b, float c, float d) { u32x2 o; o.x = cvtpk(a, b); o.y = cvtpk(c, d); return o; }
__device__ __forceinline__ float sum4rows(float x) {
    auto r1 = __builtin_amdgcn_permlane16_swap(__float_as_uint(x), __float_as_uint(x), false, false);
    const float y = __uint_as_float(r1[0]) + __uint_as_float(r1[1]);
    auto r2 = __builtin_amdgcn_permlane32_swap(__float_as_uint(y), __float_as_uint(y), false, false);
    return __uint_as_float(r2[0]) + __uint_as_float(r2[1]);
}

__device__ __forceinline__ void scanc_s1_core(const Params& p, int cid, unsigned char* smem, int lane, int w, const float (&rr)[8], const float (&ww)[8], const float (&kk)[8], const float (&vv)[8], const float (&aa)[8], const float (&bb)[8]) {
    const int r32 = lane & 31, hi = lane >> 5;
    float* gt = (float*)(smem + C_GT); float* gC = (float*)(smem + C_GC); float* RHS = (float*)(smem + C_RHS); float* Np = (float*)(smem + C_N);
    {
        float g[8]; g[0] = ww[0];
#pragma unroll
        for (int j = 1; j < 8; ++j) g[j] = g[j - 1] * ww[j];
        gt[w * 64 + lane] = g[7];
        __syncthreads();
        float pre = 1.0f, tot = 1.0f;
#pragma unroll
        for (int ww2 = 0; ww2 < 8; ++ww2) { const float x = gt[ww2 * 64 + lane]; tot *= x; if (ww2 < w) pre *= x; }
        if (w == 0) gC[lane] = tot;
        u32x4 bbt, kbt, vtt;
        float bbs[8], kbs[8];
#pragma unroll
        for (int j = 0; j < 8; ++j) {
            const int t = 8 * w + j;
            const float gam = pre * g[j], gprev = j == 0 ? pre : pre * g[j - 1], inv = frcp(gam);
            const float ah = aa[j] * gprev, rh = rr[j] * gam, bhv = bb[j] * inv, khv = kk[j] * inv;
            *(u16*)(smem + C_AH + t * CP + lane * 2) = f2bf(ah); *(u16*)(smem + C_RH + t * CP + lane * 2) = f2bf(rh);
            *(u16*)(smem + C_BH + t * CP + lane * 2) = f2bf(bhv); *(u16*)(smem + C_KH + t * CP + lane * 2) = f2bf(khv);
            RHS[t * RPITCH + lane] = ah;
            bbs[j] = bhv * tot; kbs[j] = khv * tot;
        }
        bbt.x = cvtpk(bbs[0], bbs[1]); bbt.y = cvtpk(bbs[2], bbs[3]); bbt.z = cvtpk(bbs[4], bbs[5]); bbt.w = cvtpk(bbs[6], bbs[7]);
        kbt.x = cvtpk(kbs[0], kbs[1]); kbt.y = cvtpk(kbs[2], kbs[3]); kbt.z = cvtpk(kbs[4], kbs[5]); kbt.w = cvtpk(kbs[6], kbs[7]);
        vtt.x = cvtpk(vv[0], vv[1]); vtt.y = cvtpk(vv[2], vv[3]); vtt.z = cvtpk(vv[4], vv[5]); vtt.w = cvtpk(vv[6], vv[7]);
        *(u32x4*)(smem + C_BBT + lane * CP + w * 16) = bbt; *(u32x4*)(smem + C_KBT + lane * CP + w * 16) = kbt; *(u32x4*)(smem + C_VT + lane * CP + w * 16) = vtt;
    }
    __syncthreads();
    {
        const int Lt = w & 1, Rt = (w >> 1) & 1, tb = w >> 2;
        const unsigned char* Lbase = smem + (Lt ? C_KH : C_BH); const unsigned char* Rbase = smem + (Rt ? C_RH : C_AH);
        const int t = tb * 32 + r32;
#pragma unroll
        for (int ia = 0; ia < 2; ++ia) {
            f32x16 acc;
#pragma unroll
            for (int r = 0; r < 16; ++r) acc[r] = 0.f;
            if (!(ia == 1 && tb == 0)) mm_tile(acc, Lbase + ia * 32 * CP, Rbase + tb * 32 * CP, lane);
#pragma unroll
            for (int r = 0; r < 16; ++r) { const int i = ia * 32 + crow(r, hi); const bool keep = Rt ? (i <= t) : (i < t); if (!keep) acc[r] = 0.f; }
            if (Lt == 0 && Rt == 0) {
#pragma unroll
                for (int r = 0; r < 16; ++r) { const int i = ia * 32 + crow(r, hi); Np[t * NPITCH + (i & 3) * 16 + (i >> 2)] = acc[r]; }
            } else {
                unsigned char* dst = smem + (Rt == 0 ? C_AAK : (Lt == 0 ? C_ARB : C_ARK)) + t * CP;
#pragma unroll
                for (int g4 = 0; g4 < 4; ++g4) *(u32x2*)(dst + (ia * 32 + 8 * g4 + 4 * hi) * 2) = pack4(acc[4 * g4], acc[4 * g4 + 1], acc[4 * g4 + 2], acc[4 * g4 + 3]);
            }
        }
    }
    __syncthreads();
    f32x16 accY, accQ;
#pragma unroll
    for (int r = 0; r < 16; ++r) { accY[r] = 0.f; accQ[r] = 0.f; }
    const int w4 = w & 3, ab = w4 & 1, vb = w4 >> 1;
    if (w < 4) {
        f32x16 acc;
#pragma unroll
        for (int r = 0; r < 16; ++r) acc[r] = 0.f;
        mm_tile(acc, smem + C_AAK + ab * 32 * CP, smem + C_VT + vb * 32 * CP, lane);
#pragma unroll
        for (int r = 0; r < 16; ++r) RHS[(ab * 32 + crow(r, hi)) * RPITCH + 64 + vb * 32 + r32] = acc[r];
    } else {
        mm_tile(accY, smem + C_ARK + ab * 32 * CP, smem + C_VT + vb * 32 * CP, lane);
        mm_tile(accQ, smem + C_KBT + ab * 32 * CP, smem + C_VT + vb * 32 * CP, lane);
    }
    __syncthreads();
    {
        const int cl = lane >> 2, q = lane & 3, col = 16 * w + cl;
        float x[16];
#pragma unroll
        for (int j = 0; j < 16; ++j) x[j] = 0.f;
#pragma unroll
        for (int t = 0; t < 64; ++t) {
            float part = 0.f, part2 = 0.f;
            const float* nrow = Np + t * NPITCH + q * 16;
#pragma unroll
            for (int j4 = 0; j4 < (t + 15) / 16; ++j4) {
                const f32x4 nv = *(const f32x4*)(nrow + 4 * j4);
                part = __builtin_fmaf(nv[0], x[4 * j4], part); part2 = __builtin_fmaf(nv[1], x[4 * j4 + 1], part2);
                part = __builtin_fmaf(nv[2], x[4 * j4 + 2], part); part2 = __builtin_fmaf(nv[3], x[4 * j4 + 3], part2);
            }
            float tot = part + part2; tot += dppf<0xB1>(tot); tot += dppf<0x4E>(tot);
            const float xt = RHS[t * RPITCH + col] + tot;
            x[t >> 2] = (q == (t & 3)) ? xt : x[t >> 2];
        }
        unsigned char* dst = smem + (w < 4 ? C_W1T : C_U0T) + ((w & 3) * 16 + cl) * CP;
#pragma unroll
        for (int j = 0; j < 16; ++j) *(u16*)(dst + (4 * j + q) * 2) = f2bf(x[j]);
    }
    __syncthreads();
    if (w < 4) {
        const int xk = w & 1, yk = w >> 1;
        {
            f32x16 acc;
#pragma unroll
            for (int r = 0; r < 16; ++r) acc[r] = 0.f;
            mm_tile(acc, smem + C_W1T + xk * 32 * CP, smem + C_BBT + yk * 32 * CP, lane);
            const int k = yk * 32 + r32; const float gck = gC[k];
            u16* Pm = (u16*)(p.ws + WS_PM) + (size_t)cid * 4096 + k * 64;
#pragma unroll
            for (int g4 = 0; g4 < 4; ++g4) { const int kp = xk * 32 + 8 * g4 + 4 * hi; float v4[4];
#pragma unroll
                for (int e = 0; e < 4; ++e) v4[e] = acc[4 * g4 + e] + ((kp + e) == k ? gck : 0.f);
                *(u32x2*)(Pm + kp) = pack4(v4[0], v4[1], v4[2], v4[3]); }
        }
        {
            f32x16 acc;
#pragma unroll
            for (int r = 0; r < 16; ++r) acc[r] = 0.f;
            mm_tile(acc, smem + C_W1T + xk * 32 * CP, smem + C_ARB + yk * 32 * CP, lane);
            const int t = yk * 32 + r32;
            u16* Wh = (u16*)(p.ws + WS_WH) + (size_t)cid * 4096 + t * 64;
#pragma unroll
            for (int g4 = 0; g4 < 4; ++g4) { const int k0 = xk * 32 + 8 * g4 + 4 * hi; const u32x2 rh = *(const u32x2*)(smem + C_RH + t * CP + k0 * 2);
                const float r0 = __uint_as_float(rh.x << 16), r1 = __uint_as_float(rh.x & 0xffff0000u), r2 = __uint_as_float(rh.y << 16), r3 = __uint_as_float(rh.y & 0xffff0000u);
                *(u32x2*)(Wh + k0) = pack4(acc[4 * g4] + r0, acc[4 * g4 + 1] + r1, acc[4 * g4 + 2] + r2, acc[4 * g4 + 3] + r3); }
        }
    } else {
        mm_tile(accQ, smem + C_BBT + ab * 32 * CP, smem + C_U0T + vb * 32 * CP, lane);
        mm_tile(accY, smem + C_ARB + ab * 32 * CP, smem + C_U0T + vb * 32 * CP, lane);
        const int v = vb * 32 + r32;
        float* Qm = (float*)(p.ws + WS_QM) + (size_t)cid * 4096 + v * 64; u16* Y0 = (u16*)(p.ws + WS_Y0) + (size_t)cid * 4096 + v * 64;
#pragma unroll
        for (int g4 = 0; g4 < 4; ++g4) { const int a0 = ab * 32 + 8 * g4 + 4 * hi;
            const f32x4 qv = {accQ[4 * g4], accQ[4 * g4 + 1], accQ[4 * g4 + 2], accQ[4 * g4 + 3]}, yv = {accY[4 * g4], accY[4 * g4 + 1], accY[4 * g4 + 2], accY[4 * g4 + 3]};
            *(f32x4*)(Qm + a0) = qv; *(u32x2*)(Y0 + a0) = pack4(yv[0], yv[1], yv[2], yv[3]); }
    }
    __syncthreads();
}

__device__ __forceinline__ float wsum64(float x) { return sum4rows(allred16(x)); }
__device__ __forceinline__ void scanc_fused(const Params& p, int item, unsigned char* smem) {
    const int tid = otid(), lane = tid & 63, r32 = lane & 31, hi = lane >> 5; const int w = __builtin_amdgcn_readfirstlane(tid >> 6);
    const int b = item >> 7, c = (item >> 1) & 63, hq = item & 1;
    const size_t row0 = (size_t)b * SEQ + (size_t)c * 64;
    const float* P = (const float*)(p.ws + WS_P);
    unsigned* GP = (unsigned*)(p.ws + WS_SG);
    const int which = w >> 2, tt = w & 1, kt = (w >> 1) & 1;
    const bool zfirst = (c == 0 && w == 0);
    bf16x8 wf[4]; float xr[9], xk[9], xv[9], xg[9], prm[11];
#define FUSED_FETCH(h_) { const int col_ = (h_) * 64 + lane; \
        const u16* WT_ = (const u16*)(p.ws + (which ? WS_AUPT : WS_WUPT)) + (size_t)((h_) * 64 + kt * 32 + r32) * 64; \
        _Pragma("unroll") for (int ks = 0; ks < 4; ++ks) wf[ks] = *(const bf16x8*)(WT_ + ks * 16 + hi * 8); \
        _Pragma("unroll") for (int j = 0; j < 9; ++j) { const bool z = zfirst && j == 0; const float* prow = P + (row0 + 8 * w + j - 1 + (z ? 1 : 0)) * NINP + 2048 + col_; \
            xr[j] = prow[0]; xk[j] = prow[512]; xv[j] = prow[1024]; xg[j] = prow[1536]; } \
        prm[0] = p.mu[col_]; prm[1] = p.mu[512 + col_]; prm[2] = p.mu[1024 + col_]; prm[3] = p.mu[1536 + col_]; prm[4] = p.w0[col_]; prm[5] = p.a0[col_]; prm[6] = p.k_k[col_]; \
        prm[7] = p.k_a[col_]; prm[8] = p.ln_w[col_]; prm[9] = p.ln_b[col_]; prm[10] = p.r_k[col_]; }
    FUSED_FETCH(hq * 4)
    {
        const int j = tid & 127, tb = (tid >> 7) * 16;
        const float mul = p.mu[2048 + j];
        float raw[16], prev;
#pragma unroll
        for (int k = 0; k < 16; ++k) raw[k] = P[(row0 + tb + k) * NINP + 4096 + j];
        prev = (c == 0 && tb == 0) ? 0.f : P[(row0 + tb - 1) * NINP + 4096 + j];
#pragma unroll
        for (int k = 0; k < 16; ++k) { const float zl = raw[k] + (prev - raw[k]) * mul; prev = raw[k];
            float val = zl; if (j < 64) { const float e2 = __expf(2.0f * zl); val = 1.0f - 2.0f / (e2 + 1.0f); }
            *(u16*)(smem + (j < 64 ? C_TW : C_TA) + (tb + k) * CP + (j & 63) * 2) = f2bf(val); }
        if (c == 63 && hq == 0 && tb == 48) p.out[OUT_SHP + (size_t)b * RWC + 2048 + j] = raw[15];
    }
    __syncthreads();
    for (int hh = 0; hh < 4; ++hh) {
        const int h = hq * 4 + hh, col = h * 64 + lane;
        {
            const unsigned char* Tp = smem + (which ? C_TA : C_TW) + (tt * 32 + r32) * CP;
            f32x16 acc;
#pragma unroll
            for (int r = 0; r < 16; ++r) acc[r] = 0.f;
#pragma unroll
            for (int ks = 0; ks < 4; ++ks) { const bf16x8 bf = *(const bf16x8*)(Tp + ks * 32 + hi * 16); acc = MFMA32(wf[ks], bf, acc); }
            float* L = (float*)(smem + (which ? C_LAH : C_LWH)) + (tt * 32 + r32) * LWP + kt * 32;
#pragma unroll
            for (int g4 = 0; g4 < 4; ++g4) { const f32x4 v4 = {acc[4 * g4], acc[4 * g4 + 1], acc[4 * g4 + 2], acc[4 * g4 + 3]}; *(f32x4*)(L + 8 * g4 + 4 * hi) = v4; }
        }
        __syncthreads();
        float rr[8], ww[8], kk[8], vv[8], aa[8], bb[8];
        if (zfirst) { xr[0] = 0.f; xk[0] = 0.f; xv[0] = 0.f; xg[0] = 0.f; }
        {
            const float mu_r = prm[0], mu_k = prm[1], mu_v = prm[2], mu_g = prm[3], w0c = prm[4], a0c = prm[5], kkc = prm[6], kac = prm[7], lnwc = prm[8], lnbc = prm[9], rkc = prm[10];
            const float* LW = (const float*)(smem + C_LWH); const float* LA = (const float*)(smem + C_LAH);
#pragma unroll
            for (int j = 0; j < 8; ++j) {
                const int t = 8 * w + j; const size_t R = row0 + t;
                const float zr = xr[j + 1] + (xr[j] - xr[j + 1]) * mu_r, zk = xk[j + 1] + (xk[j] - xk[j + 1]) * mu_k, zv = xv[j + 1] + (xv[j] - xv[j + 1]) * mu_v, zg = xg[j + 1] + (xg[j] - xg[j + 1]) * mu_g;
                const float lw = LW[t * LWP + lane], la = LA[t * LWP + lane];
                const float decay = __expf(-0.60653066f * frcp(1.0f + __expf(-(w0c + lw))));
                const float alr = frcp(1.0f + __expf(-(a0c + la)));
                float kn = zk * kkc; const float ss = wsum64(kn * kn); kn = kn * __builtin_amdgcn_rsqf(fmaxf(ss, 1e-24f));
                const float keff = zk * (1.0f + (alr - 1.0f) * kac);
                const float bsum = wsum64(zr * keff * rkc); const float sg = silu_f(zg);
                GP[((size_t)(b * 8 + h) * SEQ + (size_t)c * 64 + t) * 64 + lane] = cvtpk(lnwc * sg, (lnbc + bsum * zv) * sg);
                rr[j] = zr; ww[j] = decay; kk[j] = keff; vv[j] = zv; aa[j] = -kn; bb[j] = kn * alr;
            }
            if (c == 63 && w == 7) { float* sh = p.out + OUT_SHP + (size_t)b * RWC; sh[col] = xr[8]; sh[512 + col] = xk[8]; sh[1024 + col] = xv[8]; sh[1536 + col] = xg[8]; }
        }
        if (hh + 1 < 4) FUSED_FETCH(h + 1)
        scanc_s1_core(p, ((b * 8 + h) << 6) + c, smem, lane, w, rr, ww, kk, vv, aa, bb);
    }
#undef FUSED_FETCH
}

__device__ __forceinline__ void scanc_stage2(const Params& p, int bh, unsigned char* smem) {
    const int tid = otid(), lane = tid & 63, r32 = lane & 31, hi = lane >> 5; const int w = __builtin_amdgcn_readfirstlane(tid >> 6);
    const int xk = w & 1, yv = (w >> 1) & 1;
    const int v = yv * 32 + r32;
    unsigned char* Sb = smem;
    __syncthreads();
    if (w < 4) {
#pragma unroll
        for (int g4 = 0; g4 < 4; ++g4) { u32x2 z = {0u, 0u}; *(u32x2*)(Sb + v * CP + (xk * 32 + 8 * g4 + 4 * hi) * 2) = z; }
    }
    const u16* PmB = (const u16*)(p.ws + WS_PM) + (size_t)bh * 64 * 4096; const float* QmB = (const float*)(p.ws + WS_QM) + (size_t)bh * 64 * 4096;
    u16* SC = (u16*)(p.ws + WS_SC) + (size_t)bh * 64 * 4096;
    bf16x8 pf[4]; f32x4 qf[4];
    if (w < 4) {
#pragma unroll
        for (int ks = 0; ks < 4; ++ks) pf[ks] = *(const bf16x8*)(PmB + (xk * 32 + r32) * 64 + ks * 16 + hi * 8);
#pragma unroll
        for (int g4 = 0; g4 < 4; ++g4) qf[g4] = *(const f32x4*)(QmB + v * 64 + xk * 32 + 8 * g4 + 4 * hi);
    }
    f32x16 acc;
#pragma unroll
    for (int r = 0; r < 16; ++r) acc[r] = 0.f;
    __syncthreads();
    for (int c = 0; c < 64; ++c) {
        if (w < 4) {
#pragma unroll
            for (int g4 = 0; g4 < 4; ++g4) { const int k0 = xk * 32 + 8 * g4 + 4 * hi; *(u32x2*)(SC + (size_t)c * 4096 + v * 64 + k0) = *(const u32x2*)(Sb + v * CP + k0 * 2); }
            bf16x8 pc[4];
#pragma unroll
            for (int ks = 0; ks < 4; ++ks) pc[ks] = pf[ks];
#pragma unroll
            for (int g4 = 0; g4 < 4; ++g4) { acc[4 * g4] = qf[g4][0]; acc[4 * g4 + 1] = qf[g4][1]; acc[4 * g4 + 2] = qf[g4][2]; acc[4 * g4 + 3] = qf[g4][3]; }
            if (c + 1 < 64) {
#pragma unroll
                for (int ks = 0; ks < 4; ++ks) pf[ks] = *(const bf16x8*)(PmB + (size_t)(c + 1) * 4096 + (xk * 32 + r32) * 64 + ks * 16 + hi * 8);
#pragma unroll
                for (int g4 = 0; g4 < 4; ++g4) qf[g4] = *(const f32x4*)(QmB + (size_t)(c + 1) * 4096 + v * 64 + xk * 32 + 8 * g4 + 4 * hi);
            }
#pragma unroll
            for (int ks = 0; ks < 4; ++ks) { const bf16x8 sf = *(const bf16x8*)(Sb + v * CP + ks * 32 + hi * 16); acc = MFMA32(pc[ks], sf, acc); }
        }
        __syncthreads();
        if (w < 4) {
#pragma unroll
            for (int g4 = 0; g4 < 4; ++g4) *(u32x2*)(Sb + v * CP + (xk * 32 + 8 * g4 + 4 * hi) * 2) = pack4(acc[4 * g4], acc[4 * g4 + 1], acc[4 * g4 + 2], acc[4 * g4 + 3]);
        }
        __syncthreads();
    }
    if (w < 4) {
        float* so = p.out + OUT_WKVP + (size_t)bh * 4096 + v * 64;
#pragma unroll
        for (int g4 = 0; g4 < 4; ++g4) { const f32x4 o4 = {acc[4 * g4], acc[4 * g4 + 1], acc[4 * g4 + 2], acc[4 * g4 + 3]}; *(f32x4*)(so + xk * 32 + 8 * g4 + 4 * hi) = o4; }
    }
}

struct S3Ops { u32x2 y0[4]; bf16x8 af[4], bf[4]; };
__device__ __forceinline__ void s3_load(S3Ops& o, const Params& p, int item, int gq, int tb, int vb, int r32, int hi) {
    const int cid = item * 2 + gq, v = vb * 32 + r32;
    const u16* Y0 = (const u16*)(p.ws + WS_Y0) + (size_t)cid * 4096 + v * 64;
    const u16* Wh = (const u16*)(p.ws + WS_WH) + (size_t)cid * 4096 + (tb * 32 + r32) * 64;
    const u16* SC = (const u16*)(p.ws + WS_SC) + (size_t)cid * 4096 + v * 64;
#pragma unroll
    for (int g4 = 0; g4 < 4; ++g4) o.y0[g4] = *(const u32x2*)(Y0 + tb * 32 + 8 * g4 + 4 * hi);
#pragma unroll
    for (int ks = 0; ks < 4; ++ks) { o.af[ks] = *(const bf16x8*)(Wh + ks * 16 + hi * 8); o.bf[ks] = *(const bf16x8*)(SC + ks * 16 + hi * 8); }
}
__device__ __forceinline__ void phase_stage3(const Params& p, int bid, int nb, unsigned char* smem, int nitems) {
    const int tid = otid(), lane = tid & 63, r32 = lane & 31, hi = lane >> 5; const int w = __builtin_amdgcn_readfirstlane(tid >> 6);
    const int gq = w >> 2, w4 = w & 3, tb = w4 & 1, vb = w4 >> 1;
    float* Yb = (float*)smem;
    const unsigned* GP = (const unsigned*)(p.ws + WS_SG);
    u16* O = (u16*)(p.ws + WS_O);
    S3Ops cur;
    if (bid < nitems) s3_load(cur, p, bid, gq, tb, vb, r32, hi);
    for (int item = bid; item < nitems; item += nb) {
        unsigned gp[16];
#pragma unroll
        for (int i = 0; i < 16; ++i) { const int tt = w + 8 * i; const int g = tt >> 6, t = tt & 63, cc = item * 2 + g, bh = cc >> 6, c = cc & 63;
            gp[i] = GP[((size_t)bh * SEQ + (size_t)c * 64 + t) * 64 + lane]; }
        f32x16 acc;
#pragma unroll
        for (int g4 = 0; g4 < 4; ++g4) { acc[4 * g4] = __uint_as_float(cur.y0[g4].x << 16); acc[4 * g4 + 1] = __uint_as_float(cur.y0[g4].x & 0xffff0000u); acc[4 * g4 + 2] = __uint_as_float(cur.y0[g4].y << 16); acc[4 * g4 + 3] = __uint_as_float(cur.y0[g4].y & 0xffff0000u); }
#pragma unroll
        for (int ks = 0; ks < 4; ++ks) acc = MFMA32(cur.af[ks], cur.bf[ks], acc);
        if (item + nb < nitems) s3_load(cur, p, item + nb, gq, tb, vb, r32, hi);
        __syncthreads();
        { const int v = vb * 32 + r32;
#pragma unroll
          for (int r = 0; r < 16; ++r) Yb[gq * 4096 + (tb * 32 + crow(r, hi)) * 64 + v] = acc[r]; }
        __syncthreads();
#pragma unroll
        for (int i = 0; i < 16; ++i) { const int tt = w + 8 * i; const int g = tt >> 6, t = tt & 63, cc = item * 2 + g, bh = cc >> 6, c = cc & 63, b = bh >> 3, h = bh & 7;
            const size_t R = (size_t)b * SEQ + (size_t)c * 64 + t;
            const float yy = Yb[g * 4096 + t * 64 + lane];
            const float mean = wave_sum(yy) * (1.0f / 64.0f); const float dd = yy - mean;
            const float var = wave_sum(dd * dd) * (1.0f / 64.0f);
            O[R * DM + 512 + h * 64 + lane] = f2bf(dd * rsqrtf(var + 64e-5f) * __uint_as_float(gp[i] << 16) + __uint_as_float(gp[i] & 0xffff0000u)); }
    }
}

constexpr int SG_PITCH = 68;
__device__ __forceinline__ void phase_gemm2_sample(const Params& p, int bid, int nb, unsigned char* smem) {
    const int tid = otid(), lane = tid & 63, r32 = lane & 31, hi = lane >> 5; const int w = __builtin_amdgcn_readfirstlane(tid >> 6);
    const u16* Ob = (const u16*)(p.ws + WS_O); const u16* Wt = (const u16*)(p.ws + WS_WOUTT);
    float* Part = (float*)smem;
    for (int tile = bid; tile < 256; tile += nb) {
        const int tr = tile >> 4, tc = tile & 15, R0 = NPROW + tr * 64, n0 = tc * 64, k0 = w * 128;
        const int orow = tid >> 3, oc8 = (tid & 7) * 8;
        const float* xr = p.x_sample + (size_t)(tr * 64 + orow) * DM + n0 + oc8;
        const f32x4 x0 = *(const f32x4*)(xr), x1 = *(const f32x4*)(xr + 4);
        const u16* Ap = Ob + (size_t)(R0 + r32) * DM + k0 + hi * 8; const u16* Bp = Wt + (size_t)(n0 + r32) * DM + k0 + hi * 8;
        f32x16 acc[2][2];
#pragma unroll
        for (int ia = 0; ia < 2; ++ia)
#pragma unroll
            for (int ib = 0; ib < 2; ++ib)
#pragma unroll
                for (int r = 0; r < 16; ++r) acc[ia][ib][r] = 0.f;
#pragma unroll
        for (int ks = 0; ks < 8; ++ks) {
            const bf16x8 a0 = *(const bf16x8*)(Ap + ks * 16), a1 = *(const bf16x8*)(Ap + (size_t)32 * DM + ks * 16);
            const bf16x8 b0 = *(const bf16x8*)(Bp + ks * 16), b1 = *(const bf16x8*)(Bp + (size_t)32 * DM + ks * 16);
            acc[0][0] = MFMA32(a0, b0, acc[0][0]); acc[0][1] = MFMA32(a0, b1, acc[0][1]); acc[1][0] = MFMA32(a1, b0, acc[1][0]); acc[1][1] = MFMA32(a1, b1, acc[1][1]);
        }
        __syncthreads();
#pragma unroll
        for (int ia = 0; ia < 2; ++ia)
#pragma unroll
            for (int ib = 0; ib < 2; ++ib)
#pragma unroll
                for (int r = 0; r < 16; ++r) Part[(w * 64 + ia * 32 + crow(r, hi)) * SG_PITCH + ib * 32 + r32] = acc[ia][ib][r];
        __syncthreads();
        f32x4 s0 = x0, s1 = x1;
#pragma unroll
        for (int ww = 0; ww < 8; ++ww) { const float* pp = Part + (ww * 64 + orow) * SG_PITCH + oc8; s0 += *(const f32x4*)(pp); s1 += *(const f32x4*)(pp + 4); }
        float* dst = p.out + OUT_Y + (size_t)(R0 + orow) * DM + n0 + oc8;
        *(f32x4*)(dst) = s0; *(f32x4*)(dst + 4) = s1;
    }
}
__device__ __forceinline__ void phase_norm_sample(const Params& p, int bid, int nb) {
    const int tid = otid(), lane = tid & 63, w = tid >> 6;
    if (w < 4) {
        for (int r = bid * 4 + w; r < NROWS - NPROW; r += nb * 4) {
            float* src = p.out + OUT_Y + (size_t)(NPROW + r) * DM;
            f32x4 v[4], g[4]; float ss = 0.f;
#pragma unroll
            for (int i = 0; i < 4; ++i) { v[i] = *(const f32x4*)(src + lane * 4 + i * 256); g[i] = *(const f32x4*)(p.norm_f + lane * 4 + i * 256); }
#pragma unroll
            for (int i = 0; i < 4; ++i) ss += v[i][0] * v[i][0] + v[i][1] * v[i][1] + v[i][2] * v[i][2] + v[i][3] * v[i][3];
            ss = wave_sum(ss);
            const float rs = rsqrtf(ss * (1.0f / 1024.0f) + 1e-6f);
#pragma unroll
            for (int i = 0; i < 4; ++i) *(f32x4*)(src + lane * 4 + i * 256) = v[i] * rs * g[i];
        }
    }
}

__device__ __forceinline__ void phase_attn_prompt(const Params& p, int bid, int nb, unsigned char* smem, int uhi) {
    const int tid = otid(), lane = tid & 63, r32 = lane & 31, hi = lane >> 5; const int w = __builtin_amdgcn_readfirstlane(tid >> 6);
    unsigned char* ldsK = smem; unsigned char* ldsV = smem + 8192;
    const u16* Qb = (const u16*)(p.ws + WS_QB); const u16* Kb = (const u16*)(p.ws + WS_KB); const u16* Vb = (const u16*)(p.ws + WS_VB);
    const float* P = (const float*)(p.ws + WS_P); u16* O = (u16*)(p.ws + WS_O);
    for (int u = bid; u < uhi; u += nb) {
        const int qb = 15 - (u >> 5), bh = u & 31, b = bh >> 3, h = bh & 7, q0 = qb * 256, NT = 4 * qb + 4;
        const float bias2 = p.sb_bias[h] * LOG2E;
        const u16* Qw = Qb + ((size_t)bh * SEQ + q0 + w * 32) * 64;
        bf16x8 qr[4];
#pragma unroll
        for (int d0 = 0; d0 < 4; ++d0) qr[d0] = *(const bf16x8*)(Qw + r32 * 64 + d0 * 16 + hi * 8);
        const u16* ksrc = Kb + (size_t)bh * SEQ * 64 + (size_t)lane * 64 + w * 8;
        const u16* vsrc = Vb + (size_t)bh * SEQ * 64 + (size_t)(16 * (w & 3) + (lane >> 2)) * 64 + (w >> 2) * 32 + (lane & 3) * 8;
        const int jw = 4 * qb + (w >> 1), qrel = 32 * (w & 1) + r32;
        float carry = 1.0f; f32x16 o[2];
#pragma unroll
        for (int r = 0; r < 16; ++r) { o[0][r] = 0.f; o[1][r] = 0.f; }
        u32x4 kreg = *(const u32x4*)(ksrc + (size_t)(NT - 1) * 64 * 64), vreg = *(const u32x4*)(vsrc + (size_t)(NT - 1) * 64 * 64);
        for (int j = NT - 1; j >= 0; --j) {
            *(u32x4*)(ldsK + w * 1024 + lane * 16) = kreg; *(u32x4*)(ldsV + w * 1024 + lane * 16) = vreg;
            __syncthreads();
            if (j > 0) { kreg = *(const u32x4*)(ksrc + (size_t)(j - 1) * 64 * 64); vreg = *(const u32x4*)(vsrc + (size_t)(j - 1) * 64 * 64); }
            if (j <= jw) sb_tile((lds_cptr)ldsK, (lds_cptr)ldsV, qr, bias2, j == jw ? qrel : -1, lane, carry, o);
            __syncthreads();
        }
#pragma unroll
        for (int dh = 0; dh < 2; ++dh)
#pragma unroll
            for (int r = 0; r < 16; ++r) { const int R = b * SEQ + q0 + w * 32 + crow(r, hi), dcol = h * 64 + dh * 32 + r32;
                const float g = P[(size_t)R * NINP + 1536 + dcol]; O[(size_t)R * DM + dcol] = f2bf(o[dh][r] * silu_f(g)); }
    }
}

__device__ __forceinline__ void sb_scores32(lds_cptr ldsK, const bf16x8 (&qr)[4], float bias2, int qrel, int lane, float& carry, u32x4 (&pw)[2]) {
    const int r32 = lane & 31, hi = lane >> 5;
    const lds_cptr kp0 = ldsK + hi * 512 + r32 * 16;
    f32x16 C;
#pragma unroll
    for (int r = 0; r < 16; ++r) C[r] = bias2;
#pragma unroll
    for (int d0 = 0; d0 < 4; ++d0) { const bf16x8 kf = *(const __attribute__((address_space(3))) bf16x8*)(kp0 + d0 * 1024); C = MFMA32(kf, qr[d0], C); }
    if (qrel >= 0) {
#pragma unroll
        for (int r = 0; r < 16; ++r) if (crow(r, hi) >= qrel) C[r] = -INFINITY;
    }
    sb_sub(C, carry, hi);
#pragma unroll
    for (int i = 0; i < 4; ++i) { pw[0][i] = cvtpk(C[2 * i], C[2 * i + 1]); pw[1][i] = cvtpk(C[8 + 2 * i], C[8 + 2 * i + 1]); }
}
__device__ __forceinline__ void sb_pv32(lds_cptr ldsV, const u32x4 (&pw)[2], int lane, f32x16 (&o)[2]) {
    const int hi = lane >> 5;
    const lds_cptr vp0 = ldsV + ((lane >> 4) & 1) * 32 + (lane & 3) * 8 + (4 * hi + ((lane & 15) >> 2)) * 64;
#pragma unroll
    for (int i = 0; i < 4; ++i) {
        const s16x4 lo = vtr(vp0 + ((i >> 1) * 2048 + (i & 1) * 1024)), hi4 = vtr(vp0 + ((i >> 1) * 2048 + (i & 1) * 1024 + 512));
        const bf16x8 vf = {lo[0], lo[1], lo[2], lo[3], hi4[0], hi4[1], hi4[2], hi4[3]};
        o[i >> 1] = MFMA32(__builtin_bit_cast(bf16x8, pw[i & 1]), vf, o[i >> 1]);
    }
}
__device__ __forceinline__ void phase_attn_sample(const Params& p, int bid, int nb, unsigned char* smem, int uhi) {
    const int tid = otid(), lane = tid & 63, r32 = lane & 31, hi = lane >> 5; const int w = __builtin_amdgcn_readfirstlane(tid >> 6);
    unsigned char* ldsK = smem + w * 16384; unsigned char* ldsV = ldsK + 4096; unsigned char* stg = ldsK + 8192;
    const u16* Qb = (const u16*)(p.ws + WS_QB) + (size_t)NPROW * 512; const u16* Kb = (const u16*)(p.ws + WS_KB) + (size_t)NPROW * 512; const u16* Vb = (const u16*)(p.ws + WS_VB) + (size_t)NPROW * 512;
    const float* P = (const float*)(p.ws + WS_P); u16* O = (u16*)(p.ws + WS_O);
    const int srow = lane >> 4, sp = lane & 15;
#define AS_DMA_K(kp_) { _Pragma("unroll") for (int i = 0; i < 8; ++i) __builtin_amdgcn_global_load_lds((const unsigned*)((kp_) + (size_t)(i * 4) * 512), (__attribute__((address_space(3))) unsigned*)(stg + i * 1024), 16, 0, 2); }
    for (int u = bid; u < uhi; u += nb) {
        const int bd = u >> 3, h = u & 7;
        const float bias2 = p.sb_bias[h] * LOG2E;
        const int pg_lo = p.page_table[bd * 16 + 2 * w], pg_hi = p.page_table[bd * 16 + 2 * w + 1];
        bf16x8 qr[4];
#pragma unroll
        for (int d0 = 0; d0 < 4; ++d0) qr[d0] = *(const bf16x8*)(Qb + ((size_t)u * 8 + (r32 & 7)) * 64 + d0 * 16 + hi * 8);
        float carry = 1.0f; f32x16 o[2];
#pragma unroll
        for (int r = 0; r < 16; ++r) { o[0][r] = 0.f; o[1][r] = 0.f; }
        u32x4 pw[2];
        __syncthreads();
        f32x4 vx[8];
        { const size_t rb = (size_t)pg_hi * 128 + 96;
          const float* kp = p.cache_k + ((rb + srow) * 8 + h) * 64 + sp * 4; const float* vp = p.cache_v + ((rb + srow) * 8 + h) * 64 + sp * 4;
          AS_DMA_K(kp)
#pragma unroll
          for (int i = 0; i < 8; ++i) vx[i] = __builtin_nontemporal_load((const f32x4*)(vp + (size_t)(i * 4) * 512)); }
        if (w == 7) {
#pragma unroll
            for (int c8 = 0; c8 < 4; ++c8) { const int cc = c8 * 2 + hi; u32x4 kv = {0u, 0u, 0u, 0u}; if (r32 < 8) kv = *(const u32x4*)(Kb + ((size_t)u * 8 + r32) * 64 + cc * 8); *(u32x4*)(ldsK + cc * 512 + r32 * 16) = kv; }
#pragma unroll
            for (int i = 0; i < 4; ++i) { const int row = (lane >> 2) + 16 * (i & 1), dh = i >> 1; u32x4 vv = {0u, 0u, 0u, 0u};
                if (row < 8) vv = *(const u32x4*)(Vb + ((size_t)u * 8 + row) * 64 + dh * 32 + (lane & 3) * 8);
                *(u32x4*)(ldsV + dh * 2048 + row * 64 + (lane & 3) * 16) = vv; }
            asm volatile("s_waitcnt lgkmcnt(0)" ::: "memory");
            sb_scores32((lds_cptr)ldsK, qr, bias2, r32, lane, carry, pw);
            sb_pv32((lds_cptr)ldsV, pw, lane, o);
            asm volatile("" ::: "memory");
        }
        for (int st = 7; st >= 0; --st) {
            asm volatile("s_waitcnt vmcnt(0)" ::: "memory");
#pragma unroll
            for (int i = 0; i < 8; ++i) { const int row = i * 4 + srow; const f32x4 kx = *(const f32x4*)(stg + i * 1024 + lane * 16);
                u32x2 k2; k2.x = cvtpk(kx[0], kx[1]); k2.y = cvtpk(kx[2], kx[3]);
                *(u32x2*)(ldsK + (sp >> 1) * 512 + row * 16 + (sp & 1) * 8) = k2; }
#pragma unroll
            for (int i = 0; i < 8; ++i) { const int row = i * 4 + srow; u32x2 v2; v2.x = cvtpk(vx[i][0], vx[i][1]); v2.y = cvtpk(vx[i][2], vx[i][3]);
                *(u32x2*)(ldsV + (sp >> 3) * 2048 + row * 64 + (sp & 7) * 8) = v2; }
            asm volatile("s_waitcnt lgkmcnt(0)" ::: "memory");
            if (st > 0) { const int stn = st - 1; const int pagen = (stn >> 2) ? pg_hi : pg_lo; const size_t rbn = (size_t)pagen * 128 + 32 * (stn & 3);
                const float* kpn = p.cache_k + ((rbn + srow) * 8 + h) * 64 + sp * 4; const float* vpn = p.cache_v + ((rbn + srow) * 8 + h) * 64 + sp * 4;
                AS_DMA_K(kpn)
#pragma unroll
                for (int i = 0; i < 8; ++i) vx[i] = __builtin_nontemporal_load((const f32x4*)(vpn + (size_t)(i * 4) * 512)); }
            sb_scores32((lds_cptr)ldsK, qr, bias2, -1, lane, carry, pw);
            sb_pv32((lds_cptr)ldsV, pw, lane, o);
            asm volatile("" ::: "memory");
        }
#undef AS_DMA_K
        __syncthreads();
        float* Ob = (float*)smem;
        float* Tt = (float*)(smem + 16384);
#pragma unroll
        for (int dh = 0; dh < 2; ++dh)
#pragma unroll
            for (int r = 0; r < 4; ++r) Ob[(w * 8 + 4 * hi + r) * 64 + dh * 32 + r32] = o[dh][r];
        if (r32 < 8 && hi == 0) Tt[w * 8 + r32] = carry;
        __syncthreads();
        { const int q = tid >> 6, d = tid & 63; float acc = 0.f, suf = 1.0f;
#pragma unroll
          for (int ww = 7; ww >= 0; --ww) { acc += Ob[(ww * 8 + q) * 64 + d] * suf; suf *= Tt[ww * 8 + q]; }
          const int R = NPROW + bd * 8 + q, dcol = h * 64 + d;
          const float g = P[(size_t)R * NINP + 1536 + dcol]; O[(size_t)R * DM + dcol] = f2bf(acc * silu_f(g)); }
    }
}

struct EpiIn {
    static constexpr bool PERM = false, AFTER_DRAIN = false;
    float* P; float* out; u16* Qb; u16* Kb; u16* Vb;
    __device__ __forceinline__ void operator()(const pg8::f32x4 (&acc)[2][2][4][2], const pg8::Unit& u, int wr, int wc, int fr, int fq) const {
        const int row0 = u.pm * 256 + wr * 64 + fr, colt = u.pn * 256, col0 = colt + wc * 32 + 4 * fq;
        if (colt >= 1536) {
#pragma unroll
            for (int ai = 0; ai < 2; ++ai)
#pragma unroll
                for (int m = 0; m < 4; ++m) { float* rowp = P + (size_t)(row0 + ai * 128 + m * 16) * NINP + col0;
#pragma unroll
                    for (int bj = 0; bj < 2; ++bj)
#pragma unroll
                        for (int n = 0; n < 2; ++n) *(pg8::f32x4*)(rowp + bj * 128 + n * 16) = acc[ai][bj][m][n]; }
        } else {
            const int type = colt >> 9;
            const bool prompt = u.pm < 64;
            const float sc = type == 0 ? 0.125f * LOG2E : 1.0f;
            const int c0 = (colt & 511) + wc * 32 + 4 * fq, h0 = c0 >> 6, d0 = c0 & 63, rr0 = row0 - NPROW;
            u16* b16 = Qb + (size_t)type * ((size_t)NROWS * 512) + (prompt ? ((size_t)(((row0 >> 12) * 8 + h0) * SEQ + (row0 & 4095))) * 64 + d0
                                                                          : (size_t)NPROW * 512 + ((size_t)(((rr0 >> 3) * 8 + h0) * 8 + (rr0 & 7))) * 64 + d0);
            float* o32 = out + (prompt ? OUT_KP + (size_t)(type - 1) * (OUT_VP - OUT_KP) + (size_t)row0 * 512 : OUT_KS + (size_t)(type - 1) * (OUT_VS - OUT_KS) + (size_t)rr0 * 512) + c0;
            const int rstep16 = prompt ? 64 : 512;
            const int hstep16 = prompt ? SEQ * 64 : 512;
#pragma unroll
            for (int ai = 0; ai < 2; ++ai)
#pragma unroll
                for (int m = 0; m < 4; ++m)
#pragma unroll
                    for (int bj = 0; bj < 2; ++bj)
#pragma unroll
                        for (int n = 0; n < 2; ++n) { const pg8::f32x4 v = acc[ai][bj][m][n]; const int dr = ai * 128 + m * 16;
                            u32x2 pk2; pk2.x = cvtpk(v[0] * sc, v[1] * sc); pk2.y = cvtpk(v[2] * sc, v[3] * sc);
                            *(u32x2*)(b16 + (size_t)dr * rstep16 + (size_t)(bj * 2) * hstep16 + n * 16) = pk2;
                            if (type != 0) *(pg8::f32x4*)(o32 + (size_t)dr * 512 + bj * 128 + n * 16) = v; }
        }
    }
};

struct EpiRes {
    static constexpr bool PERM = false, AFTER_DRAIN = false;
    float* C; const float* xp; const float* xs;
    __device__ __forceinline__ void operator()(const pg8::f32x4 (&acc)[2][2][4][2], const pg8::Unit& u, int wr, int wc, int fr, int fq) const {
        const int row0 = u.pm * 256 + wr * 64 + fr, col0 = u.pn * 256 + wc * 32 + 4 * fq;
#pragma unroll
        for (int ai = 0; ai < 2; ++ai)
#pragma unroll
            for (int m = 0; m < 4; ++m) { const int row = row0 + ai * 128 + m * 16; float* rowp = C + (size_t)row * DM + col0;
                const float* xr = (row < NPROW ? xp + (size_t)row * DM : xs + (size_t)(row - NPROW) * DM) + col0;
#pragma unroll
                for (int bj = 0; bj < 2; ++bj)
#pragma unroll
                    for (int n = 0; n < 2; ++n) *(pg8::f32x4*)(rowp + bj * 128 + n * 16) = acc[ai][bj][m][n] + *(const pg8::f32x4*)(xr + bj * 128 + n * 16); }
    }
};

constexpr int PANEL_CNT_WORD = 4608;
struct EpiResNorm {
    static constexpr bool PERM = false, AFTER_DRAIN = true;
    float* C; const float* xp; const float* xs; const float* gain; float* stats; unsigned* ctl;
    __device__ __forceinline__ void fused(const pg8::f32x4 (&acc)[2][2][4][2], const pg8::Unit& u, int wr, int wc, int fr, int fq, PG8_LAS unsigned char* lds, int wid, int lane) const {
        PG8_LAS float* Pt = (PG8_LAS float*)lds;
        PG8_LAS float* Sr = (PG8_LAS float*)(lds + 4096);
        const int row0 = u.pm * 256 + wr * 64 + fr, col0 = u.pn * 256 + wc * 32 + 4 * fq;
        pg8::f32x4 (&hacc)[2][2][4][2] = const_cast<pg8::f32x4 (&)[2][2][4][2]>(acc);
#pragma unroll
        for (int ai = 0; ai < 2; ++ai)
#pragma unroll
            for (int m = 0; m < 4; ++m) { const int row = row0 + ai * 128 + m * 16;
                const float* xr = (row < NPROW ? xp + (size_t)row * DM : xs + (size_t)(row - NPROW) * DM) + col0;
                float s = 0.f;
#pragma unroll
                for (int bj = 0; bj < 2; ++bj)
#pragma unroll
                    for (int n = 0; n < 2; ++n) { const pg8::f32x4 hv = acc[ai][bj][m][n] + *(const pg8::f32x4*)(xr + bj * 128 + n * 16); hacc[ai][bj][m][n] = hv; s += (hv[0] * hv[0] + hv[1] * hv[1]) + (hv[2] * hv[2] + hv[3] * hv[3]); }
                s += __shfl_xor(s, 16); s += __shfl_xor(s, 32);
                if (fq == 0) Pt[(ai * 128 + wr * 64 + m * 16 + fr) * 4 + wc] = s; }
        __syncthreads();
        float* st = stats + (size_t)u.pm * 1024;
        unsigned* cnt = ctl + PANEL_CNT_WORD + 16 * u.pm;
        const int prow = wid * 32 + (lane & 31);
        if (lane < 32) { const float t4 = (Pt[prow * 4] + Pt[prow * 4 + 1]) + (Pt[prow * 4 + 2] + Pt[prow * 4 + 3]);
            __hip_atomic_store(st + prow * 4 + u.pn, t4, __ATOMIC_RELAXED, __HIP_MEMORY_SCOPE_AGENT); }
        asm volatile("s_waitcnt vmcnt(0)" ::: "memory");
        __syncthreads();
        if (threadIdx.x == 0) {
            __hip_atomic_fetch_add(cnt, 1u, __ATOMIC_RELAXED, __HIP_MEMORY_SCOPE_AGENT);
            unsigned spins = 0;
            while (__hip_atomic_load(cnt, __ATOMIC_RELAXED, __HIP_MEMORY_SCOPE_AGENT) < 4u) { __builtin_amdgcn_s_sleep(2); if (++spins > (1u << 22)) break; }
        }
        __syncthreads();
        if (lane < 32) { float tot = 0.f;
#pragma unroll
            for (int k = 0; k < 4; ++k) tot += __hip_atomic_load(st + prow * 4 + k, __ATOMIC_RELAXED, __HIP_MEMORY_SCOPE_AGENT);
            Sr[prow] = rsqrtf(tot * (1.0f / 1024.0f) + 1e-6f); }
        __syncthreads();
#pragma unroll
        for (int ai = 0; ai < 2; ++ai)
#pragma unroll
            for (int m = 0; m < 4; ++m) { const int row = row0 + ai * 128 + m * 16; float* rowp = C + (size_t)row * DM + col0;
                const float rs = Sr[ai * 128 + wr * 64 + m * 16 + fr];
#pragma unroll
                for (int bj = 0; bj < 2; ++bj)
#pragma unroll
                    for (int n = 0; n < 2; ++n) { const pg8::f32x4 hv = hacc[ai][bj][m][n]; const pg8::f32x4 gv = *(const pg8::f32x4*)(gain + col0 + bj * 128 + n * 16);
                        *(pg8::f32x4*)(rowp + bj * 128 + n * 16) = hv * rs * gv; } }
        __syncthreads();
    }
};

__device__ __forceinline__ void phase_final(const Params& p, int bid, int nb) {
    const int tid = otid(), lane = tid & 63, w = tid >> 6;
    f32x4 g[4];
#pragma unroll
    for (int i = 0; i < 4; ++i) g[i] = *(const f32x4*)(p.norm_f + lane * 4 + i * 256);
    for (int row = bid * 8 + w; row < NROWS; row += nb * 8) {
        float* src = p.out + (size_t)row * DM;
        f32x4 v[4]; float ss = 0.f;
#pragma unroll
        for (int i = 0; i < 4; ++i) { v[i] = *(const f32x4*)(src + lane * 4 + i * 256); ss += v[i][0] * v[i][0] + v[i][1] * v[i][1] + v[i][2] * v[i][2] + v[i][3] * v[i][3]; }
        ss = wave_sum(ss);
        const float rs = rsqrtf(ss * (1.0f / 1024.0f) + 1e-6f);
#pragma unroll
        for (int i = 0; i < 4; ++i) *(f32x4*)(src + lane * 4 + i * 256) = v[i] * rs * g[i];
    }
}

struct OneUnitOrder { int pm, pn;
    __device__ __forceinline__ bool next(int i, pg8::Unit& u) const { if (i != 0) return false; u.pm = pm; u.pn = pn; return true; }
    __device__ __forceinline__ void a_ready(const pg8::Unit&) const {}
    __device__ __forceinline__ void done(const pg8::Unit&) const {} };
constexpr int LDS_MAIN = 162048;
constexpr int LDS_BYTES = LDS_MAIN + 16;
static_assert(C_FEND <= LDS_MAIN, "stage-1 LDS map");
static_assert(PREP_END <= LDS_MAIN, "prep LDS map");
constexpr int WQ_WORD = XCD_BAR_WORDS + 64;
constexpr int CTL_BYTES = 32768;
__global__ __launch_bounds__(512, 2) __attribute__((target("no-packed-fp32-ops"))) void k_mega(Params p) {
    extern __shared__ __attribute__((aligned(16))) unsigned char shm[];
    const int bid = blockIdx.x, nb = gridDim.x;
    volatile LAS unsigned* xbw = (volatile LAS unsigned*)(shm + LDS_MAIN);
    volatile LAS unsigned* slot = (volatile LAS unsigned*)(shm + LDS_MAIN + 8);
    if (threadIdx.x == 0) { xbw[0] = 0u; xbw[1] = 0u; slot[0] = 0u; slot[1] = 0u; }
    __syncthreads();
    unsigned* bar = (unsigned*)(p.ws + WS_BAR);
    XcdBarrier xb = xcd_barrier_post(bar, xbw);
#define WQ_LOOP(Q, N, ...) { unsigned nxt_ = 0u; if (threadIdx.x == 0) nxt_ = __hip_atomic_fetch_add(bar + WQ_WORD + 64 * (Q), 1u, __ATOMIC_RELAXED, __HIP_MEMORY_SCOPE_AGENT); \
      for (;;) { __syncthreads(); if (threadIdx.x == 0) slot[0] = nxt_; __syncthreads(); const int item = __builtin_amdgcn_readfirstlane((int)slot[0]); if (item >= (N)) break; \
        if (threadIdx.x == 0) nxt_ = __hip_atomic_fetch_add(bar + WQ_WORD + 64 * (Q), 1u, __ATOMIC_RELAXED, __HIP_MEMORY_SCOPE_AGENT); __VA_ARGS__; } }
    phase_prologue(p, bid, nb, shm);
    xcd_barrier(xb);
    { pg8::Gemm g{(const pg8::bf16_t*)(p.ws + WS_XB), (const pg8::bf16_t*)(p.ws + WS_WINT), NROWS, NINP, DM}; pg8::StaticOrder S; S.init(NROWS, NINP, nb, bid);
      EpiIn E{(float*)(p.ws + WS_P), p.out, (u16*)(p.ws + WS_QB), (u16*)(p.ws + WS_KB), (u16*)(p.ws + WS_VB)}; pg8::gemm_phase<EpiIn, pg8::StaticOrder, false>((PG8_LAS unsigned char*)shm, g, S, E, nullptr); }
    { const int ntiles_ = (NROWS / 256) * (NINP / 256), rounds_ = (ntiles_ + nb - 1) / nb, sbase_ = ntiles_ - (rounds_ - 1) * nb, nidle_ = nb - sbase_;
      if (nidle_ > 0) { if (bid >= sbase_) phase_wout_tiles(p, bid - sbase_, nidle_, shm); } else phase_wout_tiles(p, bid, nb, shm); }
    xcd_barrier(xb);
    WQ_LOOP(7, 128, phase_prep_unit(p, item + 512, shm));
    if (bid & 1) {
        for (int it = bid; it < 768; it += nb) phase_attn_sample(p, it, 1 << 30, shm, 1024);
        for (int it = bid; it < 512; it += nb) scanc_fused(p, it, shm);
    } else {
        for (int it = bid; it < 512; it += nb) scanc_fused(p, it, shm);
        for (int it = bid; it < 768; it += nb) phase_attn_sample(p, it, 1 << 30, shm, 1024);
    }
    xcd_barrier(xb);
    for (int s_ = nb - 1 - bid; s_ < 32; s_ += nb) scanc_stage2(p, s_, shm);
    for (int it = bid; it < 256; it += nb) phase_attn_prompt(p, it, 1 << 30, shm, 512);
    for (int it = bid; it < 256; it += nb) phase_attn_sample(p, it + 768, 1 << 30, shm, 1024);
    WQ_LOOP(1, 256, phase_attn_prompt(p, item + 256, 1 << 30, shm, 512));
    WQ_LOOP(3, 1024, phase_scan(p, item + 32, 1 << 30, shm, 0, 1056));
    xcd_barrier(xb);
    phase_gemm2_sample(p, bid, nb, shm);
    phase_stage3(p, bid, nb, shm, 1024);
#undef WQ_LOOP
    xcd_barrier(xb);
    phase_norm_sample(p, bid, nb);
    for (int uu = bid; uu < 256; uu += nb) {
        pg8::Gemm g{(const pg8::bf16_t*)(p.ws + WS_O), (const pg8::bf16_t*)(p.ws + WS_WOUTT), NROWS, DM, DM}; OneUnitOrder S1u; const int ix_ = uu >> 3; S1u.pm = (uu & 7) * 8 + (ix_ >> 2); S1u.pn = ix_ & 3;
        EpiResNorm E{p.out, p.x_prompt, p.x_sample, p.norm_f, (float*)(p.ws + WS_STATS), bar}; pg8::gemm_phase<EpiResNorm, OneUnitOrder, false>((PG8_LAS unsigned char*)shm, g, S1u, E, nullptr);
    }
}

extern "C" void kernel_launch(void* const* d_in, const int* in_sizes, int n_in, void* d_out, int out_size, void* d_ws, size_t ws_size, hipStream_t stream) {
    if (ws_size < WS_END) { fprintf(stderr, "kernel_launch: workspace too small (%zu < %zu)\n", ws_size, (size_t)WS_END); return; }
    static int grid = 0;
    if (!grid) {
        int dev = 0, cus = 0, per_cu = 0;
        (void)hipGetDevice(&dev); (void)hipDeviceGetAttribute(&cus, hipDeviceAttributeMultiprocessorCount, dev);
        (void)hipFuncSetAttribute((const void*)k_mega, hipFuncAttributeMaxDynamicSharedMemorySize, LDS_BYTES);
        (void)hipOccupancyMaxActiveBlocksPerMultiprocessor(&per_cu, (const void*)k_mega, 512, LDS_BYTES);
        if (per_cu < 1) { fprintf(stderr, "kernel_launch: occupancy query says %d blocks per CU\n", per_cu); per_cu = 1; }
        grid = cus > 0 ? cus : 256;
    }
    Params p{};
    p.x_prompt = (const float*)d_in[0]; p.x_sample = (const float*)d_in[1]; p.cache_k = (const float*)d_in[2]; p.cache_v = (const float*)d_in[3]; p.page_table = (const int*)d_in[4];
    p.state_wkv = (const float*)d_in[5]; p.state_shift = (const float*)d_in[6]; p.norm_in = (const float*)d_in[7]; p.w_in = (const float*)d_in[8]; p.sb_bias = (const float*)d_in[9];
    p.mu = (const float*)d_in[10]; p.w0 = (const float*)d_in[11]; p.w_up = (const float*)d_in[12]; p.a0 = (const float*)d_in[13]; p.a_up = (const float*)d_in[14];
    p.k_k = (const float*)d_in[15]; p.k_a = (const float*)d_in[16]; p.r_k = (const float*)d_in[17]; p.ln_w = (const float*)d_in[18]; p.ln_b = (const float*)d_in[19];
    p.w_out = (const float*)d_in[20]; p.norm_f = (const float*)d_in[21];
    p.out = (float*)d_out; p.ws = (unsigned char*)d_ws;
    (void)hipMemsetAsync((unsigned char*)d_ws + WS_BAR, 0, CTL_BYTES, stream);
    hipLaunchKernelGGL(k_mega, dim3(grid), dim3(512), LDS_BYTES, stream, p);
}
```

```cpp
#include <hip/hip_runtime.h>
#include <stdint.h>
#include <stdio.h>
__device__ __forceinline__ void mk_sync() { __builtin_amdgcn_fence(__ATOMIC_RELEASE, "workgroup"); __builtin_amdgcn_s_barrier(); __builtin_amdgcn_fence(__ATOMIC_ACQUIRE, "workgroup"); }
#define __syncthreads() mk_sync()
namespace pg8 {
#define PG8_LAS __attribute__((address_space(3)))
typedef unsigned short bf16_t;
typedef short bf16x8 __attribute__((ext_vector_type(8)));
typedef float f32x4 __attribute__((ext_vector_type(4)));
typedef unsigned u32x4 __attribute__((ext_vector_type(4)));
constexpr int BM = 256, BK = 64, HALF = 128, HTB = HALF * BK * 2  , STAGE_BYTES = 8 * HTB, NXCD = 8, WGM = 8;

__host__ __device__ __forceinline__ int lds_byte(int r, int c) { const int st = (r >> 4) * 2 + (c >> 5), rr = r & 15, cc = c & 31, ob = rr * 64 + cc * 2; return st * 1024 + (ob ^ (((ob >> 9) & 1) << 5)); }
__host__ __device__ __forceinline__ void stage_rc(int b, int& R, int& C) { const int st = b / 1024, sb = b % 1024, swz = sb ^ (((sb >> 9) & 1) << 5); R = (st >> 1) * 16 + swz / 64; C = (st & 1) * 32 + (swz % 64) / 2; }
__host__ __device__ __forceinline__ int perm32(int rho) { const int n = rho >> 4, i = rho & 15; return 8 * (i >> 2) + 4 * n + (i & 3); }

struct Unit { int pm, pn; };
struct Gemm { const bf16_t* A; const bf16_t* Bt; int M, N, K; };

struct StaticOrder {
    int nM, nN, nwg, G, c;
    __host__ __device__ __forceinline__ void init(int M, int N, int G_, int c_) { nM = M / BM; nN = N / BM; nwg = nM * nN; G = G_; c = c_; }
    __host__ __device__ __forceinline__ bool next(int i, Unit& u) const {
        const long L = (long)i * G + c; if (L >= nwg) return false;
        int wgid = (int)L; { const int q = nwg / NXCD, r = nwg % NXCD, xcd = wgid % NXCD, off = wgid / NXCD; wgid = (xcd < r ? xcd * (q + 1) : r * (q + 1) + (xcd - r) * q) + off; }
        const int nig = WGM * nN, gid = wgid / nig, fm = gid * WGM, gsz = (nM - fm) < WGM ? (nM - fm) : WGM;
        u.pm = fm + ((wgid % nig) % gsz); u.pn = (wgid % nig) / gsz; return true;
    }
    __device__ __forceinline__ void a_ready(const Unit&) const {}
    __device__ __forceinline__ void done(const Unit&) const {}
};
struct CountedOrder : StaticOrder {
    const unsigned* ready; unsigned need; unsigned* tmo;
    __device__ __forceinline__ void a_ready(const Unit& u) const {
        if (threadIdx.x < 64) {
            const unsigned long long t0 = __builtin_amdgcn_s_memrealtime(); unsigned polls = 0;
            while ((unsigned)__builtin_amdgcn_readfirstlane(__hip_atomic_load(ready + 64 * u.pm, __ATOMIC_RELAXED, __HIP_MEMORY_SCOPE_AGENT)) < need) {
                if ((++polls & 255u) == 0u && __builtin_amdgcn_readfirstlane(__hip_atomic_load(tmo, __ATOMIC_RELAXED, __HIP_MEMORY_SCOPE_AGENT)) != 0u) break;
                if (__builtin_amdgcn_s_memrealtime() - t0 > 2000000ull) {
                    if (threadIdx.x == 0) { unsigned expect = 0u; __hip_atomic_compare_exchange_strong(tmo + 1, &expect, 0x600u | (unsigned)(u.pm & 0xff), __ATOMIC_RELAXED, __ATOMIC_RELAXED, __HIP_MEMORY_SCOPE_AGENT); __hip_atomic_store(tmo, 1u, __ATOMIC_RELAXED, __HIP_MEMORY_SCOPE_AGENT); }
                    break; }
                __builtin_amdgcn_s_sleep(2); }
            __builtin_amdgcn_fence(__ATOMIC_ACQUIRE, "agent");
            asm volatile("s_waitcnt vmcnt(0)" ::: "memory");
        }
#if !defined(BROKEN_HOOK_NO_BARRIER)
        asm volatile("" ::: "memory"); __builtin_amdgcn_s_barrier(); asm volatile("" ::: "memory");
#endif
    }
};

__device__ __forceinline__ unsigned cvt_pk_bf16(float lo, float hi) { unsigned r; asm volatile("v_cvt_pk_bf16_f32 %0, %1, %2" : "=v"(r) : "v"(lo), "v"(hi)); return r; }
typedef float f32x2 __attribute__((ext_vector_type(2)));
__device__ __forceinline__ f32x2 gelu_pk(f32x2 v) {
    const f32x2 av = __builtin_elementwise_abs(v), d = av * 0.2316418882f + 1.0f;
    f32x2 t; t.x = __builtin_amdgcn_rcpf(d.x); t.y = __builtin_amdgcn_rcpf(d.y);
    f32x2 q = t * 0.5307027145f + (-0.7265760135f); q = q * t + 0.7107068705f; q = q * t + (-0.142248368f); q = q * t + 0.127414796f; q = q * t;
    const f32x2 s = (v * v) * (-0.72134752044f);
    f32x2 e; e.x = __builtin_amdgcn_exp2f(s.x); e.y = __builtin_amdgcn_exp2f(s.y);
    const f32x2 m = v * (q * e), r = v - m;
    f32x2 o; o.x = v.x < 0.f ? m.x : r.x; o.y = v.y < 0.f ? m.y : r.y; return o;
}

struct EpiF32 {
    static constexpr bool PERM = false, AFTER_DRAIN = false;
    float* C; int ldc; const float* bias;
    __device__ __forceinline__ void operator()(const f32x4 (&acc)[2][2][4][2], const Unit& u, int wr, int wc, int fr, int fq) const {
        const int row0 = u.pm * BM + wr * 64 + fr, col0 = u.pn * BM + wc * 32 + 4 * fq;
        f32x4 bv[2][2];
#pragma unroll
        for (int bj = 0; bj < 2; ++bj)
#pragma unroll
            for (int n = 0; n < 2; ++n) bv[bj][n] = bias ? *(const f32x4*)(bias + col0 + bj * HALF + n * 16) : (f32x4){0.f, 0.f, 0.f, 0.f};
#pragma unroll
        for (int ai = 0; ai < 2; ++ai)
#pragma unroll
            for (int m = 0; m < 4; ++m) { float* rowp = C + (size_t)(row0 + ai * HALF + m * 16) * ldc + col0;
#pragma unroll
                for (int bj = 0; bj < 2; ++bj)
#pragma unroll
                    for (int n = 0; n < 2; ++n) *(f32x4*)(rowp + bj * HALF + n * 16) = acc[ai][bj][m][n] + bv[bj][n]; }
    }
};
template <class Epi, class Sched, bool STAMP = false>
__device__ __forceinline__ void gemm_phase(PG8_LAS unsigned char* lds, const Gemm g, const Sched& S, const Epi& E, unsigned long long* stamps) {
    int tid_ = threadIdx.x; asm volatile("" : "+v"(tid_));
    const int tid = tid_, wid = __builtin_amdgcn_readfirstlane(tid >> 6), lane = tid & 63, wr = wid >> 2, wc = wid & 3, fr = lane & 15, fq = lane >> 4;
    const int K = g.K, nt = K / BK;
    int ts_lo = 0, ts_hi = 0, nts = 0; const unsigned long long rt_entry = STAMP ? (unsigned long long)wall_clock64() : 0ull;
#define PG8_STAMP() do { if (STAMP && wid == 0 && nts < 64) { const unsigned long long _c = (unsigned long long)clock64(); \
        ts_lo = (lane == nts) ? (int)(unsigned)_c : ts_lo; ts_hi = (lane == nts) ? (int)(unsigned)(_c >> 32) : ts_hi; ++nts; } } while (0)
    PG8_STAMP();
    unsigned voffA[2], voffB[2];
#pragma unroll
    for (int i = 0; i < 2; ++i) { int R, C; stage_rc(tid * 16 + i * 8192, R, C); const int Rb = Epi::PERM ? ((R & ~31) + perm32(R & 31)) : R;
        voffA[i] = (unsigned)(R * K + C) * 2u; voffB[i] = (unsigned)(Rb * K + C) * 2u; }
    const size_t kstep = (size_t)(BK * 2);
    const size_t hstep = (size_t)HALF * K * 2;
    const size_t tstep = 2 * hstep;
    const unsigned ldsw = (unsigned)wid * 1024u;
    const int aoff = lds_byte(wr * 64 + fr, fq * 8), boff = lds_byte(wc * 32 + fr, fq * 8);
#define PG8_SA(b, h) (((b) * 2 + (h)) * HTB)
#define PG8_SB(b, h) ((4 + (b) * 2 + (h)) * HTB)
#define PG8_STAGE(bufoff, gbase, voff) do { _Pragma("unroll") for (int _i = 0; _i < 2; ++_i) \
        __builtin_amdgcn_global_load_lds((const unsigned*)((const char*)(gbase) + (voff)[_i]), (PG8_LAS unsigned*)(lds + (bufoff) + ldsw + _i * 8192), 16, 0, 0); } while (0)
#define PG8_LDA(dst, b, h) do { _Pragma("unroll") for (int m = 0; m < 4; ++m) _Pragma("unroll") for (int k = 0; k < 2; ++k) dst[m][k] = *(const PG8_LAS bf16x8*)(lds + PG8_SA(b, h) + aoff + m * 2048 + k * 1024); } while (0)
#define PG8_LDB(dst, b, h) do { _Pragma("unroll") for (int n = 0; n < 2; ++n) _Pragma("unroll") for (int k = 0; k < 2; ++k) dst[n][k] = *(const PG8_LAS bf16x8*)(lds + PG8_SB(b, h) + boff + n * 2048 + k * 1024); } while (0)
#define PG8_MMA(ai, bj, At, Bt) do { __builtin_amdgcn_s_setprio(1); _Pragma("unroll") for (int m = 0; m < 4; ++m) _Pragma("unroll") for (int n = 0; n < 2; ++n) _Pragma("unroll") for (int k = 0; k < 2; ++k) \
        acc[ai][bj][m][n] = __builtin_amdgcn_mfma_f32_16x16x32_bf16(Bt[n][k], At[m][k], acc[ai][bj][m][n], 0, 0, 0); __builtin_amdgcn_s_setprio(0); } while (0)
#define PG8_WAIT_V(n) asm volatile("s_waitcnt vmcnt(" #n ")" ::: "memory")
#define PG8_WAIT_L(n) asm volatile("s_waitcnt lgkmcnt(" #n ")" ::: "memory")
#define PG8_BAR __builtin_amdgcn_s_barrier()
#define PG8_SCHED __builtin_amdgcn_sched_barrier(0)
    Unit cur, nxt; int ui = 0;
    if (!S.next(0, cur)) return;
    f32x4 acc[2][2][4][2];
#pragma unroll
    for (int a = 0; a < 2; ++a)
#pragma unroll
        for (int b = 0; b < 2; ++b)
#pragma unroll
            for (int m = 0; m < 4; ++m)
#pragma unroll
                for (int n = 0; n < 2; ++n) acc[a][b][m][n] = (f32x4){0.f, 0.f, 0.f, 0.f};
    bf16x8 At[4][2], B0[2][2], B1[2][2];
    const char* cA = (const char*)g.A + (size_t)cur.pm * tstep; const char* cB = (const char*)g.Bt + (size_t)cur.pn * tstep;
    S.a_ready(cur);
    PG8_STAGE(PG8_SB(0, 0), cB, voffB); PG8_STAGE(PG8_SA(0, 0), cA, voffA); PG8_STAGE(PG8_SB(0, 1), cB + hstep, voffB); PG8_STAGE(PG8_SA(0, 1), cA + hstep, voffA);
    if (wr == 1) PG8_BAR;
    PG8_WAIT_V(4); PG8_BAR;
    PG8_STAGE(PG8_SB(1, 0), cB + kstep, voffB); PG8_STAGE(PG8_SA(1, 0), cA + kstep, voffA); PG8_STAGE(PG8_SB(1, 1), cB + hstep + kstep, voffB);
    PG8_WAIT_V(6); PG8_BAR;
    PG8_STAMP();
    for (;;) {
        const bool has_next = S.next(ui + 1, nxt);
        const char* nA = has_next ? (const char*)g.A + (size_t)nxt.pm * tstep : cA; const char* nB = has_next ? (const char*)g.Bt + (size_t)nxt.pn * tstep : cB;
        for (int t = 0; t < nt; t += 2) {
            const bool last = (t == nt - 2);
            const char* a1 = cA + (size_t)(t + 1) * kstep;
            const char* a2 = last ? nA : cA + (size_t)(t + 2) * kstep; const char* b2 = last ? nB : cB + (size_t)(t + 2) * kstep;
            const char* a3 = a2 + kstep; const char* b3 = b2 + kstep;
            if (last && has_next) S.a_ready(nxt);
            PG8_LDB(B0, 0, 0); PG8_SCHED; PG8_LDA(At, 0, 0); PG8_STAGE(PG8_SA(1, 1), a1 + hstep, voffA);
            PG8_WAIT_L(8); PG8_BAR; PG8_WAIT_L(0); PG8_MMA(0, 0, At, B0); PG8_BAR; PG8_SCHED;
            PG8_LDB(B1, 0, 1); PG8_STAGE(PG8_SB(0, 0), b2, voffB);
            PG8_BAR; PG8_WAIT_L(0); PG8_MMA(0, 1, At, B1); PG8_BAR;
            PG8_LDA(At, 0, 1); PG8_STAGE(PG8_SA(0, 0), a2, voffA);
            PG8_BAR; PG8_WAIT_L(0); PG8_MMA(1, 0, At, B0); PG8_BAR; PG8_SCHED;
            PG8_STAGE(PG8_SB(0, 1), b2 + hstep, voffB);
            PG8_WAIT_V(6); PG8_BAR; PG8_MMA(1, 1, At, B1); PG8_BAR;
            PG8_LDB(B0, 1, 0); PG8_SCHED; PG8_LDA(At, 1, 0); PG8_STAGE(PG8_SA(0, 1), a2 + hstep, voffA);
            PG8_WAIT_L(8); PG8_BAR; PG8_WAIT_L(0); PG8_MMA(0, 0, At, B0); PG8_BAR; PG8_SCHED;
            PG8_LDB(B1, 1, 1); PG8_STAGE(PG8_SB(1, 0), b3, voffB);
            PG8_BAR; PG8_WAIT_L(0); PG8_MMA(0, 1, At, B1); PG8_BAR;
            PG8_LDA(At, 1, 1); PG8_STAGE(PG8_SA(1, 0), a3, voffA);
            PG8_BAR; PG8_WAIT_L(0); PG8_MMA(1, 0, At, B0); PG8_BAR; PG8_SCHED;
            PG8_STAGE(PG8_SB(1, 1), b3 + hstep, voffB);
            PG8_WAIT_V(6); PG8_BAR; PG8_MMA(1, 1, At, B1); PG8_BAR;
        }
        PG8_STAMP();
        if constexpr (!Epi::AFTER_DRAIN) { E(acc, cur, wr, wc, fr, fq); S.done(cur); }
        PG8_STAMP();
        if (!has_next) break;
#pragma unroll
        for (int a = 0; a < 2; ++a)
#pragma unroll
            for (int b = 0; b < 2; ++b)
#pragma unroll
                for (int m = 0; m < 4; ++m)
#pragma unroll
                    for (int n = 0; n < 2; ++n) acc[a][b][m][n] = (f32x4){0.f, 0.f, 0.f, 0.f};
        cur = nxt; cA = nA; cB = nB; ++ui;
    }
    PG8_WAIT_V(0);
    if (wr == 0) PG8_BAR;
    PG8_BAR;
    if constexpr (Epi::AFTER_DRAIN) { E.fused(acc, cur, wr, wc, fr, fq, lds, wid, lane); S.done(cur); }
    PG8_STAMP();
    if (STAMP && wid == 0) { stamps[lane] = lane < nts ? (((unsigned long long)(unsigned)ts_hi << 32) | (unsigned)ts_lo) : 0ull;
        if (lane == 62) stamps[62] = rt_entry; if (lane == 63) stamps[63] = (unsigned long long)wall_clock64(); }
#undef PG8_STAMP
#undef PG8_SA
#undef PG8_SB
#undef PG8_STAGE
#undef PG8_LDA
#undef PG8_LDB
#undef PG8_MMA
#undef PG8_WAIT_V
#undef PG8_WAIT_L
#undef PG8_BAR
#undef PG8_SCHED
}
}

#define XB_TMO      128
#define XB_XCNT(j)  (256  + 64 * (j))
#define XB_XSUB(j)  (1280 + 64 * (j))
#define XB_XGEN(j)  (2304 + 64 * (j))
#define XB_TOP      3328
#define XB_TOPGEN   3392
#define XCD_BAR_WORDS 3456
#define XB_SPIN_CAP (1u << 18)
#define LAS __attribute__((address_space(3)))

__device__ __forceinline__ unsigned xb_ld(unsigned* p)              { return __hip_atomic_load(p, __ATOMIC_RELAXED, __HIP_MEMORY_SCOPE_AGENT); }
__device__ __forceinline__ unsigned xb_add(unsigned* p, unsigned v) { return __hip_atomic_fetch_add(p, v, __ATOMIC_RELAXED, __HIP_MEMORY_SCOPE_AGENT); }
__device__ __forceinline__ unsigned xb_xcc_id() { return (unsigned)__builtin_amdgcn_s_getreg((3 << 11) | 20) & 0xFu; }
#define XB_SPIN(cond, bar) do { unsigned _sp = 0; while (cond) { __builtin_amdgcn_s_sleep(1); \
    if ((++_sp & 255u) == 0u) { if (xb_ld(&(bar)[XB_TMO])) break; if (_sp > XB_SPIN_CAP) { atomicAdd(&(bar)[XB_TMO], 1u); break; } } } } while (0)

struct XcdBarrier {
    unsigned* bar; unsigned x;
    volatile LAS unsigned* st;
};

__device__ __forceinline__ XcdBarrier xcd_barrier_post(unsigned* bar, volatile LAS unsigned* st) {
    XcdBarrier b; b.bar = bar; b.x = xb_xcc_id(); b.st = st;
    if (threadIdx.x == 0) (void)xb_add(&bar[XB_XCNT(b.x)], 1u);
    return b;
}
__device__ __forceinline__ void xcd_barrier_complete(unsigned* bar, unsigned x, unsigned& nloc, unsigned& nx) {
    const unsigned G = gridDim.x * gridDim.y * gridDim.z;
    unsigned sum, cnt, mine, sp = 0u;
    for (;;) {
        sum = 0u; cnt = 0u; mine = 0u;
#pragma unroll
        for (unsigned j = 0; j < 16; ++j) { const unsigned c = xb_ld(&bar[XB_XCNT(j)]); sum += c; cnt += (c > 0u) ? 1u : 0u; mine = (j == x) ? c : mine; }
        if (sum == G) break;
        __builtin_amdgcn_s_sleep(1);
        if ((++sp & 255u) == 0u) { if (xb_ld(&bar[XB_TMO])) break; if (sp > XB_SPIN_CAP) { atomicAdd(&bar[XB_TMO], 1u); break; } }
    }
    nloc = mine > 0u ? mine : 1u; nx = cnt > 0u ? cnt : 1u;
}

__device__ __forceinline__ void xcd_barrier(const XcdBarrier& b) {
    asm volatile("s_waitcnt vmcnt(0)" ::: "memory");
    __syncthreads();
    if (threadIdx.x == 0) {
        unsigned* bar = b.bar;
        __builtin_amdgcn_s_waitcnt(0);
        unsigned nloc = b.st[0], nx = b.st[1];
        if (nloc == 0u) { xcd_barrier_complete(bar, b.x, nloc, nx); b.st[0] = nloc; b.st[1] = nx; }
        const unsigned old = xb_add(&bar[XB_XSUB(b.x)], 1u);
        const unsigned gen = old / nloc;
        if (old + 1u == (gen + 1u) * nloc) {
            __builtin_amdgcn_fence(__ATOMIC_RELEASE, "agent");
            asm volatile("s_waitcnt vmcnt(0)" ::: "memory");
            const unsigned og = xb_add(&bar[XB_TOP], 1u);
            const unsigned tg = og / nx;
            if (og + 1u == (tg + 1u) * nx) xb_add(&bar[XB_TOPGEN], 1u);
            else XB_SPIN(xb_ld(&bar[XB_TOPGEN]) == tg, bar);
            __builtin_amdgcn_fence(__ATOMIC_ACQUIRE, "agent");
            xb_add(&bar[XB_XGEN(b.x)], 1u);
            asm volatile("s_waitcnt vmcnt(0)" ::: "memory");
        } else {
            XB_SPIN(xb_ld(&bar[XB_XGEN(b.x)]) == gen, bar);
            __builtin_amdgcn_fence(__ATOMIC_ACQUIRE, "agent");
            asm volatile("s_waitcnt vmcnt(0)" ::: "memory");
        }
    }
    __syncthreads();
}

typedef unsigned short u16;
typedef short bf16x8 __attribute__((ext_vector_type(8)));
typedef short s16x4 __attribute__((ext_vector_type(4)));
typedef float f32x16 __attribute__((ext_vector_type(16)));
typedef float f32x4 __attribute__((ext_vector_type(4)));
typedef unsigned u32x4 __attribute__((ext_vector_type(4)));
typedef unsigned u32x2 __attribute__((ext_vector_type(2)));

constexpr int NROWS = 17408, NPROW = 16384, DM = 1024, NIN = 4224, NINP = 4352, SEQ = 4096;
constexpr int RWC = 2176;
constexpr size_t OUT_Y = 0, OUT_KP = 17825792, OUT_VP = 26214400, OUT_WKVP = 34603008, OUT_SHP = 34734080,
                 OUT_KS = 34742784, OUT_VS = 35267072, OUT_WKVS = 35791360, OUT_SHS = 39985664;
constexpr size_t WS_BAR = 0;
constexpr size_t WS_XB = 32768;
constexpr size_t WS_WINT = WS_XB + (size_t)NROWS * DM * 2;
constexpr size_t WS_WOUTT = WS_WINT + (size_t)NINP * DM * 2;
constexpr size_t WS_P = WS_WOUTT + (size_t)DM * DM * 2;
constexpr size_t WS_QB = WS_P + (size_t)NROWS * NINP * 4;
constexpr size_t WS_KB = WS_QB + (size_t)NROWS * 512 * 2;
constexpr size_t WS_VB = WS_KB + (size_t)NROWS * 512 * 2;
constexpr size_t WS_SR = WS_VB + (size_t)NROWS * 512 * 2;
constexpr size_t SARR = (size_t)NROWS * 512 * 4;
constexpr size_t WS_SW = WS_SR + SARR, WS_SK = WS_SW + SARR, WS_SV = WS_SK + SARR, WS_SA = WS_SV + SARR, WS_SB = WS_SA + SARR, WS_SG = WS_SB + SARR, WS_S2 = WS_SG + SARR;
constexpr size_t WS_O = WS_S2 + SARR;
constexpr size_t WS_PM = WS_O + (size_t)NROWS * DM * 2;
constexpr size_t WS_QM = WS_PM + (size_t)2048 * 4096 * 2;
constexpr size_t WS_WH = WS_QM + (size_t)2048 * 4096 * 4;
constexpr size_t WS_Y0 = WS_WH + (size_t)2048 * 4096 * 2;
constexpr size_t WS_SC = WS_Y0 + (size_t)2048 * 4096 * 4;
constexpr size_t WS_WUPT = WS_SC + (size_t)2048 * 4096 * 2;
constexpr size_t WS_AUPT = WS_WUPT + 65536;
constexpr size_t WS_STATS = WS_AUPT + 65536;
constexpr size_t WS_END = WS_STATS + (size_t)68 * 1024 * 4;

struct Params {
    const float* x_prompt; const float* x_sample; const float* cache_k; const float* cache_v; const int* page_table;
    const float* state_wkv; const float* state_shift; const float* norm_in; const float* w_in; const float* sb_bias;
    const float* mu; const float* w0; const float* w_up; const float* a0; const float* a_up; const float* k_k; const float* k_a;
    const float* r_k; const float* ln_w; const float* ln_b; const float* w_out; const float* norm_f;
    float* out; unsigned char* ws;
};

#define LOG2E 1.4426950408889634f
#define MFMA32(a, b, c) __builtin_amdgcn_mfma_f32_32x32x16_bf16(a, b, c, 0, 0, 0)

typedef float f32x2_t __attribute__((ext_vector_type(2)));
typedef __bf16 bf16x2_t __attribute__((ext_vector_type(2)));
__device__ __forceinline__ unsigned cvtpk(float lo, float hi) { const f32x2_t v = {lo, hi}; return __builtin_bit_cast(unsigned, __builtin_convertvector(v, bf16x2_t)); }
__device__ __forceinline__ u16 f2bf(float f) { return (u16)(cvtpk(f, 0.f) & 0xffffu); }
template <int CTRL> __device__ __forceinline__ float dppf(float x) { return __builtin_bit_cast(float, __builtin_amdgcn_update_dpp(0, __builtin_bit_cast(int, x), CTRL, 0xf, 0xf, true)); }
__device__ __forceinline__ float reduce8(float x) { x += dppf<0xB1>(x); x += dppf<0x4E>(x); x += dppf<0x141>(x); return x; }
__device__ __forceinline__ float wave_sum(float x) { x = reduce8(x); x += dppf<0x140>(x); x += __shfl_xor(x, 16); x += __shfl_xor(x, 32); return x; }
__device__ __forceinline__ int otid() { int t = threadIdx.x; asm volatile("" : "+v"(t)); return t; }
__device__ __forceinline__ float frcp(float x) { return __builtin_amdgcn_rcpf(x); }
__device__ __forceinline__ float silu_f(float g) { return g * frcp(1.0f + __expf(-g)); }
__device__ __forceinline__ float softplus_f(float x) { return fmaxf(x, 0.f) + __logf(1.0f + __expf(-fabsf(x))); }

__device__ __forceinline__ void phase_prologue(const Params& p, int bid, int nb, unsigned char* smem) {
    const int tid = otid(), lane = tid & 63, w = tid >> 6;
    u16* Xb = (u16*)(p.ws + WS_XB);
    u16* WupT = (u16*)(p.ws + WS_WUPT); u16* AupT = (u16*)(p.ws + WS_AUPT);
    const int e0 = bid * 512 + tid; float up0 = 0.f;
    if (e0 < 65536) { const int which = e0 >> 15, idx = e0 & 32767, cc = idx >> 6, ii = idx & 63; up0 = (which ? p.a_up : p.w_up)[ii * 512 + cc]; }
    float* tileb = (float*)smem;
    u16* WinT = (u16*)(p.ws + WS_WINT); u16* WoutT = (u16*)(p.ws + WS_WOUTT);
    const int NT1 = (NINP / 64) * 16, NT2 = 16 * 16;
    float tv[8], tn[8]; int buf = 0;
    auto tload = [&](int id) {
        const bool first = id < NT1; const int id2 = first ? id : id - NT1; const int nt = id2 / 16, kt = id2 % 16, n0 = nt * 64, k0 = kt * 64;
#pragma unroll
        for (int j = 0; j < 8; ++j) { const int e = tid + 512 * j, kr = e >> 6, nc = e & 63;
            if (first) { tv[j] = (n0 + nc < NIN) ? p.w_in[(size_t)(k0 + kr) * NIN + n0 + nc] : 0.f; tn[j] = p.norm_in[k0 + kr]; }
            else { tv[j] = p.w_out[(size_t)(k0 + kr) * DM + n0 + nc]; tn[j] = 1.0f; } } };
    if (bid < NT1) tload(bid);
    constexpr int NR = 5;
    for (int row = bid * 8 + w; row < NROWS; row += nb * 8 * NR) {
        f32x4 v[NR][4];
#pragma unroll
        for (int k = 0; k < NR; ++k) { const int rk = row + k * nb * 8;
            if (rk < NROWS) { const float* src = rk < NPROW ? p.x_prompt + (size_t)rk * DM : p.x_sample + (size_t)(rk - NPROW) * DM;
#pragma unroll
                for (int i = 0; i < 4; ++i) v[k][i] = *(const f32x4*)(src + lane * 4 + i * 256); }
            else {
#pragma unroll
                for (int i = 0; i < 4; ++i) { const f32x4 z = {0.f, 0.f, 0.f, 0.f}; v[k][i] = z; } } }
#pragma unroll
        for (int k = 0; k < NR; ++k) { const int rk = row + k * nb * 8;
            float ss = 0.f;
#pragma unroll
            for (int i = 0; i < 4; ++i) ss += v[k][i][0] * v[k][i][0] + v[k][i][1] * v[k][i][1] + v[k][i][2] * v[k][i][2] + v[k][i][3] * v[k][i][3];
            ss = wave_sum(ss);
            const float rs = rsqrtf(ss * (1.0f / 1024.0f) + 1e-6f);
            if (rk < NROWS) {
#pragma unroll
                for (int i = 0; i < 4; ++i) { u32x2 o; o.x = cvtpk(v[k][i][0] * rs, v[k][i][1] * rs); o.y = cvtpk(v[k][i][2] * rs, v[k][i][3] * rs); *(u32x2*)(Xb + (size_t)rk * DM + lane * 4 + i * 256) = o; } } }
    }
    if (e0 < 65536) { const int which = e0 >> 15, idx = e0 & 32767, cc = idx >> 6, ii = idx & 63; (which ? AupT : WupT)[cc * 64 + ii] = f2bf(up0); }
    for (int e = e0 + nb * 512; e < 65536; e += nb * 512) { const int which = e >> 15, idx = e & 32767, cc = idx >> 6, ii = idx & 63;
        const float val = (which ? p.a_up : p.w_up)[ii * 512 + cc]; (which ? AupT : WupT)[cc * 64 + ii] = f2bf(val); }
    for (int id = bid; id < NT1; id += nb) {
        const bool first = id < NT1; const int id2 = first ? id : id - NT1; const int nt = id2 / 16, kt = id2 % 16, n0 = nt * 64, k0 = kt * 64;
        float* tile = tileb + buf * (64 * 65);
#pragma unroll
        for (int j = 0; j < 8; ++j) { const int e = tid + 512 * j; tile[(e >> 6) * 65 + (e & 63)] = tv[j] * tn[j]; }
        __syncthreads();
        if (id + nb < NT1) tload(id + nb);
        u16* dst = first ? WinT : WoutT;
#pragma unroll
        for (int j = 0; j < 4; ++j) { const int e = tid + 512 * j, nr = e >> 5, kc = (e & 31) * 2; *(unsigned*)(dst + (size_t)(n0 + nr) * DM + k0 + kc) = cvtpk(tile[kc * 65 + nr], tile[(kc + 1) * 65 + nr]); }
        buf ^= 1;
    }
    __syncthreads();
}

__device__ __forceinline__ void phase_wout_tiles(const Params& p, int idx, int stride, unsigned char* smem) {
    const int tid = otid();
    float* tileb = (float*)smem;
    u16* WoutT = (u16*)(p.ws + WS_WOUTT);
    float tv[8]; int buf = 0;
    auto tload = [&](int id) { const int nt = id / 16, kt = id % 16, n0 = nt * 64, k0 = kt * 64;
#pragma unroll
        for (int j = 0; j < 8; ++j) { const int e = tid + 512 * j, kr = e >> 6, nc = e & 63; tv[j] = p.w_out[(size_t)(k0 + kr) * DM + n0 + nc]; } };
    if (idx < 256) tload(idx);
    __syncthreads();
    for (int id = idx; id < 256; id += stride) {
        const int nt = id / 16, kt = id % 16, n0 = nt * 64, k0 = kt * 64;
        float* tile = tileb + buf * (64 * 65);
#pragma unroll
        for (int j = 0; j < 8; ++j) { const int e = tid + 512 * j; tile[(e >> 6) * 65 + (e & 63)] = tv[j]; }
        __syncthreads();
        if (id + stride < 256) tload(id + stride);
#pragma unroll
        for (int j = 0; j < 4; ++j) { const int e = tid + 512 * j, nr = e >> 5, kc = (e & 31) * 2; *(unsigned*)(WoutT + (size_t)(n0 + nr) * DM + k0 + kc) = cvtpk(tile[kc * 65 + nr], tile[(kc + 1) * 65 + nr]); }
        buf ^= 1;
    }
    __syncthreads();
}

constexpr int PREP_TW = 0, PREP_TA = 32 * 144, PREP_LW = 2 * 32 * 144, PREP_LP = 516, PREP_LA = PREP_LW + 32 * PREP_LP * 4, PREP_END = PREP_LA + 32 * PREP_LP * 4;
struct PrepRow { float xr, xk, xv, xg; };
__device__ __forceinline__ void prep_load(PrepRow& o, const float* prow, int c) { o.xr = prow[2048 + c]; o.xk = prow[2560 + c]; o.xv = prow[3072 + c]; o.xg = prow[3584 + c]; }
__device__ __forceinline__ void phase_prep_unit(const Params& p, int u, unsigned char* smem) {
    const int c = otid(), lane = c & 63, r32 = lane & 31, hi = lane >> 5; const int w = __builtin_amdgcn_readfirstlane(c >> 6);
    const float* P = (const float*)(p.ws + WS_P);
    u16* Qb = (u16*)(p.ws + WS_QB); u16* Kb = (u16*)(p.ws + WS_KB); u16* Vb = (u16*)(p.ws + WS_VB);
    float* SR = (float*)(p.ws + WS_SR); float* SW = (float*)(p.ws + WS_SW); float* SK = (float*)(p.ws + WS_SK); float* SV = (float*)(p.ws + WS_SV);
    float* SA = (float*)(p.ws + WS_SA); float* SBb = (float*)(p.ws + WS_SB); float* SG = (float*)(p.ws + WS_SG); float* S2 = (float*)(p.ws + WS_S2);
    const bool prompt = u < 512; const int bd = u - 512;
    const int t0 = prompt ? (u & 127) * 32 : 0, n = prompt ? 32 : 8;
    const int row0 = prompt ? (u >> 7) * SEQ + t0 : NPROW + bd * 8;
    const bool has_prev_row = prompt && t0 > 0;
    {
        const int j = c & 127, tq = c >> 7, tb = tq * 8;
        if (tb < n) {
            const float mul = p.mu[2048 + j];
            float raw[8], prev;
#pragma unroll
            for (int k = 0; k < 8; ++k) raw[k] = P[(size_t)(row0 + tb + k) * NINP + 4096 + j];
            if (tb > 0 || has_prev_row) prev = P[(size_t)(row0 + tb - 1) * NINP + 4096 + j];
            else prev = prompt ? 0.f : p.state_shift[(size_t)bd * RWC + 2048 + j];
#pragma unroll
            for (int k = 0; k < 8; ++k) { const float zl = raw[k] + (prev - raw[k]) * mul; prev = raw[k];
                float val = zl; if (j < 64) { const float e2 = __expf(2.0f * zl); val = 1.0f - 2.0f / (e2 + 1.0f); }
                *(u16*)(smem + (j < 64 ? PREP_TW : PREP_TA) + (tb + k) * 144 + (j & 63) * 2) = f2bf(val); }
        }
    }
    __syncthreads();
    {
        const u16* WupT = (const u16*)(p.ws + WS_WUPT); const u16* AupT = (const u16*)(p.ws + WS_AUPT);
        float* LW = (float*)(smem + PREP_LW); float* LA = (float*)(smem + PREP_LA);
#pragma unroll
        for (int mt = 0; mt < 2; ++mt) {
            const int crow0 = (2 * w + mt) * 32;
            f32x16 accw, acca;
#pragma unroll
            for (int r = 0; r < 16; ++r) { accw[r] = 0.f; acca[r] = 0.f; }
#pragma unroll
            for (int ks = 0; ks < 4; ++ks) {
                const bf16x8 wa = *(const bf16x8*)(WupT + (crow0 + r32) * 64 + ks * 16 + hi * 8), aa = *(const bf16x8*)(AupT + (crow0 + r32) * 64 + ks * 16 + hi * 8);
                const bf16x8 tw = *(const bf16x8*)(smem + PREP_TW + r32 * 144 + ks * 32 + hi * 16), ta = *(const bf16x8*)(smem + PREP_TA + r32 * 144 + ks * 32 + hi * 16);
                accw = MFMA32(wa, tw, accw); acca = MFMA32(aa, ta, acca);
            }
#pragma unroll
            for (int g4 = 0; g4 < 4; ++g4) { const int cc = crow0 + 8 * g4 + 4 * hi;
                const f32x4 v1 = {accw[4 * g4], accw[4 * g4 + 1], accw[4 * g4 + 2], accw[4 * g4 + 3]}, v2 = {acca[4 * g4], acca[4 * g4 + 1], acca[4 * g4 + 2], acca[4 * g4 + 3]};
                *(f32x4*)(LW + r32 * PREP_LP + cc) = v1; *(f32x4*)(LA + r32 * PREP_LP + cc) = v2; }
        }
    }
    __syncthreads();
    {
        const float* LW = (const float*)(smem + PREP_LW); const float* LA = (const float*)(smem + PREP_LA);
        const float mu_r = p.mu[c], mu_k = p.mu[512 + c], mu_v = p.mu[1024 + c], mu_g = p.mu[1536 + c];
        const float w0c = p.w0[c], a0c = p.a0[c], kkc = p.k_k[c], kac = p.k_a[c], lnwc = p.ln_w[c], lnbc = p.ln_b[c], rkc = p.r_k[c];
        float pr, pk, pv, pg;
        if (has_prev_row) { const float* q = P + (size_t)(row0 - 1) * NINP + 2048; pr = q[c]; pk = q[512 + c]; pv = q[1024 + c]; pg = q[1536 + c]; }
        else if (prompt) { pr = pk = pv = pg = 0.f; }
        else { const float* q = p.state_shift + (size_t)bd * RWC; pr = q[c]; pk = q[512 + c]; pv = q[1024 + c]; pg = q[1536 + c]; }
        PrepRow cur[4], nxt[4];
#pragma unroll
        for (int e = 0; e < 4; ++e) { prep_load(cur[e], P + (size_t)(row0 + e) * NINP, c); nxt[e] = cur[e]; }
        for (int tg = 0; tg < n; tg += 4) {
            if (tg + 4 < n) {
#pragma unroll
                for (int e = 0; e < 4; ++e) prep_load(nxt[e], P + (size_t)(row0 + tg + 4 + e) * NINP, c); }
#pragma unroll
            for (int e = 0; e < 4; ++e) {
            const int t = tg + e; const int R = row0 + t;
            const float xr = cur[e].xr, xk = cur[e].xk, xv = cur[e].xv, xg = cur[e].xg;
            const float zr = xr + (pr - xr) * mu_r, zk = xk + (pk - xk) * mu_k, zv = xv + (pv - xv) * mu_v, zg = xg + (pg - xg) * mu_g;
            const float lw = LW[t * PREP_LP + c], la = LA[t * PREP_LP + c];
            const float xw = -(w0c + lw);
            const float sp = softplus_f(xw);
            const float decay = __expf(-__expf(-sp - 0.5f));
            const float alr = frcp(1.0f + __expf(-(a0c + la)));
            float kk = zk * kkc; const float ss = wave_sum(kk * kk); kk = kk * __builtin_amdgcn_rsqf(fmaxf(ss, 1e-24f));
            const float keff = zk * (1.0f + (alr - 1.0f) * kac);
            const size_t o = (size_t)R * 512 + c;
            const float bsum = wave_sum(zr * keff * rkc); const float sg = silu_f(zg);
            SR[o] = zr; SW[o] = decay; SK[o] = keff; SV[o] = zv; SA[o] = -kk; SBb[o] = kk * alr; SG[o] = lnwc * sg; S2[o] = (lnbc + bsum * zv) * sg;
            if ((prompt && t0 + t == SEQ - 1) || (!prompt && t == 7)) {
                float* sh = prompt ? p.out + OUT_SHP + (size_t)(R >> 12) * RWC : p.out + OUT_SHS + (size_t)bd * RWC;
                sh[c] = xr; sh[512 + c] = xk; sh[1024 + c] = xv; sh[1536 + c] = xg; if (c < 128) sh[2048 + c] = P[(size_t)R * NINP + 4096 + c]; }
            pr = xr; pk = xk; pv = xv; pg = xg;
            }
#pragma unroll
            for (int e = 0; e < 4; ++e) cur[e] = nxt[e];
        }
    }
    __syncthreads();
}

constexpr int SCH = 32;
constexpr int SARRF = SCH * 64 + 64;
constexpr int SBUFF = 6 * SARRF + SCH * 64;
struct ScanOps { f32x4 r, w, k, a, b; float v0, v1; };
__device__ __forceinline__ float allred16(float x) { x += dppf<0xB1>(x); x += dppf<0x4E>(x); x += dppf<0x124>(x); x += dppf<0x128>(x); return x; }
__device__ __forceinline__ void scan_load(ScanOps& o, const float* L, int t, int cg, int rowp) {
    const float* base = L + t * 64 + cg * 4;
    o.r = *(const f32x4*)(base); o.w = *(const f32x4*)(base + SARRF); o.k = *(const f32x4*)(base + 2 * SARRF);
    o.a = *(const f32x4*)(base + 4 * SARRF); o.b = *(const f32x4*)(base + 5 * SARRF);
    const float* vp = L + 3 * SARRF + t * 64 + rowp; o.v0 = vp[0]; o.v1 = vp[1];
}
__device__ __forceinline__ void scan_step(const ScanOps& o, float (&s0)[4], float (&s1)[4], float* ybuf, int t, int cg, int rowp) {
    float d0 = (s0[0] * o.a[0] + s0[1] * o.a[1]) + (s0[2] * o.a[2] + s0[3] * o.a[3]);
    float d1 = (s1[0] * o.a[0] + s1[1] * o.a[1]) + (s1[2] * o.a[2] + s1[3] * o.a[3]);
    float sw0[4], sw1[4];
#pragma unroll
    for (int e = 0; e < 4; ++e) { sw0[e] = __builtin_fmaf(s0[e], o.w[e], o.v0 * o.k[e]); sw1[e] = __builtin_fmaf(s1[e], o.w[e], o.v1 * o.k[e]); }
    d0 = allred16(d0); d1 = allred16(d1);
#pragma unroll
    for (int e = 0; e < 4; ++e) { s0[e] = __builtin_fmaf(d0, o.b[e], sw0[e]); s1[e] = __builtin_fmaf(d1, o.b[e], sw1[e]); }
    float y0 = (s0[0] * o.r[0] + s0[1] * o.r[1]) + (s0[2] * o.r[2] + s0[3] * o.r[3]);
    float y1 = (s1[0] * o.r[0] + s1[1] * o.r[1]) + (s1[2] * o.r[2] + s1[3] * o.r[3]);
    y0 = allred16(y0); y1 = allred16(y1);
    if (cg == 0) { ybuf[t * 64 + rowp] = y0; ybuf[t * 64 + rowp + 1] = y1; }
}
__device__ __forceinline__ void phase_scan(const Params& p, int bid, int nb, unsigned char* smem, int ulo, int uhi) {
    const int tid = otid(), lane = tid & 63, w = tid >> 6;
    float* LB = (float*)smem;
    const float* SRC[6] = {(const float*)(p.ws + WS_SR), (const float*)(p.ws + WS_SW), (const float*)(p.ws + WS_SK), (const float*)(p.ws + WS_SV), (const float*)(p.ws + WS_SA), (const float*)(p.ws + WS_SB)};
    const float* SG = (const float*)(p.ws + WS_SG); const float* S2 = (const float*)(p.ws + WS_S2);
    u16* O = (u16*)(p.ws + WS_O);
    const int cg = lane & 15, rowp = w * 8 + 2 * (lane >> 4);
    for (int u = ulo + bid; u < uhi; u += nb) {
        int h, row0, T; const float* sin; float* sout;
        if (u < 32) { h = u & 7; row0 = (u >> 3) * SEQ; T = SEQ; sin = nullptr; sout = p.out + OUT_WKVP + (size_t)u * 4096; }
        else { const int idx = u - 32; h = idx & 7; row0 = NPROW + (idx >> 3) * 8; T = 8; sin = p.state_wkv + (size_t)idx * 4096; sout = p.out + OUT_WKVS + (size_t)idx * 4096; }
        float s0[4], s1[4];
        if (sin) { const f32x4 a = *(const f32x4*)(sin + rowp * 64 + cg * 4), b = *(const f32x4*)(sin + (rowp + 1) * 64 + cg * 4);
#pragma unroll
            for (int e = 0; e < 4; ++e) { s0[e] = a[e]; s1[e] = b[e]; } }
        else {
#pragma unroll
            for (int e = 0; e < 4; ++e) { s0[e] = 0.f; s1[e] = 0.f; } }
        const int CH = T < SCH ? T : SCH, nch = T / CH;
        const int ptok = tid >> 4, pf4 = tid & 15; const bool pact = ptok < CH;
        f32x4 pf[6];
        if (pact) {
#pragma unroll
            for (int j = 0; j < 6; ++j) pf[j] = *(const f32x4*)(SRC[j] + (size_t)(row0 + ptok) * 512 + h * 64 + pf4 * 4); }
        __syncthreads();
        for (int ch = 0; ch < nch; ++ch) {
            float* L = LB + (ch & 1) * SBUFF; float* ybuf = L + 6 * SARRF;
            if (pact) {
#pragma unroll
                for (int j = 0; j < 6; ++j) *(f32x4*)(L + j * SARRF + ptok * 64 + pf4 * 4) = pf[j]; }
            __syncthreads();
            if (pact && ch + 1 < nch) {
#pragma unroll
                for (int j = 0; j < 6; ++j) pf[j] = *(const f32x4*)(SRC[j] + (size_t)(row0 + (ch + 1) * CH + ptok) * 512 + h * 64 + pf4 * 4); }
            ScanOps oa, ob;
            scan_load(oa, L, 0, cg, rowp);
            for (int t = 0; t < CH; t += 2) {
                scan_load(ob, L, t + 1, cg, rowp);
                scan_step(oa, s0, s1, ybuf, t, cg, rowp);
                scan_load(oa, L, t + 2, cg, rowp);
                scan_step(ob, s0, s1, ybuf, t + 1, cg, rowp);
            }
            __syncthreads();
            for (int tt = w; tt < CH; tt += 8) {
                const int R = row0 + ch * CH + tt;
                const float y = ybuf[tt * 64 + lane];
                const float mean = wave_sum(y) * (1.0f / 64.0f); const float dd = y - mean;
                const float var = wave_sum(dd * dd) * (1.0f / 64.0f);
                const size_t og = (size_t)R * 512 + h * 64 + lane;
                const float outv = dd * rsqrtf(var + 64e-5f) * SG[og] + S2[og];
                O[(size_t)R * DM + 512 + h * 64 + lane] = f2bf(outv);
            }
        }
        { f32x4 a = {s0[0], s0[1], s0[2], s0[3]}, b = {s1[0], s1[1], s1[2], s1[3]}; *(f32x4*)(sout + rowp * 64 + cg * 4) = a; *(f32x4*)(sout + (rowp + 1) * 64 + cg * 4) = b; }
    }
}

typedef __attribute__((address_space(3))) const char* lds_cptr;
typedef short v4i16_t __attribute__((ext_vector_type(4)));
__device__ __forceinline__ s16x4 vtr(lds_cptr ptr) { return __builtin_bit_cast(s16x4, __builtin_amdgcn_ds_read_tr16_b64_v4i16((__attribute__((address_space(3))) v4i16_t*)ptr)); }
__device__ __forceinline__ int crow(int r, int hi) { return (r & 3) + 8 * (r >> 2) + 4 * hi; }

__device__ __forceinline__ void sb_sub(f32x16& x, float& carry, int hi) {
    float t[16], g[4];
#pragma unroll
    for (int r = 0; r < 16; ++r) t[r] = __builtin_amdgcn_exp2f(fminf(x[r], 30.0f));
#pragma unroll
    for (int m = 0; m < 4; ++m) { const float F1 = 1.0f + t[4 * m], F2 = __builtin_fmaf(t[4 * m + 1], F1, F1), F3 = __builtin_fmaf(t[4 * m + 2], F2, F2), F4 = __builtin_fmaf(t[4 * m + 3], F3, F3);
        g[m] = __builtin_amdgcn_rcpf(F4); t[4 * m + 1] = F2 - F1; t[4 * m + 2] = F3 - F2; t[4 * m + 3] = F4 - F3; }
    float cm[4];
#pragma unroll
    for (int m = 0; m < 4; ++m) { auto rr = __builtin_amdgcn_permlane32_swap(__float_as_uint(g[m]), __float_as_uint(g[m]), false, false);
        cm[m] = __uint_as_float(rr[0]) * __uint_as_float(rr[1]); }
    float D[5]; D[4] = carry; D[3] = cm[3] * D[4]; D[2] = cm[2] * D[3]; D[1] = cm[1] * D[2]; D[0] = cm[0] * D[1]; carry = D[0];
#pragma unroll
    for (int m = 0; m < 4; ++m) { const float gH = g[m] * D[m + 1]; const float gL = hi ? gH : D[m];
#pragma unroll
        for (int i = 0; i < 4; ++i) x[4 * m + i] = t[4 * m + i] * gL; }
}

__device__ __forceinline__ void sb_tile(lds_cptr ldsK, lds_cptr ldsV, const bf16x8 (&qr)[4], float bias2, int qrel, int lane, float& carry, f32x16 (&o)[2]) {
    const int r32 = lane & 31, hi = lane >> 5;
    const lds_cptr kp0 = ldsK + hi * 1024 + r32 * 16;
    bf16x8 kf[8];
#pragma unroll
    for (int d0 = 0; d0 < 4; ++d0) { kf[2 * d0] = *(const __attribute__((address_space(3))) bf16x8*)(kp0 + d0 * 2048); kf[2 * d0 + 1] = *(const __attribute__((address_space(3))) bf16x8*)(kp0 + d0 * 2048 + 512); }
    f32x16 C0, C1;
#pragma unroll
    for (int r = 0; r < 16; ++r) { C0[r] = bias2; C1[r] = bias2; }
#pragma unroll
    for (int d0 = 0; d0 < 4; ++d0) { C0 = MFMA32(kf[2 * d0], qr[d0], C0); C1 = MFMA32(kf[2 * d0 + 1], qr[d0], C1); }
    if (qrel >= 0) {
#pragma unroll
        for (int r = 0; r < 16; ++r) { const int kv = crow(r, hi); if (kv >= qrel) C0[r] = -INFINITY; if (kv + 32 >= qrel) C1[r] = -INFINITY; }
    }
    sb_sub(C1, carry, hi); sb_sub(C0, carry, hi);
    u32x4 pw[4];
#pragma unroll
    for (int i = 0; i < 4; ++i) { pw[0][i] = cvtpk(C0[2 * i], C0[2 * i + 1]); pw[1][i] = cvtpk(C0[8 + 2 * i], C0[8 + 2 * i + 1]); pw[2][i] = cvtpk(C1[2 * i], C1[2 * i + 1]); pw[3][i] = cvtpk(C1[8 + 2 * i], C1[8 + 2 * i + 1]); }
    const lds_cptr vp0 = ldsV + ((lane >> 4) & 1) * 32 + (lane & 3) * 8 + (4 * hi + ((lane & 15) >> 2)) * 64;
#pragma unroll
    for (int i = 0; i < 8; ++i) {
        const s16x4 lo = vtr(vp0 + ((i >> 2) * 4096 + (i & 3) * 1024)), hi4 = vtr(vp0 + ((i >> 2) * 4096 + (i & 3) * 1024 + 512));
        const bf16x8 vf = {lo[0], lo[1], lo[2], lo[3], hi4[0], hi4[1], hi4[2], hi4[3]};
        o[i >> 2] = MFMA32(__builtin_bit_cast(bf16x8, pw[i & 3]), vf, o[i >> 2]);
    }
}

constexpr int CP = 144;
constexpr int CMAT = 64 * CP;
constexpr int C_AH = 0, C_BH = CMAT, C_KH = 2 * CMAT, C_RH = 3 * CMAT, C_BBT = 4 * CMAT, C_KBT = 5 * CMAT, C_VT = 6 * CMAT,
              C_AAK = 7 * CMAT, C_ARB = 8 * CMAT, C_ARK = 9 * CMAT, C_N = 10 * CMAT;
constexpr int NPITCH = 68;
constexpr int C_RHS = C_N + 64 * NPITCH * 4;
constexpr int RPITCH = 132;
constexpr int C_GT = C_ARK;
constexpr int C_GC = C_RHS + 64 * RPITCH * 4;
constexpr int C_END = C_GC + 256;
constexpr int C_TW = C_END, C_TA = C_TW + CMAT, C_FEND = C_TA + CMAT;
constexpr int C_LWH = C_N, C_LAH = C_AAK;
constexpr int LWP = 68;
constexpr int C_W1T = C_AH, C_U0T = C_BH;

__device__ __forceinline__ void mm_tile(f32x16& acc, const unsigned char* Lp, const unsigned char* Rp, int lane) {
    const int off = (lane & 31) * CP + (lane >> 5) * 16;
#pragma unroll
    for (int ks = 0; ks < 4; ++ks) {
        const bf16x8 af = *(const bf16x8*)(Lp + off + ks * 32), bf = *(const bf16x8*)(Rp + off + ks * 32);
        acc = MFMA32(af, bf, acc);
    }
}
__device__ __forceinline__ u32x2 pack4(float a, float b, float c, float d) { u32x2 o; o.x = cvtpk(a, b); o.y = cvtpk(c, d); return o; }
__device__ __forceinline__ float sum4rows(float x) {
    auto r1 = __builtin_amdgcn_permlane16_swap(__float_as_uint(x), __float_as_uint(x), false, false);
    const float y = __uint_as_float(r1[0]) + __uint_as_float(r1[1]);
    auto r2 = __builtin_amdgcn_permlane32_swap(__float_as_uint(y), __float_as_uint(y), false, false);
    return __uint_as_float(r2[0]) + __uint_as_float(r2[1]);
}

__device__ __forceinline__ void scanc_s1_core(const Params& p, int cid, unsigned char* smem, int lane, int w, const float (&rr)[8], const float (&ww)[8], const float (&kk)[8], const float (&vv)[8], const float (&aa)[8], const float (&bb)[8]) {
    const int r32 = lane & 31, hi = lane >> 5;
    float* gt = (float*)(smem + C_GT); float* gC = (float*)(smem + C_GC); float* RHS = (float*)(smem + C_RHS); float* Np = (float*)(smem + C_N);
    {
        float g[8]; g[0] = ww[0];
#pragma unroll
        for (int j = 1; j < 8; ++j) g[j] = g[j - 1] * ww[j];
        gt[w * 64 + lane] = g[7];
        __syncthreads();
        float pre = 1.0f, tot = 1.0f;
#pragma unroll
        for (int ww2 = 0; ww2 < 8; ++ww2) { const float x = gt[ww2 * 64 + lane]; tot *= x; if (ww2 < w) pre *= x; }
        if (w == 0) gC[lane] = tot;
        u32x4 bbt, kbt, vtt;
        float bbs[8], kbs[8];
#pragma unroll
        for (int j = 0; j < 8; ++j) {
            const int t = 8 * w + j;
            const float gam = pre * g[j], gprev = j == 0 ? pre : pre * g[j - 1], inv = frcp(gam);
            const float ah = aa[j] * gprev, rh = rr[j] * gam, bhv = bb[j] * inv, khv = kk[j] * inv;
            *(u16*)(smem + C_AH + t * CP + lane * 2) = f2bf(ah); *(u16*)(smem + C_RH + t * CP + lane * 2) = f2bf(rh);
            *(u16*)(smem + C_BH + t * CP + lane * 2) = f2bf(bhv); *(u16*)(smem + C_KH + t * CP + lane * 2) = f2bf(khv);
            RHS[t * RPITCH + lane] = ah;
            bbs[j] = bhv * tot; kbs[j] = khv * tot;
        }
        bbt.x = cvtpk(bbs[0], bbs[1]); bbt.y = cvtpk(bbs[2], bbs[3]); bbt.z = cvtpk(bbs[4], bbs[5]); bbt.w = cvtpk(bbs[6], bbs[7]);
        kbt.x = cvtpk(kbs[0], kbs[1]); kbt.y = cvtpk(kbs[2], kbs[3]); kbt.z = cvtpk(kbs[4], kbs[5]); kbt.w = cvtpk(kbs[6], kbs[7]);
        vtt.x = cvtpk(vv[0], vv[1]); vtt.y = cvtpk(vv[2], vv[3]); vtt.z = cvtpk(vv[4], vv[5]); vtt.w = cvtpk(vv[6], vv[7]);
        *(u32x4*)(smem + C_BBT + lane * CP + w * 16) = bbt; *(u32x4*)(smem + C_KBT + lane * CP + w * 16) = kbt; *(u32x4*)(smem + C_VT + lane * CP + w * 16) = vtt;
    }
    __syncthreads();
    {
        const int Lt = w & 1, Rt = (w >> 1) & 1, tb = w >> 2;
        const unsigned char* Lbase = smem + (Lt ? C_KH : C_BH); const unsigned char* Rbase = smem + (Rt ? C_RH : C_AH);
        const int t = tb * 32 + r32;
#pragma unroll
        for (int ia = 0; ia < 2; ++ia) {
            f32x16 acc;
#pragma unroll
            for (int r = 0; r < 16; ++r) acc[r] = 0.f;
            if (!(ia == 1 && tb == 0)) mm_tile(acc, Lbase + ia * 32 * CP, Rbase + tb * 32 * CP, lane);
#pragma unroll
            for (int r = 0; r < 16; ++r) { const int i = ia * 32 + crow(r, hi); const bool keep = Rt ? (i <= t) : (i < t); if (!keep) acc[r] = 0.f; }
            if (Lt == 0 && Rt == 0) {
#pragma unroll
                for (int r = 0; r < 16; ++r) { const int i = ia * 32 + crow(r, hi); Np[t * NPITCH + (i & 3) * 16 + (i >> 2)] = acc[r]; }
            } else {
                unsigned char* dst = smem + (Rt == 0 ? C_AAK : (Lt == 0 ? C_ARB : C_ARK)) + t * CP;
#pragma unroll
                for (int g4 = 0; g4 < 4; ++g4) *(u32x2*)(dst + (ia * 32 + 8 * g4 + 4 * hi) * 2) = pack4(acc[4 * g4], acc[4 * g4 + 1], acc[4 * g4 + 2], acc[4 * g4 + 3]);
            }
        }
    }
    __syncthreads();
    f32x16 accY, accQ;
#pragma unroll
    for (int r = 0; r < 16; ++r) { accY[r] = 0.f; accQ[r] = 0.f; }
    const int w4 = w & 3, ab = w4 & 1, vb = w4 >> 1;
    if (w < 4) {
        f32x16 acc;
#pragma unroll
        for (int r = 0; r < 16; ++r) acc[r] = 0.f;
        mm_tile(acc, smem + C_AAK + ab * 32 * CP, smem + C_VT + vb * 32 * CP, lane);
#pragma unroll
        for (int r = 0; r < 16; ++r) RHS[(ab * 32 + crow(r, hi)) * RPITCH + 64 + vb * 32 + r32] = acc[r];
    } else {
        mm_tile(accY, smem + C_ARK + ab * 32 * CP, smem + C_VT + vb * 32 * CP, lane);
        mm_tile(accQ, smem + C_KBT + ab * 32 * CP, smem + C_VT + vb * 32 * CP, lane);
    }
    __syncthreads();
    {
        const int cl = lane >> 2, q = lane & 3, col = 16 * w + cl;
        float x[16];
#pragma unroll
        for (int j = 0; j < 16; ++j) x[j] = 0.f;
#pragma unroll
        for (int t = 0; t < 64; ++t) {
            float part = 0.f, part2 = 0.f;
            const float* nrow = Np + t * NPITCH + q * 16;
#pragma unroll
            for (int j4 = 0; j4 < (t + 15) / 16; ++j4) {
                const f32x4 nv = *(const f32x4*)(nrow + 4 * j4);
                part = __builtin_fmaf(nv[0], x[4 * j4], part); part2 = __builtin_fmaf(nv[1], x[4 * j4 + 1], part2);
                part = __builtin_fmaf(nv[2], x[4 * j4 + 2], part); part2 = __builtin_fmaf(nv[3], x[4 * j4 + 3], part2);
            }
            float tot = part + part2; tot += dppf<0xB1>(tot); tot += dppf<0x4E>(tot);
            const float xt = RHS[t * RPITCH + col] + tot;
            x[t >> 2] = (q == (t & 3)) ? xt : x[t >> 2];
        }
        unsigned char* dst = smem + (w < 4 ? C_W1T : C_U0T) + ((w & 3) * 16 + cl) * CP;
#pragma unroll
        for (int j = 0; j < 16; ++j) *(u16*)(dst + (4 * j + q) * 2) = f2bf(x[j]);
    }
    __syncthreads();
    if (w < 4) {
        const int xk = w & 1, yk = w >> 1;
        {
            f32x16 acc;
#pragma unroll
            for (int r = 0; r < 16; ++r) acc[r] = 0.f;
            mm_tile(acc, smem + C_W1T + xk * 32 * CP, smem + C_BBT + yk * 32 * CP, lane);
            const int k = yk * 32 + r32; const float gck = gC[k];
            u16* Pm = (u16*)(p.ws + WS_PM) + (size_t)cid * 4096 + k * 64;
#pragma unroll
            for (int g4 = 0; g4 < 4; ++g4) { const int kp = xk * 32 + 8 * g4 + 4 * hi; float v4[4];
#pragma unroll
                for (int e = 0; e < 4; ++e) v4[e] = acc[4 * g4 + e] + ((kp + e) == k ? gck : 0.f);
                *(u32x2*)(Pm + kp) = pack4(v4[0], v4[1], v4[2], v4[3]); }
        }
        {
            f32x16 acc;
#pragma unroll
            for (int r = 0; r < 16; ++r) acc[r] = 0.f;
            mm_tile(acc, smem + C_W1T + xk * 32 * CP, smem + C_ARB + yk * 32 * CP, lane);
            const int t = yk * 32 + r32;
            u16* Wh = (u16*)(p.ws + WS_WH) + (size_t)cid * 4096 + t * 64;
#pragma unroll
            for (int g4 = 0; g4 < 4; ++g4) { const int k0 = xk * 32 + 8 * g4 + 4 * hi; const u32x2 rh = *(const u32x2*)(smem + C_RH + t * CP + k0 * 2);
                const float r0 = __uint_as_float(rh.x << 16), r1 = __uint_as_float(rh.x & 0xffff0000u), r2 = __uint_as_float(rh.y << 16), r3 = __uint_as_float(rh.y & 0xffff0000u);
                *(u32x2*)(Wh + k0) = pack4(acc[4 * g4] + r0, acc[4 * g4 + 1] + r1, acc[4 * g4 + 2] + r2, acc[4 * g4 + 3] + r3); }
        }
    } else {
        mm_tile(accQ, smem + C_BBT + ab * 32 * CP, smem + C_U0T + vb * 32 * CP, lane);
        mm_tile(accY, smem + C_ARB + ab * 32 * CP, smem + C_U0T + vb * 32 * CP, lane);
        const int v = vb * 32 + r32;
        float* Qm = (float*)(p.ws + WS_QM) + (size_t)cid * 4096 + v * 64; u16* Y0 = (u16*)(p.ws + WS_Y0) + (size_t)cid * 4096 + v * 64;
#pragma unroll
        for (int g4 = 0; g4 < 4; ++g4) { const int a0 = ab * 32 + 8 * g4 + 4 * hi;
            const f32x4 qv = {accQ[4 * g4], accQ[4 * g4 + 1], accQ[4 * g4 + 2], accQ[4 * g4 + 3]}, yv = {accY[4 * g4], accY[4 * g4 + 1], accY[4 * g4 + 2], accY[4 * g4 + 3]};
            *(f32x4*)(Qm + a0) = qv; *(u32x2*)(Y0 + a0) = pack4(yv[0], yv[1], yv[2], yv[3]); }
    }
    __syncthreads();
}

__device__ __forceinline__ float wsum64(float x) { return sum4rows(allred16(x)); }
__device__ __forceinline__ void scanc_fused(const Params& p, int item, unsigned char* smem) {
    const int tid = otid(), lane = tid & 63, r32 = lane & 31, hi = lane >> 5; const int w = __builtin_amdgcn_readfirstlane(tid >> 6);
    const int b = item >> 7, c = (item >> 1) & 63, hq = item & 1;
    const size_t row0 = (size_t)b * SEQ + (size_t)c * 64;
    const float* P = (const float*)(p.ws + WS_P);
    unsigned* GP = (unsigned*)(p.ws + WS_SG);
    const int which = w >> 2, tt = w & 1, kt = (w >> 1) & 1;
    const bool zfirst = (c == 0 && w == 0);
    bf16x8 wf[4]; float xr[9], xk[9], xv[9], xg[9], prm[11];
#define FUSED_FETCH(h_) { const int col_ = (h_) * 64 + lane; \
        const u16* WT_ = (const u16*)(p.ws + (which ? WS_AUPT : WS_WUPT)) + (size_t)((h_) * 64 + kt * 32 + r32) * 64; \
        _Pragma("unroll") for (int ks = 0; ks < 4; ++ks) wf[ks] = *(const bf16x8*)(WT_ + ks * 16 + hi * 8); \
        _Pragma("unroll") for (int j = 0; j < 9; ++j) { const bool z = zfirst && j == 0; const float* prow = P + (row0 + 8 * w + j - 1 + (z ? 1 : 0)) * NINP + 2048 + col_; \
            xr[j] = prow[0]; xk[j] = prow[512]; xv[j] = prow[1024]; xg[j] = prow[1536]; } \
        prm[0] = p.mu[col_]; prm[1] = p.mu[512 + col_]; prm[2] = p.mu[1024 + col_]; prm[3] = p.mu[1536 + col_]; prm[4] = p.w0[col_]; prm[5] = p.a0[col_]; prm[6] = p.k_k[col_]; \
        prm[7] = p.k_a[col_]; prm[8] = p.ln_w[col_]; prm[9] = p.ln_b[col_]; prm[10] = p.r_k[col_]; }
    FUSED_FETCH(hq * 4)
    {
        const int j = tid & 127, tb = (tid >> 7) * 16;
        const float mul = p.mu[2048 + j];
        float raw[16], prev;
#pragma unroll
        for (int k = 0; k < 16; ++k) raw[k] = P[(row0 + tb + k) * NINP + 4096 + j];
        prev = (c == 0 && tb == 0) ? 0.f : P[(row0 + tb - 1) * NINP + 4096 + j];
#pragma unroll
        for (int k = 0; k < 16; ++k) { const float zl = raw[k] + (prev - raw[k]) * mul; prev = raw[k];
            float val = zl; if (j < 64) { const float e2 = __expf(2.0f * zl); val = 1.0f - 2.0f / (e2 + 1.0f); }
            *(u16*)(smem + (j < 64 ? C_TW : C_TA) + (tb + k) * CP + (j & 63) * 2) = f2bf(val); }
        if (c == 63 && hq == 0 && tb == 48) p.out[OUT_SHP + (size_t)b * RWC + 2048 + j] = raw[15];
    }
    __syncthreads();
    for (int hh = 0; hh < 4; ++hh) {
        const int h = hq * 4 + hh, col = h * 64 + lane;
        {
            const unsigned char* Tp = smem + (which ? C_TA : C_TW) + (tt * 32 + r32) * CP;
            f32x16 acc;
#pragma unroll
            for (int r = 0; r < 16; ++r) acc[r] = 0.f;
#pragma unroll
            for (int ks = 0; ks < 4; ++ks) { const bf16x8 bf = *(const bf16x8*)(Tp + ks * 32 + hi * 16); acc = MFMA32(wf[ks], bf, acc); }
            float* L = (float*)(smem + (which ? C_LAH : C_LWH)) + (tt * 32 + r32) * LWP + kt * 32;
#pragma unroll
            for (int g4 = 0; g4 < 4; ++g4) { const f32x4 v4 = {acc[4 * g4], acc[4 * g4 + 1], acc[4 * g4 + 2], acc[4 * g4 + 3]}; *(f32x4*)(L + 8 * g4 + 4 * hi) = v4; }
        }
        __syncthreads();
        float rr[8], ww[8], kk[8], vv[8], aa[8], bb[8];
        if (zfirst) { xr[0] = 0.f; xk[0] = 0.f; xv[0] = 0.f; xg[0] = 0.f; }
        {
            const float mu_r = prm[0], mu_k = prm[1], mu_v = prm[2], mu_g = prm[3], w0c = prm[4], a0c = prm[5], kkc = prm[6], kac = prm[7], lnwc = prm[8], lnbc = prm[9], rkc = prm[10];
            const float* LW = (const float*)(smem + C_LWH); const float* LA = (const float*)(smem + C_LAH);
#pragma unroll
            for (int j = 0; j < 8; ++j) {
                const int t = 8 * w + j; const size_t R = row0 + t;
                const float zr = xr[j + 1] + (xr[j] - xr[j + 1]) * mu_r, zk = xk[j + 1] + (xk[j] - xk[j + 1]) * mu_k, zv = xv[j + 1] + (xv[j] - xv[j + 1]) * mu_v, zg = xg[j + 1] + (xg[j] - xg[j + 1]) * mu_g;
                const float lw = LW[t * LWP + lane], la = LA[t * LWP + lane];
                const float decay = __expf(-0.60653066f * frcp(1.0f + __expf(-(w0c + lw))));
                const float alr = frcp(1.0f + __expf(-(a0c + la)));
                float kn = zk * kkc; const float ss = wsum64(kn * kn); kn = kn * __builtin_amdgcn_rsqf(fmaxf(ss, 1e-24f));
                const float keff = zk * (1.0f + (alr - 1.0f) * kac);
                const float bsum = wsum64(zr * keff * rkc); const float sg = silu_f(zg);
                GP[((size_t)(b * 8 + h) * SEQ + (size_t)c * 64 + t) * 64 + lane] = cvtpk(lnwc * sg, (lnbc + bsum * zv) * sg);
                rr[j] = zr; ww[j] = decay; kk[j] = keff; vv[j] = zv; aa[j] = -kn; bb[j] = kn * alr;
            }
            if (c == 63 && w == 7) { float* sh = p.out + OUT_SHP + (size_t)b * RWC; sh[col] = xr[8]; sh[512 + col] = xk[8]; sh[1024 + col] = xv[8]; sh[1536 + col] = xg[8]; }
        }
        if (hh + 1 < 4) FUSED_FETCH(h + 1)
        scanc_s1_core(p, ((b * 8 + h) << 6) + c, smem, lane, w, rr, ww, kk, vv, aa, bb);
    }
#undef FUSED_FETCH
}

__device__ __forceinline__ void scanc_stage2(const Params& p, int bh, unsigned char* smem) {
    const int tid = otid(), lane = tid & 63, r32 = lane & 31, hi = lane >> 5; const int w = __builtin_amdgcn_readfirstlane(tid >> 6);
    const int xk = w & 1, yv = (w >> 1) & 1;
    const int v = yv * 32 + r32;
    unsigned char* Sb = smem;
    __syncthreads();
    if (w < 4) {
#pragma unroll
        for (int g4 = 0; g4 < 4; ++g4) { u32x2 z = {0u, 0u}; *(u32x2*)(Sb + v * CP + (xk * 32 + 8 * g4 + 4 * hi) * 2) = z; }
    }
    const u16* PmB = (const u16*)(p.ws + WS_PM) + (size_t)bh * 64 * 4096; const float* QmB = (const float*)(p.ws + WS_QM) + (size_t)bh * 64 * 4096;
    u16* SC = (u16*)(p.ws + WS_SC) + (size_t)bh * 64 * 4096;
    bf16x8 pf[4]; f32x4 qf[4];
    if (w < 4) {
#pragma unroll
        for (int ks = 0; ks < 4; ++ks) pf[ks] = *(const bf16x8*)(PmB + (xk * 32 + r32) * 64 + ks * 16 + hi * 8);
#pragma unroll
        for (int g4 = 0; g4 < 4; ++g4) qf[g4] = *(const f32x4*)(QmB + v * 64 + xk * 32 + 8 * g4 + 4 * hi);
    }
    f32x16 acc;
#pragma unroll
    for (int r = 0; r < 16; ++r) acc[r] = 0.f;
    __syncthreads();
    for (int c = 0; c < 64; ++c) {
        if (w < 4) {
#pragma unroll
            for (int g4 = 0; g4 < 4; ++g4) { const int k0 = xk * 32 + 8 * g4 + 4 * hi; *(u32x2*)(SC + (size_t)c * 4096 + v * 64 + k0) = *(const u32x2*)(Sb + v * CP + k0 * 2); }
            bf16x8 pc[4];
#pragma unroll
            for (int ks = 0; ks < 4; ++ks) pc[ks] = pf[ks];
#pragma unroll
            for (int g4 = 0; g4 < 4; ++g4) { acc[4 * g4] = qf[g4][0]; acc[4 * g4 + 1] = qf[g4][1]; acc[4 * g4 + 2] = qf[g4][2]; acc[4 * g4 + 3] = qf[g4][3]; }
            if (c + 1 < 64) {
#pragma unroll
                for (int ks = 0; ks < 4; ++ks) pf[ks] = *(const bf16x8*)(PmB + (size_t)(c + 1) * 4096 + (xk * 32 + r32) * 64 + ks * 16 + hi * 8);
#pragma unroll
                for (int g4 = 0; g4 < 4; ++g4) qf[g4] = *(const f32x4*)(QmB + (size_t)(c + 1) * 4096 + v * 64 + xk * 32 + 8 * g4 + 4 * hi);
            }
#pragma unroll
            for (int ks = 0; ks < 4; ++ks) { const bf16x8 sf = *(const bf16x8*)(Sb + v * CP + ks * 32 + hi * 16); acc = MFMA32(pc[ks], sf, acc); }
        }
        __syncthreads();
        if (w < 4) {
#pragma unroll
            for (int g4 = 0; g4 < 4; ++g4) *(u32x2*)(Sb + v * CP + (xk * 32 + 8 * g4 + 4 * hi) * 2) = pack4(acc[4 * g4], acc[4 * g4 + 1], acc[4 * g4 + 2], acc[4 * g4 + 3]);
        }
        __syncthreads();
    }
    if (w < 4) {
        float* so = p.out + OUT_WKVP + (size_t)bh * 4096 + v * 64;
#pragma unroll
        for (int g4 = 0; g4 < 4; ++g4) { const f32x4 o4 = {acc[4 * g4], acc[4 * g4 + 1], acc[4 * g4 + 2], acc[4 * g4 + 3]}; *(f32x4*)(so + xk * 32 + 8 * g4 + 4 * hi) = o4; }
    }
}

struct S3Ops { u32x2 y0[4]; bf16x8 af[4], bf[4]; };
__device__ __forceinline__ void s3_load(S3Ops& o, const Params& p, int item, int gq, int tb, int vb, int r32, int hi) {
    const int cid = item * 2 + gq, v = vb * 32 + r32;
    const u16* Y0 = (const u16*)(p.ws + WS_Y0) + (size_t)cid * 4096 + v * 64;
    const u16* Wh = (const u16*)(p.ws + WS_WH) + (size_t)cid * 4096 + (tb * 32 + r32) * 64;
    const u16* SC = (const u16*)(p.ws + WS_SC) + (size_t)cid * 4096 + v * 64;
#pragma unroll
    for (int g4 = 0; g4 < 4; ++g4) o.y0[g4] = *(const u32x2*)(Y0 + tb * 32 + 8 * g4 + 4 * hi);
#pragma unroll
    for (int ks = 0; ks < 4; ++ks) { o.af[ks] = *(const bf16x8*)(Wh + ks * 16 + hi * 8); o.bf[ks] = *(const bf16x8*)(SC + ks * 16 + hi * 8); }
}
__device__ __forceinline__ void phase_stage3(const Params& p, int bid, int nb, unsigned char* smem, int nitems) {
    const int tid = otid(), lane = tid & 63, r32 = lane & 31, hi = lane >> 5; const int w = __builtin_amdgcn_readfirstlane(tid >> 6);
    const int gq = w >> 2, w4 = w & 3, tb = w4 & 1, vb = w4 >> 1;
    float* Yb = (float*)smem;
    const unsigned* GP = (const unsigned*)(p.ws + WS_SG);
    u16* O = (u16*)(p.ws + WS_O);
    S3Ops cur;
    if (bid < nitems) s3_load(cur, p, bid, gq, tb, vb, r32, hi);
    for (int item = bid; item < nitems; item += nb) {
        unsigned gp[16];
#pragma unroll
        for (int i = 0; i < 16; ++i) { const int tt = w + 8 * i; const int g = tt >> 6, t = tt & 63, cc = item * 2 + g, bh = cc >> 6, c = cc & 63;
            gp[i] = GP[((size_t)bh * SEQ + (size_t)c * 64 + t) * 64 + lane]; }
        f32x16 acc;
#pragma unroll
        for (int g4 = 0; g4 < 4; ++g4) { acc[4 * g4] = __uint_as_float(cur.y0[g4].x << 16); acc[4 * g4 + 1] = __uint_as_float(cur.y0[g4].x & 0xffff0000u); acc[4 * g4 + 2] = __uint_as_float(cur.y0[g4].y << 16); acc[4 * g4 + 3] = __uint_as_float(cur.y0[g4].y & 0xffff0000u); }
#pragma unroll
        for (int ks = 0; ks < 4; ++ks) acc = MFMA32(cur.af[ks], cur.bf[ks], acc);
        if (item + nb < nitems) s3_load(cur, p, item + nb, gq, tb, vb, r32, hi);
        __syncthreads();
        { const int v = vb * 32 + r32;
#pragma unroll
          for (int r = 0; r < 16; ++r) Yb[gq * 4096 + (tb * 32 + crow(r, hi)) * 64 + v] = acc[r]; }
        __syncthreads();
#pragma unroll
        for (int i = 0; i < 16; ++i) { const int tt = w + 8 * i; const int g = tt >> 6, t = tt & 63, cc = item * 2 + g, bh = cc >> 6, c = cc & 63, b = bh >> 3, h = bh & 7;
            const size_t R = (size_t)b * SEQ + (size_t)c * 64 + t;
            const float yy = Yb[g * 4096 + t * 64 + lane];
            const float mean = wave_sum(yy) * (1.0f / 64.0f); const float dd = yy - mean;
            const float var = wave_sum(dd * dd) * (1.0f / 64.0f);
            O[R * DM + 512 + h * 64 + lane] = f2bf(dd * rsqrtf(var + 64e-5f) * __uint_as_float(gp[i] << 16) + __uint_as_float(gp[i] & 0xffff0000u)); }
    }
}

constexpr int SG_PITCH = 68;
__device__ __forceinline__ void phase_gemm2_sample(const Params& p, int bid, int nb, unsigned char* smem) {
    const int tid = otid(), lane = tid & 63, r32 = lane & 31, hi = lane >> 5; const int w = __builtin_amdgcn_readfirstlane(tid >> 6);
    const u16* Ob = (const u16*)(p.ws + WS_O); const u16* Wt = (const u16*)(p.ws + WS_WOUTT);
    float* Part = (float*)smem;
    for (int tile = bid; tile < 256; tile += nb) {
        const int tr = tile >> 4, tc = tile & 15, R0 = NPROW + tr * 64, n0 = tc * 64, k0 = w * 128;
        const int orow = tid >> 3, oc8 = (tid & 7) * 8;
        const float* xr = p.x_sample + (size_t)(tr * 64 + orow) * DM + n0 + oc8;
        const f32x4 x0 = *(const f32x4*)(xr), x1 = *(const f32x4*)(xr + 4);
        const u16* Ap = Ob + (size_t)(R0 + r32) * DM + k0 + hi * 8; const u16* Bp = Wt + (size_t)(n0 + r32) * DM + k0 + hi * 8;
        f32x16 acc[2][2];
#pragma unroll
        for (int ia = 0; ia < 2; ++ia)
#pragma unroll
            for (int ib = 0; ib < 2; ++ib)
#pragma unroll
                for (int r = 0; r < 16; ++r) acc[ia][ib][r] = 0.f;
#pragma unroll
        for (int ks = 0; ks < 8; ++ks) {
            const bf16x8 a0 = *(const bf16x8*)(Ap + ks * 16), a1 = *(const bf16x8*)(Ap + (size_t)32 * DM + ks * 16);
            const bf16x8 b0 = *(const bf16x8*)(Bp + ks * 16), b1 = *(const bf16x8*)(Bp + (size_t)32 * DM + ks * 16);
            acc[0][0] = MFMA32(a0, b0, acc[0][0]); acc[0][1] = MFMA32(a0, b1, acc[0][1]); acc[1][0] = MFMA32(a1, b0, acc[1][0]); acc[1][1] = MFMA32(a1, b1, acc[1][1]);
        }
        __syncthreads();
#pragma unroll
        for (int ia = 0; ia < 2; ++ia)
#pragma unroll
            for (int ib = 0; ib < 2; ++ib)
#pragma unroll
                for (int r = 0; r < 16; ++r) Part[(w * 64 + ia * 32 + crow(r, hi)) * SG_PITCH + ib * 32 + r32] = acc[ia][ib][r];
        __syncthreads();
        f32x4 s0 = x0, s1 = x1;
#pragma unroll
        for (int ww = 0; ww < 8; ++ww) { const float* pp = Part + (ww * 64 + orow) * SG_PITCH + oc8; s0 += *(const f32x4*)(pp); s1 += *(const f32x4*)(pp + 4); }
        float* dst = p.out + OUT_Y + (size_t)(R0 + orow) * DM + n0 + oc8;
        *(f32x4*)(dst) = s0; *(f32x4*)(dst + 4) = s1;
    }
}
__device__ __forceinline__ void phase_norm_sample(const Params& p, int bid, int nb) {
    const int tid = otid(), lane = tid & 63, w = tid >> 6;
    if (w < 4) {
        for (int r = bid * 4 + w; r < NROWS - NPROW; r += nb * 4) {
            float* src = p.out + OUT_Y + (size_t)(NPROW + r) * DM;
            f32x4 v[4], g[4]; float ss = 0.f;
#pragma unroll
            for (int i = 0; i < 4; ++i) { v[i] = *(const f32x4*)(src + lane * 4 + i * 256); g[i] = *(const f32x4*)(p.norm_f + lane * 4 + i * 256); }
#pragma unroll
            for (int i = 0; i < 4; ++i) ss += v[i][0] * v[i][0] + v[i][1] * v[i][1] + v[i][2] * v[i][2] + v[i][3] * v[i][3];
            ss = wave_sum(ss);
            const float rs = rsqrtf(ss * (1.0f / 1024.0f) + 1e-6f);
#pragma unroll
            for (int i = 0; i < 4; ++i) *(f32x4*)(src + lane * 4 + i * 256) = v[i] * rs * g[i];
        }
    }
}

__device__ __forceinline__ void phase_attn_prompt(const Params& p, int bid, int nb, unsigned char* smem, int uhi) {
    const int tid = otid(), lane = tid & 63, r32 = lane & 31, hi = lane >> 5; const int w = __builtin_amdgcn_readfirstlane(tid >> 6);
    unsigned char* ldsK = smem; unsigned char* ldsV = smem + 8192;
    const u16* Qb = (const u16*)(p.ws + WS_QB); const u16* Kb = (const u16*)(p.ws + WS_KB); const u16* Vb = (const u16*)(p.ws + WS_VB);
    const float* P = (const float*)(p.ws + WS_P); u16* O = (u16*)(p.ws + WS_O);
    for (int u = bid; u < uhi; u += nb) {
        const int qb = 15 - (u >> 5), bh = u & 31, b = bh >> 3, h = bh & 7, q0 = qb * 256, NT = 4 * qb + 4;
        const float bias2 = p.sb_bias[h] * LOG2E;
        const u16* Qw = Qb + ((size_t)bh * SEQ + q0 + w * 32) * 64;
        bf16x8 qr[4];
#pragma unroll
        for (int d0 = 0; d0 < 4; ++d0) qr[d0] = *(const bf16x8*)(Qw + r32 * 64 + d0 * 16 + hi * 8);
        const u16* ksrc = Kb + (size_t)bh * SEQ * 64 + (size_t)lane * 64 + w * 8;
        const u16* vsrc = Vb + (size_t)bh * SEQ * 64 + (size_t)(16 * (w & 3) + (lane >> 2)) * 64 + (w >> 2) * 32 + (lane & 3) * 8;
        const int jw = 4 * qb + (w >> 1), qrel = 32 * (w & 1) + r32;
        float carry = 1.0f; f32x16 o[2];
#pragma unroll
        for (int r = 0; r < 16; ++r) { o[0][r] = 0.f; o[1][r] = 0.f; }
        u32x4 kreg = *(const u32x4*)(ksrc + (size_t)(NT - 1) * 64 * 64), vreg = *(const u32x4*)(vsrc + (size_t)(NT - 1) * 64 * 64);
        for (int j = NT - 1; j >= 0; --j) {
            *(u32x4*)(ldsK + w * 1024 + lane * 16) = kreg; *(u32x4*)(ldsV + w * 1024 + lane * 16) = vreg;
            __syncthreads();
            if (j > 0) { kreg = *(const u32x4*)(ksrc + (size_t)(j - 1) * 64 * 64); vreg = *(const u32x4*)(vsrc + (size_t)(j - 1) * 64 * 64); }
            if (j <= jw) sb_tile((lds_cptr)ldsK, (lds_cptr)ldsV, qr, bias2, j == jw ? qrel : -1, lane, carry, o);
            __syncthreads();
        }
#pragma unroll
        for (int dh = 0; dh < 2; ++dh)
#pragma unroll
            for (int r = 0; r < 16; ++r) { const int R = b * SEQ + q0 + w * 32 + crow(r, hi), dcol = h * 64 + dh * 32 + r32;
                const float g = P[(size_t)R * NINP + 1536 + dcol]; O[(size_t)R * DM + dcol] = f2bf(o[dh][r] * silu_f(g)); }
    }
}

__device__ __forceinline__ void sb_scores32(lds_cptr ldsK, const bf16x8 (&qr)[4], float bias2, int qrel, int lane, float& carry, u32x4 (&pw)[2]) {
    const int r32 = lane & 31, hi = lane >> 5;
    const lds_cptr kp0 = ldsK + hi * 512 + r32 * 16;
    f32x16 C;
#pragma unroll
    for (int r = 0; r < 16; ++r) C[r] = bias2;
#pragma unroll
    for (int d0 = 0; d0 < 4; ++d0) { const bf16x8 kf = *(const __attribute__((address_space(3))) bf16x8*)(kp0 + d0 * 1024); C = MFMA32(kf, qr[d0], C); }
    if (qrel >= 0) {
#pragma unroll
        for (int r = 0; r < 16; ++r) if (crow(r, hi) >= qrel) C[r] = -INFINITY;
    }
    sb_sub(C, carry, hi);
#pragma unroll
    for (int i = 0; i < 4; ++i) { pw[0][i] = cvtpk(C[2 * i], C[2 * i + 1]); pw[1][i] = cvtpk(C[8 + 2 * i], C[8 + 2 * i + 1]); }
}
__device__ __forceinline__ void sb_pv32(lds_cptr ldsV, const u32x4 (&pw)[2], int lane, f32x16 (&o)[2]) {
    const int hi = lane >> 5;
    const lds_cptr vp0 = ldsV + ((lane >> 4) & 1) * 32 + (lane & 3) * 8 + (4 * hi + ((lane & 15) >> 2)) * 64;
#pragma unroll
    for (int i = 0; i < 4; ++i) {
        const s16x4 lo = vtr(vp0 + ((i >> 1) * 2048 + (i & 1) * 1024)), hi4 = vtr(vp0 + ((i >> 1) * 2048 + (i & 1) * 1024 + 512));
        const bf16x8 vf = {lo[0], lo[1], lo[2], lo[3], hi4[0], hi4[1], hi4[2], hi4[3]};
        o[i >> 1] = MFMA32(__builtin_bit_cast(bf16x8, pw[i & 1]), vf, o[i >> 1]);
    }
}
__device__ __forceinline__ void phase_attn_sample(const Params& p, int bid, int nb, unsigned char* smem, int uhi) {
    const int tid = otid(), lane = tid & 63, r32 = lane & 31, hi = lane >> 5; const int w = __builtin_amdgcn_readfirstlane(tid >> 6);
    unsigned char* ldsK = smem + w * 16384; unsigned char* ldsV = ldsK + 4096; unsigned char* stg = ldsK + 8192;
    const u16* Qb = (const u16*)(p.ws + WS_QB) + (size_t)NPROW * 512; const u16* Kb = (const u16*)(p.ws + WS_KB) + (size_t)NPROW * 512; const u16* Vb = (const u16*)(p.ws + WS_VB) + (size_t)NPROW * 512;
    const float* P = (const float*)(p.ws + WS_P); u16* O = (u16*)(p.ws + WS_O);
    const int srow = lane >> 4, sp = lane & 15;
#define AS_DMA_K(kp_) { _Pragma("unroll") for (int i = 0; i < 8; ++i) __builtin_amdgcn_global_load_lds((const unsigned*)((kp_) + (size_t)(i * 4) * 512), (__attribute__((address_space(3))) unsigned*)(stg + i * 1024), 16, 0, 2); }
    for (int u_ = bid; u_ < uhi; u_ += nb) {
        const int bd = (u_ >> 8) * 32 + (u_ & 7) * 4 + ((u_ >> 6) & 3), h = (u_ >> 3) & 7, u = bd * 8 + h;
        const float bias2 = p.sb_bias[h] * LOG2E;
        const int pg_lo = p.page_table[bd * 16 + 2 * w], pg_hi = p.page_table[bd * 16 + 2 * w + 1];
        bf16x8 qr[4];
#pragma unroll
        for (int d0 = 0; d0 < 4; ++d0) qr[d0] = *(const bf16x8*)(Qb + ((size_t)u * 8 + (r32 & 7)) * 64 + d0 * 16 + hi * 8);
        float carry = 1.0f; f32x16 o[2];
#pragma unroll
        for (int r = 0; r < 16; ++r) { o[0][r] = 0.f; o[1][r] = 0.f; }
        u32x4 pw[2];
        __syncthreads();
        f32x4 vx[8];
        { const size_t rb = (size_t)pg_hi * 128 + 96;
          const float* kp = p.cache_k + ((rb + srow) * 8 + h) * 64 + sp * 4; const float* vp = p.cache_v + ((rb + srow) * 8 + h) * 64 + sp * 4;
          AS_DMA_K(kp)
#pragma unroll
          for (int i = 0; i < 8; ++i) vx[i] = __builtin_nontemporal_load((const f32x4*)(vp + (size_t)(i * 4) * 512)); }
        if (w == 7) {
#pragma unroll
            for (int c8 = 0; c8 < 4; ++c8) { const int cc = c8 * 2 + hi; u32x4 kv = {0u, 0u, 0u, 0u}; if (r32 < 8) kv = *(const u32x4*)(Kb + ((size_t)u * 8 + r32) * 64 + cc * 8); *(u32x4*)(ldsK + cc * 512 + r32 * 16) = kv; }
#pragma unroll
            for (int i = 0; i < 4; ++i) { const int row = (lane >> 2) + 16 * (i & 1), dh = i >> 1; u32x4 vv = {0u, 0u, 0u, 0u};
                if (row < 8) vv = *(const u32x4*)(Vb + ((size_t)u * 8 + row) * 64 + dh * 32 + (lane & 3) * 8);
                *(u32x4*)(ldsV + dh * 2048 + row * 64 + (lane & 3) * 16) = vv; }
            asm volatile("s_waitcnt lgkmcnt(0)" ::: "memory");
            sb_scores32((lds_cptr)ldsK, qr, bias2, r32, lane, carry, pw);
            sb_pv32((lds_cptr)ldsV, pw, lane, o);
            asm volatile("" ::: "memory");
        }
        for (int st = 7; st >= 0; --st) {
            asm volatile("s_waitcnt vmcnt(0)" ::: "memory");
#pragma unroll
            for (int i = 0; i < 8; ++i) { const int row = i * 4 + srow; const f32x4 kx = *(const f32x4*)(stg + i * 1024 + lane * 16);
                u32x2 k2; k2.x = cvtpk(kx[0], kx[1]); k2.y = cvtpk(kx[2], kx[3]);
                *(u32x2*)(ldsK + (sp >> 1) * 512 + row * 16 + (sp & 1) * 8) = k2; }
#pragma unroll
            for (int i = 0; i < 8; ++i) { const int row = i * 4 + srow; u32x2 v2; v2.x = cvtpk(vx[i][0], vx[i][1]); v2.y = cvtpk(vx[i][2], vx[i][3]);
                *(u32x2*)(ldsV + (sp >> 3) * 2048 + row * 64 + (sp & 7) * 8) = v2; }
            asm volatile("s_waitcnt lgkmcnt(0)" ::: "memory");
            if (st > 0) { const int stn = st - 1; const int pagen = (stn >> 2) ? pg_hi : pg_lo; const size_t rbn = (size_t)pagen * 128 + 32 * (stn & 3);
                const float* kpn = p.cache_k + ((rbn + srow) * 8 + h) * 64 + sp * 4; const float* vpn = p.cache_v + ((rbn + srow) * 8 + h) * 64 + sp * 4;
                AS_DMA_K(kpn)
#pragma unroll
                for (int i = 0; i < 8; ++i) vx[i] = __builtin_nontemporal_load((const f32x4*)(vpn + (size_t)(i * 4) * 512)); }
            sb_scores32((lds_cptr)ldsK, qr, bias2, -1, lane, carry, pw);
            sb_pv32((lds_cptr)ldsV, pw, lane, o);
            asm volatile("" ::: "memory");
        }
#undef AS_DMA_K
        __syncthreads();
        float* Ob = (float*)smem;
        float* Tt = (float*)(smem + 16384);
#pragma unroll
        for (int dh = 0; dh < 2; ++dh)
#pragma unroll
            for (int r = 0; r < 4; ++r) Ob[(w * 8 + 4 * hi + r) * 64 + dh * 32 + r32] = o[dh][r];
        if (r32 < 8 && hi == 0) Tt[w * 8 + r32] = carry;
        __syncthreads();
        { const int q = tid >> 6, d = tid & 63; float acc = 0.f, suf = 1.0f;
#pragma unroll
          for (int ww = 7; ww >= 0; --ww) { acc += Ob[(ww * 8 + q) * 64 + d] * suf; suf *= Tt[ww * 8 + q]; }
          const int R = NPROW + bd * 8 + q, dcol = h * 64 + d;
          const float g = P[(size_t)R * NINP + 1536 + dcol]; O[(size_t)R * DM + dcol] = f2bf(acc * silu_f(g)); }
    }
}

struct EpiIn {
    static constexpr bool PERM = false, AFTER_DRAIN = false;
    float* P; float* out; u16* Qb; u16* Kb; u16* Vb;
    __device__ __forceinline__ void operator()(const pg8::f32x4 (&acc)[2][2][4][2], const pg8::Unit& u, int wr, int wc, int fr, int fq) const {
        const int row0 = u.pm * 256 + wr * 64 + fr, colt = u.pn * 256, col0 = colt + wc * 32 + 4 * fq;
        if (colt >= 1536) {
#pragma unroll
            for (int ai = 0; ai < 2; ++ai)
#pragma unroll
                for (int m = 0; m < 4; ++m) { float* rowp = P + (size_t)(row0 + ai * 128 + m * 16) * NINP + col0;
#pragma unroll
                    for (int bj = 0; bj < 2; ++bj)
#pragma unroll
                        for (int n = 0; n < 2; ++n) *(pg8::f32x4*)(rowp + bj * 128 + n * 16) = acc[ai][bj][m][n]; }
        } else {
            const int type = colt >> 9;
            const bool prompt = u.pm < 64;
            const float sc = type == 0 ? 0.125f * LOG2E : 1.0f;
            const int c0 = (colt & 511) + wc * 32 + 4 * fq, h0 = c0 >> 6, d0 = c0 & 63, rr0 = row0 - NPROW;
            u16* b16 = Qb + (size_t)type * ((size_t)NROWS * 512) + (prompt ? ((size_t)(((row0 >> 12) * 8 + h0) * SEQ + (row0 & 4095))) * 64 + d0
                                                                          : (size_t)NPROW * 512 + ((size_t)(((rr0 >> 3) * 8 + h0) * 8 + (rr0 & 7))) * 64 + d0);
            float* o32 = out + (prompt ? OUT_KP + (size_t)(type - 1) * (OUT_VP - OUT_KP) + (size_t)row0 * 512 : OUT_KS + (size_t)(type - 1) * (OUT_VS - OUT_KS) + (size_t)rr0 * 512) + c0;
            const int rstep16 = prompt ? 64 : 512;
            const int hstep16 = prompt ? SEQ * 64 : 512;
#pragma unroll
            for (int ai = 0; ai < 2; ++ai)
#pragma unroll
                for (int m = 0; m < 4; ++m)
#pragma unroll
                    for (int bj = 0; bj < 2; ++bj)
#pragma unroll
                        for (int n = 0; n < 2; ++n) { const pg8::f32x4 v = acc[ai][bj][m][n]; const int dr = ai * 128 + m * 16;
                            u32x2 pk2; pk2.x = cvtpk(v[0] * sc, v[1] * sc); pk2.y = cvtpk(v[2] * sc, v[3] * sc);
                            *(u32x2*)(b16 + (size_t)dr * rstep16 + (size_t)(bj * 2) * hstep16 + n * 16) = pk2;
                            if (type != 0) *(pg8::f32x4*)(o32 + (size_t)dr * 512 + bj * 128 + n * 16) = v; }
        }
    }
};

struct EpiRes {
    static constexpr bool PERM = false, AFTER_DRAIN = false;
    float* C; const float* xp; const float* xs;
    __device__ __forceinline__ void operator()(const pg8::f32x4 (&acc)[2][2][4][2], const pg8::Unit& u, int wr, int wc, int fr, int fq) const {
        const int row0 = u.pm * 256 + wr * 64 + fr, col0 = u.pn * 256 + wc * 32 + 4 * fq;
#pragma unroll
        for (int ai = 0; ai < 2; ++ai)
#pragma unroll
            for (int m = 0; m < 4; ++m) { const int row = row0 + ai * 128 + m * 16; float* rowp = C + (size_t)row * DM + col0;
                const float* xr = (row < NPROW ? xp + (size_t)row * DM : xs + (size_t)(row - NPROW) * DM) + col0;
#pragma unroll
                for (int bj = 0; bj < 2; ++bj)
#pragma unroll
                    for (int n = 0; n < 2; ++n) *(pg8::f32x4*)(rowp + bj * 128 + n * 16) = acc[ai][bj][m][n] + *(const pg8::f32x4*)(xr + bj * 128 + n * 16); }
    }
};

constexpr int PANEL_CNT_WORD = 4608;
struct EpiResNorm {
    static constexpr bool PERM = false, AFTER_DRAIN = true;
    float* C; const float* xp; const float* xs; const float* gain; float* stats; unsigned* ctl;
    __device__ __forceinline__ void fused(const pg8::f32x4 (&acc)[2][2][4][2], const pg8::Unit& u, int wr, int wc, int fr, int fq, PG8_LAS unsigned char* lds, int wid, int lane) const {
        PG8_LAS float* Pt = (PG8_LAS float*)lds;
        PG8_LAS float* Sr = (PG8_LAS float*)(lds + 4096);
        const int row0 = u.pm * 256 + wr * 64 + fr, col0 = u.pn * 256 + wc * 32 + 4 * fq;
        pg8::f32x4 (&hacc)[2][2][4][2] = const_cast<pg8::f32x4 (&)[2][2][4][2]>(acc);
#pragma unroll
        for (int ai = 0; ai < 2; ++ai)
#pragma unroll
            for (int m = 0; m < 4; ++m) { const int row = row0 + ai * 128 + m * 16;
                const float* xr = (row < NPROW ? xp + (size_t)row * DM : xs + (size_t)(row - NPROW) * DM) + col0;
                float s = 0.f;
#pragma unroll
                for (int bj = 0; bj < 2; ++bj)
#pragma unroll
                    for (int n = 0; n < 2; ++n) { const pg8::f32x4 hv = acc[ai][bj][m][n] + *(const pg8::f32x4*)(xr + bj * 128 + n * 16); hacc[ai][bj][m][n] = hv; s += (hv[0] * hv[0] + hv[1] * hv[1]) + (hv[2] * hv[2] + hv[3] * hv[3]); }
                s += __shfl_xor(s, 16); s += __shfl_xor(s, 32);
                if (fq == 0) Pt[(ai * 128 + wr * 64 + m * 16 + fr) * 4 + wc] = s; }
        __syncthreads();
        float* st = stats + (size_t)u.pm * 1024;
        unsigned* cnt = ctl + PANEL_CNT_WORD + 16 * u.pm;
        const int prow = wid * 32 + (lane & 31);
        if (lane < 32) { const float t4 = (Pt[prow * 4] + Pt[prow * 4 + 1]) + (Pt[prow * 4 + 2] + Pt[prow * 4 + 3]);
            __hip_atomic_store(st + prow * 4 + u.pn, t4, __ATOMIC_RELAXED, __HIP_MEMORY_SCOPE_AGENT); }
        asm volatile("s_waitcnt vmcnt(0)" ::: "memory");
        __syncthreads();
        if (threadIdx.x == 0) {
            __hip_atomic_fetch_add(cnt, 1u, __ATOMIC_RELAXED, __HIP_MEMORY_SCOPE_AGENT);
            unsigned spins = 0;
            while (__hip_atomic_load(cnt, __ATOMIC_RELAXED, __HIP_MEMORY_SCOPE_AGENT) < 4u) { __builtin_amdgcn_s_sleep(2); if (++spins > (1u << 22)) break; }
        }
        __syncthreads();
        if (lane < 32) { float tot = 0.f;
#pragma unroll
            for (int k = 0; k < 4; ++k) tot += __hip_atomic_load(st + prow * 4 + k, __ATOMIC_RELAXED, __HIP_MEMORY_SCOPE_AGENT);
            Sr[prow] = rsqrtf(tot * (1.0f / 1024.0f) + 1e-6f); }
        __syncthreads();
#pragma unroll
        for (int ai = 0; ai < 2; ++ai)
#pragma unroll
            for (int m = 0; m < 4; ++m) { const int row = row0 + ai * 128 + m * 16; float* rowp = C + (size_t)row * DM + col0;
                const float rs = Sr[ai * 128 + wr * 64 + m * 16 + fr];
#pragma unroll
                for (int bj = 0; bj < 2; ++bj)
#pragma unroll
                    for (int n = 0; n < 2; ++n) { const pg8::f32x4 hv = hacc[ai][bj][m][n]; const pg8::f32x4 gv = *(const pg8::f32x4*)(gain + col0 + bj * 128 + n * 16);
                        *(pg8::f32x4*)(rowp + bj * 128 + n * 16) = hv * rs * gv; } }
        __syncthreads();
    }
};

__device__ __forceinline__ void phase_final(const Params& p, int bid, int nb) {
    const int tid = otid(), lane = tid & 63, w = tid >> 6;
    f32x4 g[4];
#pragma unroll
    for (int i = 0; i < 4; ++i) g[i] = *(const f32x4*)(p.norm_f + lane * 4 + i * 256);
    for (int row = bid * 8 + w; row < NROWS; row += nb * 8) {
        float* src = p.out + (size_t)row * DM;
        f32x4 v[4]; float ss = 0.f;
#pragma unroll
        for (int i = 0; i < 4; ++i) { v[i] = *(const f32x4*)(src + lane * 4 + i * 256); ss += v[i][0] * v[i][0] + v[i][1] * v[i][1] + v[i][2] * v[i][2] + v[i][3] * v[i][3]; }
        ss = wave_sum(ss);
        const float rs = rsqrtf(ss * (1.0f / 1024.0f) + 1e-6f);
#pragma unroll
        for (int i = 0; i < 4; ++i) *(f32x4*)(src + lane * 4 + i * 256) = v[i] * rs * g[i];
    }
}

struct OneUnitOrder { int pm, pn;
    __device__ __forceinline__ bool next(int i, pg8::Unit& u) const { if (i != 0) return false; u.pm = pm; u.pn = pn; return true; }
    __device__ __forceinline__ void a_ready(const pg8::Unit&) const {}
    __device__ __forceinline__ void done(const pg8::Unit&) const {} };
constexpr int LDS_MAIN = 162048;
constexpr int LDS_BYTES = LDS_MAIN + 16;
static_assert(C_FEND <= LDS_MAIN, "stage-1 LDS map");
static_assert(PREP_END <= LDS_MAIN, "prep LDS map");
constexpr int WQ_WORD = XCD_BAR_WORDS + 64;
constexpr int CTL_BYTES = 32768;
__global__ __launch_bounds__(512, 2) __attribute__((target("no-packed-fp32-ops"))) void k_mega(Params p) {
    extern __shared__ __attribute__((aligned(16))) unsigned char shm[];
    const int bid = blockIdx.x, nb = gridDim.x;
    volatile LAS unsigned* xbw = (volatile LAS unsigned*)(shm + LDS_MAIN);
    volatile LAS unsigned* slot = (volatile LAS unsigned*)(shm + LDS_MAIN + 8);
    if (threadIdx.x == 0) { xbw[0] = 0u; xbw[1] = 0u; slot[0] = 0u; slot[1] = 0u; }
    __syncthreads();
    unsigned* bar = (unsigned*)(p.ws + WS_BAR);
    XcdBarrier xb = xcd_barrier_post(bar, xbw);
#define WQ_LOOP(Q, N, ...) { unsigned nxt_ = 0u; if (threadIdx.x == 0) nxt_ = __hip_atomic_fetch_add(bar + WQ_WORD + 64 * (Q), 1u, __ATOMIC_RELAXED, __HIP_MEMORY_SCOPE_AGENT); \
      for (;;) { __syncthreads(); if (threadIdx.x == 0) slot[0] = nxt_; __syncthreads(); const int item = __builtin_amdgcn_readfirstlane((int)slot[0]); if (item >= (N)) break; \
        if (threadIdx.x == 0) nxt_ = __hip_atomic_fetch_add(bar + WQ_WORD + 64 * (Q), 1u, __ATOMIC_RELAXED, __HIP_MEMORY_SCOPE_AGENT); __VA_ARGS__; } }
    phase_prologue(p, bid, nb, shm);
    xcd_barrier(xb);
    { pg8::Gemm g{(const pg8::bf16_t*)(p.ws + WS_XB), (const pg8::bf16_t*)(p.ws + WS_WINT), NROWS, NINP, DM}; pg8::StaticOrder S; S.init(NROWS, NINP, nb, bid);
      EpiIn E{(float*)(p.ws + WS_P), p.out, (u16*)(p.ws + WS_QB), (u16*)(p.ws + WS_KB), (u16*)(p.ws + WS_VB)}; pg8::gemm_phase<EpiIn, pg8::StaticOrder, false>((PG8_LAS unsigned char*)shm, g, S, E, nullptr); }
    { const int ntiles_ = (NROWS / 256) * (NINP / 256), rounds_ = (ntiles_ + nb - 1) / nb, sbase_ = ntiles_ - (rounds_ - 1) * nb, nidle_ = nb - sbase_;
      if (nidle_ > 0) { if (bid >= sbase_) phase_wout_tiles(p, bid - sbase_, nidle_, shm); } else phase_wout_tiles(p, bid, nb, shm); }
    xcd_barrier(xb);
    WQ_LOOP(7, 128, phase_prep_unit(p, item + 512, shm));
    if ((bid >> 6) & 1) {
        for (int it = bid; it < 768; it += nb) phase_attn_sample(p, it, 1 << 30, shm, 1024);
        for (int it = bid; it < 512; it += nb) scanc_fused(p, it, shm);
    } else {
        for (int it = bid; it < 512; it += nb) scanc_fused(p, it, shm);
        for (int it = bid; it < 768; it += nb) phase_attn_sample(p, it, 1 << 30, shm, 1024);
    }
    xcd_barrier(xb);
    for (int s_ = nb - 1 - bid; s_ < 32; s_ += nb) scanc_stage2(p, s_, shm);
    for (int it = bid; it < 256; it += nb) phase_attn_prompt(p, it, 1 << 30, shm, 512);
    for (int it = bid; it < 256; it += nb) phase_attn_sample(p, it + 768, 1 << 30, shm, 1024);
    WQ_LOOP(1, 256, phase_attn_prompt(p, item + 256, 1 << 30, shm, 512));
    WQ_LOOP(3, 1024, phase_scan(p, item + 32, 1 << 30, shm, 0, 1056));
    xcd_barrier(xb);
    phase_gemm2_sample(p, bid, nb, shm);
    phase_stage3(p, bid, nb, shm, 1024);
#undef WQ_LOOP
    xcd_barrier(xb);
    phase_norm_sample(p, bid, nb);
    for (int uu = bid; uu < 256; uu += nb) {
        pg8::Gemm g{(const pg8::bf16_t*)(p.ws + WS_O), (const pg8::bf16_t*)(p.ws + WS_WOUTT), NROWS, DM, DM}; OneUnitOrder S1u; const int ix_ = uu >> 3; S1u.pm = (uu & 7) * 8 + (ix_ >> 2); S1u.pn = ix_ & 3;
        EpiResNorm E{p.out, p.x_prompt, p.x_sample, p.norm_f, (float*)(p.ws + WS_STATS), bar}; pg8::gemm_phase<EpiResNorm, OneUnitOrder, false>((PG8_LAS unsigned char*)shm, g, S1u, E, nullptr);
    }
}

extern "C" void kernel_launch(void* const* d_in, const int* in_sizes, int n_in, void* d_out, int out_size, void* d_ws, size_t ws_size, hipStream_t stream) {
    if (ws_size < WS_END) { fprintf(stderr, "kernel_launch: workspace too small (%zu < %zu)\n", ws_size, (size_t)WS_END); return; }
    static int grid = 0;
    if (!grid) {
        int dev = 0, cus = 0, per_cu = 0;
        (void)hipGetDevice(&dev); (void)hipDeviceGetAttribute(&cus, hipDeviceAttributeMultiprocessorCount, dev);
        (void)hipFuncSetAttribute((const void*)k_mega, hipFuncAttributeMaxDynamicSharedMemorySize, LDS_BYTES);
        (void)hipOccupancyMaxActiveBlocksPerMultiprocessor(&per_cu, (const void*)k_mega, 512, LDS_BYTES);
        if (per_cu < 1) { fprintf(stderr, "kernel_launch: occupancy query says %d blocks per CU\n", per_cu); per_cu = 1; }
        grid = cus > 0 ? cus : 256;
    }
    Params p{};
    p.x_prompt = (const float*)d_in[0]; p.x_sample = (const float*)d_in[1]; p.cache_k = (const float*)d_in[2]; p.cache_v = (const float*)d_in[3]; p.page_table = (const int*)d_in[4];
    p.state_wkv = (const float*)d_in[5]; p.state_shift = (const float*)d_in[6]; p.norm_in = (const float*)d_in[7]; p.w_in = (const float*)d_in[8]; p.sb_bias = (const float*)d_in[9];
    p.mu = (const float*)d_in[10]; p.w0 = (const float*)d_in[11]; p.w_up = (const float*)d_in[12]; p.a0 = (const float*)d_in[13]; p.a_up = (const float*)d_in[14];
    p.k_k = (const float*)d_in[15]; p.k_a = (const float*)d_in[16]; p.r_k = (const float*)d_in[17]; p.ln_w = (const float*)d_in[18]; p.ln_b = (const float*)d_in[19];
    p.w_out = (const float*)d_in[20]; p.norm_f = (const float*)d_in[21];
    p.out = (float*)d_out; p.ws = (unsigned char*)d_ws;
    (void)hipMemsetAsync((unsigned char*)d_ws + WS_BAR, 0, CTL_BYTES, stream);
    hipLaunchKernelGGL(k_mega, dim3(grid), dim3(512), LDS_BYTES, stream, p);
}
```

```cpp
#include <hip/hip_runtime.h>
#include <stdint.h>
#include <stdio.h>
__device__ __forceinline__ void mk_sync() { __builtin_amdgcn_fence(__ATOMIC_RELEASE, "workgroup"); __builtin_amdgcn_s_barrier(); __builtin_amdgcn_fence(__ATOMIC_ACQUIRE, "workgroup"); }
#define __syncthreads() mk_sync()
namespace pg8 {
#define PG8_LAS __attribute__((address_space(3)))
typedef unsigned short bf16_t;
typedef short bf16x8 __attribute__((ext_vector_type(8)));
typedef float f32x4 __attribute__((ext_vector_type(4)));
typedef unsigned u32x4 __attribute__((ext_vector_type(4)));
constexpr int BM = 256, BK = 64, HALF = 128, HTB = HALF * BK * 2  , STAGE_BYTES = 8 * HTB, NXCD = 8, WGM = 8;

__host__ __device__ __forceinline__ int lds_byte(int r, int c) { const int st = (r >> 4) * 2 + (c >> 5), rr = r & 15, cc = c & 31, ob = rr * 64 + cc * 2; return st * 1024 + (ob ^ (((ob >> 9) & 1) << 5)); }
__host__ __device__ __forceinline__ void stage_rc(int b, int& R, int& C) { const int st = b / 1024, sb = b % 1024, swz = sb ^ (((sb >> 9) & 1) << 5); R = (st >> 1) * 16 + swz / 64; C = (st & 1) * 32 + (swz % 64) / 2; }
__host__ __device__ __forceinline__ int perm32(int rho) { const int n = rho >> 4, i = rho & 15; return 8 * (i >> 2) + 4 * n + (i & 3); }

struct Unit { int pm, pn; };
struct Gemm { const bf16_t* A; const bf16_t* Bt; int M, N, K; };

struct StaticOrder {
    int nM, nN, nwg, G, c;
    __host__ __device__ __forceinline__ void init(int M, int N, int G_, int c_) { nM = M / BM; nN = N / BM; nwg = nM * nN; G = G_; c = c_; }
    __host__ __device__ __forceinline__ bool next(int i, Unit& u) const {
        const long L = (long)i * G + c; if (L >= nwg) return false;
        int wgid = (int)L; { const int q = nwg / NXCD, r = nwg % NXCD, xcd = wgid % NXCD, off = wgid / NXCD; wgid = (xcd < r ? xcd * (q + 1) : r * (q + 1) + (xcd - r) * q) + off; }
        const int nig = WGM * nN, gid = wgid / nig, fm = gid * WGM, gsz = (nM - fm) < WGM ? (nM - fm) : WGM;
        u.pm = fm + ((wgid % nig) % gsz); u.pn = (wgid % nig) / gsz; return true;
    }
    __device__ __forceinline__ void a_ready(const Unit&) const {}
    __device__ __forceinline__ void done(const Unit&) const {}
};
struct CountedOrder : StaticOrder {
    const unsigned* ready; unsigned need; unsigned* tmo;
    __device__ __forceinline__ void a_ready(const Unit& u) const {
        if (threadIdx.x < 64) {
            const unsigned long long t0 = __builtin_amdgcn_s_memrealtime(); unsigned polls = 0;
            while ((unsigned)__builtin_amdgcn_readfirstlane(__hip_atomic_load(ready + 64 * u.pm, __ATOMIC_RELAXED, __HIP_MEMORY_SCOPE_AGENT)) < need) {
                if ((++polls & 255u) == 0u && __builtin_amdgcn_readfirstlane(__hip_atomic_load(tmo, __ATOMIC_RELAXED, __HIP_MEMORY_SCOPE_AGENT)) != 0u) break;
                if (__builtin_amdgcn_s_memrealtime() - t0 > 2000000ull) {
                    if (threadIdx.x == 0) { unsigned expect = 0u; __hip_atomic_compare_exchange_strong(tmo + 1, &expect, 0x600u | (unsigned)(u.pm & 0xff), __ATOMIC_RELAXED, __ATOMIC_RELAXED, __HIP_MEMORY_SCOPE_AGENT); __hip_atomic_store(tmo, 1u, __ATOMIC_RELAXED, __HIP_MEMORY_SCOPE_AGENT); }
                    break; }
                __builtin_amdgcn_s_sleep(2); }
            __builtin_amdgcn_fence(__ATOMIC_ACQUIRE, "agent");
            asm volatile("s_waitcnt vmcnt(0)" ::: "memory");
        }
#if !defined(BROKEN_HOOK_NO_BARRIER)
        asm volatile("" ::: "memory"); __builtin_amdgcn_s_barrier(); asm volatile("" ::: "memory");
#endif
    }
};

__device__ __forceinline__ unsigned cvt_pk_bf16(float lo, float hi) { unsigned r; asm volatile("v_cvt_pk_bf16_f32 %0, %1, %2" : "=v"(r) : "v"(lo), "v"(hi)); return r; }
typedef float f32x2 __attribute__((ext_vector_type(2)));
__device__ __forceinline__ f32x2 gelu_pk(f32x2 v) {
    const f32x2 av = __builtin_elementwise_abs(v), d = av * 0.2316418882f + 1.0f;
    f32x2 t; t.x = __builtin_amdgcn_rcpf(d.x); t.y = __builtin_amdgcn_rcpf(d.y);
    f32x2 q = t * 0.5307027145f + (-0.7265760135f); q = q * t + 0.7107068705f; q = q * t + (-0.142248368f); q = q * t + 0.127414796f; q = q * t;
    const f32x2 s = (v * v) * (-0.72134752044f);
    f32x2 e; e.x = __builtin_amdgcn_exp2f(s.x); e.y = __builtin_amdgcn_exp2f(s.y);
    const f32x2 m = v * (q * e), r = v - m;
    f32x2 o; o.x = v.x < 0.f ? m.x : r.x; o.y = v.y < 0.f ? m.y : r.y; return o;
}

struct EpiF32 {
    static constexpr bool PERM = false, AFTER_DRAIN = false;
    float* C; int ldc; const float* bias;
    __device__ __forceinline__ void operator()(const f32x4 (&acc)[2][2][4][2], const Unit& u, int wr, int wc, int fr, int fq) const {
        const int row0 = u.pm * BM + wr * 64 + fr, col0 = u.pn * BM + wc * 32 + 4 * fq;
        f32x4 bv[2][2];
#pragma unroll
        for (int bj = 0; bj < 2; ++bj)
#pragma unroll
            for (int n = 0; n < 2; ++n) bv[bj][n] = bias ? *(const f32x4*)(bias + col0 + bj * HALF + n * 16) : (f32x4){0.f, 0.f, 0.f, 0.f};
#pragma unroll
        for (int ai = 0; ai < 2; ++ai)
#pragma unroll
            for (int m = 0; m < 4; ++m) { float* rowp = C + (size_t)(row0 + ai * HALF + m * 16) * ldc + col0;
#pragma unroll
                for (int bj = 0; bj < 2; ++bj)
#pragma unroll
                    for (int n = 0; n < 2; ++n) *(f32x4*)(rowp + bj * HALF + n * 16) = acc[ai][bj][m][n] + bv[bj][n]; }
    }
};
template <class Epi, class Sched, bool STAMP = false>
__device__ __forceinline__ void gemm_phase(PG8_LAS unsigned char* lds, const Gemm g, const Sched& S, const Epi& E, unsigned long long* stamps) {
    int tid_ = threadIdx.x; asm volatile("" : "+v"(tid_));
    const int tid = tid_, wid = __builtin_amdgcn_readfirstlane(tid >> 6), lane = tid & 63, wr = wid >> 2, wc = wid & 3, fr = lane & 15, fq = lane >> 4;
    const int K = g.K, nt = K / BK;
    int ts_lo = 0, ts_hi = 0, nts = 0; const unsigned long long rt_entry = STAMP ? (unsigned long long)wall_clock64() : 0ull;
#define PG8_STAMP() do { if (STAMP && wid == 0 && nts < 64) { const unsigned long long _c = (unsigned long long)clock64(); \
        ts_lo = (lane == nts) ? (int)(unsigned)_c : ts_lo; ts_hi = (lane == nts) ? (int)(unsigned)(_c >> 32) : ts_hi; ++nts; } } while (0)
    PG8_STAMP();
    unsigned voffA[2], voffB[2];
#pragma unroll
    for (int i = 0; i < 2; ++i) { int R, C; stage_rc(tid * 16 + i * 8192, R, C); const int Rb = Epi::PERM ? ((R & ~31) + perm32(R & 31)) : R;
        voffA[i] = (unsigned)(R * K + C) * 2u; voffB[i] = (unsigned)(Rb * K + C) * 2u; }
    const size_t kstep = (size_t)(BK * 2);
    const size_t hstep = (size_t)HALF * K * 2;
    const size_t tstep = 2 * hstep;
    const unsigned ldsw = (unsigned)wid * 1024u;
    const int aoff = lds_byte(wr * 64 + fr, fq * 8), boff = lds_byte(wc * 32 + fr, fq * 8);
#define PG8_SA(b, h) (((b) * 2 + (h)) * HTB)
#define PG8_SB(b, h) ((4 + (b) * 2 + (h)) * HTB)
#define PG8_STAGE(bufoff, gbase, voff) do { _Pragma("unroll") for (int _i = 0; _i < 2; ++_i) \
        __builtin_amdgcn_global_load_lds((const unsigned*)((const char*)(gbase) + (voff)[_i]), (PG8_LAS unsigned*)(lds + (bufoff) + ldsw + _i * 8192), 16, 0, 0); } while (0)
#define PG8_LDA(dst, b, h) do { _Pragma("unroll") for (int m = 0; m < 4; ++m) _Pragma("unroll") for (int k = 0; k < 2; ++k) dst[m][k] = *(const PG8_LAS bf16x8*)(lds + PG8_SA(b, h) + aoff + m * 2048 + k * 1024); } while (0)
#define PG8_LDB(dst, b, h) do { _Pragma("unroll") for (int n = 0; n < 2; ++n) _Pragma("unroll") for (int k = 0; k < 2; ++k) dst[n][k] = *(const PG8_LAS bf16x8*)(lds + PG8_SB(b, h) + boff + n * 2048 + k * 1024); } while (0)
#define PG8_MMA(ai, bj, At, Bt) do { __builtin_amdgcn_s_setprio(1); _Pragma("unroll") for (int m = 0; m < 4; ++m) _Pragma("unroll") for (int n = 0; n < 2; ++n) _Pragma("unroll") for (int k = 0; k < 2; ++k) \
        acc[ai][bj][m][n] = __builtin_amdgcn_mfma_f32_16x16x32_bf16(Bt[n][k], At[m][k], acc[ai][bj][m][n], 0, 0, 0); __builtin_amdgcn_s_setprio(0); } while (0)
#define PG8_WAIT_V(n) asm volatile("s_waitcnt vmcnt(" #n ")" ::: "memory")
#define PG8_WAIT_L(n) asm volatile("s_waitcnt lgkmcnt(" #n ")" ::: "memory")
#define PG8_BAR __builtin_amdgcn_s_barrier()
#define PG8_SCHED __builtin_amdgcn_sched_barrier(0)
    Unit cur, nxt; int ui = 0;
    if (!S.next(0, cur)) return;
    f32x4 acc[2][2][4][2];
#pragma unroll
    for (int a = 0; a < 2; ++a)
#pragma unroll
        for (int b = 0; b < 2; ++b)
#pragma unroll
            for (int m = 0; m < 4; ++m)
#pragma unroll
                for (int n = 0; n < 2; ++n) acc[a][b][m][n] = (f32x4){0.f, 0.f, 0.f, 0.f};
    bf16x8 At[4][2], B0[2][2], B1[2][2];
    const char* cA = (const char*)g.A + (size_t)cur.pm * tstep; const char* cB = (const char*)g.Bt + (size_t)cur.pn * tstep;
    S.a_ready(cur);
    PG8_STAGE(PG8_SB(0, 0), cB, voffB); PG8_STAGE(PG8_SA(0, 0), cA, voffA); PG8_STAGE(PG8_SB(0, 1), cB + hstep, voffB); PG8_STAGE(PG8_SA(0, 1), cA + hstep, voffA);
    if (wr == 1) PG8_BAR;
    PG8_WAIT_V(4); PG8_BAR;
    PG8_STAGE(PG8_SB(1, 0), cB + kstep, voffB); PG8_STAGE(PG8_SA(1, 0), cA + kstep, voffA); PG8_STAGE(PG8_SB(1, 1), cB + hstep + kstep, voffB);
    PG8_WAIT_V(6); PG8_BAR;
    PG8_STAMP();
    for (;;) {
        const bool has_next = S.next(ui + 1, nxt);
        const char* nA = has_next ? (const char*)g.A + (size_t)nxt.pm * tstep : cA; const char* nB = has_next ? (const char*)g.Bt + (size_t)nxt.pn * tstep : cB;
        for (int t = 0; t < nt; t += 2) {
            const bool last = (t == nt - 2);
            const char* a1 = cA + (size_t)(t + 1) * kstep;
            const char* a2 = last ? nA : cA + (size_t)(t + 2) * kstep; const char* b2 = last ? nB : cB + (size_t)(t + 2) * kstep;
            const char* a3 = a2 + kstep; const char* b3 = b2 + kstep;
            if (last && has_next) S.a_ready(nxt);
            PG8_LDB(B0, 0, 0); PG8_SCHED; PG8_LDA(At, 0, 0); PG8_STAGE(PG8_SA(1, 1), a1 + hstep, voffA);
            PG8_WAIT_L(8); PG8_BAR; PG8_WAIT_L(0); PG8_MMA(0, 0, At, B0); PG8_BAR; PG8_SCHED;
            PG8_LDB(B1, 0, 1); PG8_STAGE(PG8_SB(0, 0), b2, voffB);
            PG8_BAR; PG8_WAIT_L(0); PG8_MMA(0, 1, At, B1); PG8_BAR;
            PG8_LDA(At, 0, 1); PG8_STAGE(PG8_SA(0, 0), a2, voffA);
            PG8_BAR; PG8_WAIT_L(0); PG8_MMA(1, 0, At, B0); PG8_BAR; PG8_SCHED;
            PG8_STAGE(PG8_SB(0, 1), b2 + hstep, voffB);
            PG8_WAIT_V(6); PG8_BAR; PG8_MMA(1, 1, At, B1); PG8_BAR;
            PG8_LDB(B0, 1, 0); PG8_SCHED; PG8_LDA(At, 1, 0); PG8_STAGE(PG8_SA(0, 1), a2 + hstep, voffA);
            PG8_WAIT_L(8); PG8_BAR; PG8_WAIT_L(0); PG8_MMA(0, 0, At, B0); PG8_BAR; PG8_SCHED;
            PG8_LDB(B1, 1, 1); PG8_STAGE(PG8_SB(1, 0), b3, voffB);
            PG8_BAR; PG8_WAIT_L(0); PG8_MMA(0, 1, At, B1); PG8_BAR;
            PG8_LDA(At, 1, 1); PG8_STAGE(PG8_SA(1, 0), a3, voffA);
            PG8_BAR; PG8_WAIT_L(0); PG8_MMA(1, 0, At, B0); PG8_BAR; PG8_SCHED;
            PG8_STAGE(PG8_SB(1, 1), b3 + hstep, voffB);
            PG8_WAIT_V(6); PG8_BAR; PG8_MMA(1, 1, At, B1); PG8_BAR;
        }
        PG8_STAMP();
        if constexpr (!Epi::AFTER_DRAIN) { E(acc, cur, wr, wc, fr, fq); S.done(cur); }
        PG8_STAMP();
        if (!has_next) break;
#pragma unroll
        for (int a = 0; a < 2; ++a)
#pragma unroll
            for (int b = 0; b < 2; ++b)
#pragma unroll
                for (int m = 0; m < 4; ++m)
#pragma unroll
                    for (int n = 0; n < 2; ++n) acc[a][b][m][n] = (f32x4){0.f, 0.f, 0.f, 0.f};
        cur = nxt; cA = nA; cB = nB; ++ui;
    }
    PG8_WAIT_V(0);
    if (wr == 0) PG8_BAR;
    PG8_BAR;
    if constexpr (Epi::AFTER_DRAIN) { E.fused(acc, cur, wr, wc, fr, fq, lds, wid, lane); S.done(cur); }
    PG8_STAMP();
    if (STAMP && wid == 0) { stamps[lane] = lane < nts ? (((unsigned long long)(unsigned)ts_hi << 32) | (unsigned)ts_lo) : 0ull;
        if (lane == 62) stamps[62] = rt_entry; if (lane == 63) stamps[63] = (unsigned long long)wall_clock64(); }
#undef PG8_STAMP
#undef PG8_SA
#undef PG8_SB
#undef PG8_STAGE
#undef PG8_LDA
#undef PG8_LDB
#undef PG8_MMA
#undef PG8_WAIT_V
#undef PG8_WAIT_L
#undef PG8_BAR
#undef PG8_SCHED
}
}

#define XB_TMO      128
#define XB_XCNT(j)  (256  + 64 * (j))
#define XB_XSUB(j)  (1280 + 64 * (j))
#define XB_XGEN(j)  (2304 + 64 * (j))
#define XB_TOP      3328
#define XB_TOPGEN   3392
#define XCD_BAR_WORDS 3456
#define XB_SPIN_CAP (1u << 18)
#define LAS __attribute__((address_space(3)))

__device__ __forceinline__ unsigned xb_ld(unsigned* p)              { return __hip_atomic_load(p, __ATOMIC_RELAXED, __HIP_MEMORY_SCOPE_AGENT); }
__device__ __forceinline__ unsigned xb_add(unsigned* p, unsigned v) { return __hip_atomic_fetch_add(p, v, __ATOMIC_RELAXED, __HIP_MEMORY_SCOPE_AGENT); }
__device__ __forceinline__ unsigned xb_xcc_id() { return (unsigned)__builtin_amdgcn_s_getreg((3 << 11) | 20) & 0xFu; }
#define XB_SPIN(cond, bar) do { unsigned _sp = 0; while (cond) { __builtin_amdgcn_s_sleep(1); \
    if ((++_sp & 255u) == 0u) { if (xb_ld(&(bar)[XB_TMO])) break; if (_sp > XB_SPIN_CAP) { atomicAdd(&(bar)[XB_TMO], 1u); break; } } } } while (0)

struct XcdBarrier {
    unsigned* bar; unsigned x;
    volatile LAS unsigned* st;
};

__device__ __forceinline__ XcdBarrier xcd_barrier_post(unsigned* bar, volatile LAS unsigned* st) {
    XcdBarrier b; b.bar = bar; b.x = xb_xcc_id(); b.st = st;
    if (threadIdx.x == 0) (void)xb_add(&bar[XB_XCNT(b.x)], 1u);
    return b;
}
__device__ __forceinline__ void xcd_barrier_complete(unsigned* bar, unsigned x, unsigned& nloc, unsigned& nx) {
    const unsigned G = gridDim.x * gridDim.y * gridDim.z;
    unsigned sum, cnt, mine, sp = 0u;
    for (;;) {
        sum = 0u; cnt = 0u; mine = 0u;
#pragma unroll
        for (unsigned j = 0; j < 16; ++j) { const unsigned c = xb_ld(&bar[XB_XCNT(j)]); sum += c; cnt += (c > 0u) ? 1u : 0u; mine = (j == x) ? c : mine; }
        if (sum == G) break;
        __builtin_amdgcn_s_sleep(1);
        if ((++sp & 255u) == 0u) { if (xb_ld(&bar[XB_TMO])) break; if (sp > XB_SPIN_CAP) { atomicAdd(&bar[XB_TMO], 1u); break; } }
    }
    nloc = mine > 0u ? mine : 1u; nx = cnt > 0u ? cnt : 1u;
}

__device__ __forceinline__ void xcd_barrier(const XcdBarrier& b) {
    asm volatile("s_waitcnt vmcnt(0)" ::: "memory");
    __syncthreads();
    if (threadIdx.x == 0) {
        unsigned* bar = b.bar;
        __builtin_amdgcn_s_waitcnt(0);
        unsigned nloc = b.st[0], nx = b.st[1];
        if (nloc == 0u) { xcd_barrier_complete(bar, b.x, nloc, nx); b.st[0] = nloc; b.st[1] = nx; }
        const unsigned old = xb_add(&bar[XB_XSUB(b.x)], 1u);
        const unsigned gen = old / nloc;
        if (old + 1u == (gen + 1u) * nloc) {
            __builtin_amdgcn_fence(__ATOMIC_RELEASE, "agent");
            asm volatile("s_waitcnt vmcnt(0)" ::: "memory");
            const unsigned og = xb_add(&bar[XB_TOP], 1u);
            const unsigned tg = og / nx;
            if (og + 1u == (tg + 1u) * nx) xb_add(&bar[XB_TOPGEN], 1u);
            else XB_SPIN(xb_ld(&bar[XB_TOPGEN]) == tg, bar);
            __builtin_amdgcn_fence(__ATOMIC_ACQUIRE, "agent");
            xb_add(&bar[XB_XGEN(b.x)], 1u);
            asm volatile("s_waitcnt vmcnt(0)" ::: "memory");
        } else {
            XB_SPIN(xb_ld(&bar[XB_XGEN(b.x)]) == gen, bar);
            __builtin_amdgcn_fence(__ATOMIC_ACQUIRE, "agent");
            asm volatile("s_waitcnt vmcnt(0)" ::: "memory");
        }
    }
    __syncthreads();
}

typedef unsigned short u16;
typedef short bf16x8 __attribute__((ext_vector_type(8)));
typedef short s16x4 __attribute__((ext_vector_type(4)));
typedef float f32x16 __attribute__((ext_vector_type(16)));
typedef float f32x4 __attribute__((ext_vector_type(4)));
typedef unsigned u32x4 __attribute__((ext_vector_type(4)));
typedef unsigned u32x2 __attribute__((ext_vector_type(2)));

constexpr int NROWS = 17408, NPROW = 16384, DM = 1024, NIN = 4224, NINP = 4352, SEQ = 4096;
constexpr int RWC = 2176;
constexpr size_t OUT_Y = 0, OUT_KP = 17825792, OUT_VP = 26214400, OUT_WKVP = 34603008, OUT_SHP = 34734080,
                 OUT_KS = 34742784, OUT_VS = 35267072, OUT_WKVS = 35791360, OUT_SHS = 39985664;
constexpr size_t WS_BAR = 0;
constexpr size_t WS_XB = 32768;
constexpr size_t WS_WINT = WS_XB + (size_t)NROWS * DM * 2;
constexpr size_t WS_WOUTT = WS_WINT + (size_t)NINP * DM * 2;
constexpr size_t WS_P = WS_WOUTT + (size_t)DM * DM * 2;
constexpr size_t WS_QB = WS_P + (size_t)NROWS * NINP * 4;
constexpr size_t WS_KB = WS_QB + (size_t)NROWS * 512 * 2;
constexpr size_t WS_VB = WS_KB + (size_t)NROWS * 512 * 2;
constexpr size_t WS_SR = WS_VB + (size_t)NROWS * 512 * 2;
constexpr size_t SARR = (size_t)NROWS * 512 * 4;
constexpr size_t WS_SW = WS_SR + SARR, WS_SK = WS_SW + SARR, WS_SV = WS_SK + SARR, WS_SA = WS_SV + SARR, WS_SB = WS_SA + SARR, WS_SG = WS_SB + SARR, WS_S2 = WS_SG + SARR;
constexpr size_t WS_O = WS_S2 + SARR;
constexpr size_t WS_PM = WS_O + (size_t)NROWS * DM * 2;
constexpr size_t WS_QM = WS_PM + (size_t)2048 * 4096 * 2;
constexpr size_t WS_WH = WS_QM + (size_t)2048 * 4096 * 4;
constexpr size_t WS_Y0 = WS_WH + (size_t)2048 * 4096 * 2;
constexpr size_t WS_SC = WS_Y0 + (size_t)2048 * 4096 * 4;
constexpr size_t WS_WUPT = WS_SC + (size_t)2048 * 4096 * 2;
constexpr size_t WS_AUPT = WS_WUPT + 65536;
constexpr size_t WS_STATS = WS_AUPT + 65536;
constexpr size_t WS_END = WS_STATS + (size_t)68 * 1024 * 4;

struct Params {
    const float* x_prompt; const float* x_sample; const float* cache_k; const float* cache_v; const int* page_table;
    const float* state_wkv; const float* state_shift; const float* norm_in; const float* w_in; const float* sb_bias;
    const float* mu; const float* w0; const float* w_up; const float* a0; const float* a_up; const float* k_k; const float* k_a;
    const float* r_k; const float* ln_w; const float* ln_b; const float* w_out; const float* norm_f;
    float* out; unsigned char* ws;
};

#define LOG2E 1.4426950408889634f
#define MFMA32(a, b, c) __builtin_amdgcn_mfma_f32_32x32x16_bf16(a, b, c, 0, 0, 0)

typedef float f32x2_t __attribute__((ext_vector_type(2)));
typedef __bf16 bf16x2_t __attribute__((ext_vector_type(2)));
__device__ __forceinline__ unsigned cvtpk(float lo, float hi) { const f32x2_t v = {lo, hi}; return __builtin_bit_cast(unsigned, __builtin_convertvector(v, bf16x2_t)); }
__device__ __forceinline__ u16 f2bf(float f) { return (u16)(cvtpk(f, 0.f) & 0xffffu); }
template <int CTRL> __device__ __forceinline__ float dppf(float x) { return __builtin_bit_cast(float, __builtin_amdgcn_update_dpp(0, __builtin_bit_cast(int, x), CTRL, 0xf, 0xf, true)); }
__device__ __forceinline__ float reduce8(float x) { x += dppf<0xB1>(x); x += dppf<0x4E>(x); x += dppf<0x141>(x); return x; }
__device__ __forceinline__ float wave_sum(float x) {
    x += dppf<0xB1>(x); x += dppf<0x4E>(x); x += dppf<0x124>(x); x += dppf<0x128>(x);
    auto r1 = __builtin_amdgcn_permlane16_swap(__float_as_uint(x), __float_as_uint(x), false, false);
    const float y = __uint_as_float(r1[0]) + __uint_as_float(r1[1]);
    auto r2 = __builtin_amdgcn_permlane32_swap(__float_as_uint(y), __float_as_uint(y), false, false);
    return __uint_as_float(r2[0]) + __uint_as_float(r2[1]); }
__device__ __forceinline__ int otid() { int t = threadIdx.x; asm volatile("" : "+v"(t)); return t; }
__device__ __forceinline__ float frcp(float x) { return __builtin_amdgcn_rcpf(x); }
__device__ __forceinline__ float silu_f(float g) { return g * frcp(1.0f + __expf(-g)); }
__device__ __forceinline__ float softplus_f(float x) { return fmaxf(x, 0.f) + __logf(1.0f + __expf(-fabsf(x))); }

__device__ __forceinline__ void phase_prologue(const Params& p, int bid, int nb, unsigned char* smem) {
    const int tid = otid(), lane = tid & 63, w = tid >> 6;
    u16* Xb = (u16*)(p.ws + WS_XB);
    u16* WupT = (u16*)(p.ws + WS_WUPT); u16* AupT = (u16*)(p.ws + WS_AUPT);
    const int e0 = bid * 512 + tid; float up0 = 0.f;
    if (e0 < 65536) { const int which = e0 >> 15, idx = e0 & 32767, cc = idx >> 6, ii = idx & 63; up0 = (which ? p.a_up : p.w_up)[ii * 512 + cc]; }
    float* tileb = (float*)smem;
    u16* WinT = (u16*)(p.ws + WS_WINT); u16* WoutT = (u16*)(p.ws + WS_WOUTT);
    const int NT1 = (NINP / 64) * 16, NT2 = 16 * 16;
    float tv[8], tn[8]; int buf = 0;
    auto tload = [&](int id) {
        const bool first = id < NT1; const int id2 = first ? id : id - NT1; const int nt = id2 / 16, kt = id2 % 16, n0 = nt * 64, k0 = kt * 64;
#pragma unroll
        for (int j = 0; j < 8; ++j) { const int e = tid + 512 * j, kr = e >> 6, nc = e & 63;
            if (first) { tv[j] = (n0 + nc < NIN) ? p.w_in[(size_t)(k0 + kr) * NIN + n0 + nc] : 0.f; tn[j] = p.norm_in[k0 + kr]; }
            else { tv[j] = p.w_out[(size_t)(k0 + kr) * DM + n0 + nc]; tn[j] = 1.0f; } } };
    if (bid < NT1) tload(bid);
    constexpr int NR = 5;
    for (int row = bid * 8 + w; row < NROWS; row += nb * 8 * NR) {
        f32x4 v[NR][4];
#pragma unroll
        for (int k = 0; k < NR; ++k) { const int rk = row + k * nb * 8;
            if (rk < NROWS) { const float* src = rk < NPROW ? p.x_prompt + (size_t)rk * DM : p.x_sample + (size_t)(rk - NPROW) * DM;
#pragma unroll
                for (int i = 0; i < 4; ++i) v[k][i] = *(const f32x4*)(src + lane * 4 + i * 256); }
            else {
#pragma unroll
                for (int i = 0; i < 4; ++i) { const f32x4 z = {0.f, 0.f, 0.f, 0.f}; v[k][i] = z; } } }
#pragma unroll
        for (int k = 0; k < NR; ++k) { const int rk = row + k * nb * 8;
            float ss = 0.f;
#pragma unroll
            for (int i = 0; i < 4; ++i) ss += v[k][i][0] * v[k][i][0] + v[k][i][1] * v[k][i][1] + v[k][i][2] * v[k][i][2] + v[k][i][3] * v[k][i][3];
            ss = wave_sum(ss);
            const float rs = rsqrtf(ss * (1.0f / 1024.0f) + 1e-6f);
            if (rk < NROWS) {
#pragma unroll
                for (int i = 0; i < 4; ++i) { u32x2 o; o.x = cvtpk(v[k][i][0] * rs, v[k][i][1] * rs); o.y = cvtpk(v[k][i][2] * rs, v[k][i][3] * rs); *(u32x2*)(Xb + (size_t)rk * DM + lane * 4 + i * 256) = o; } } }
    }
    if (e0 < 65536) { const int which = e0 >> 15, idx = e0 & 32767, cc = idx >> 6, ii = idx & 63; (which ? AupT : WupT)[cc * 64 + ii] = f2bf(up0); }
    for (int e = e0 + nb * 512; e < 65536; e += nb * 512) { const int which = e >> 15, idx = e & 32767, cc = idx >> 6, ii = idx & 63;
        const float val = (which ? p.a_up : p.w_up)[ii * 512 + cc]; (which ? AupT : WupT)[cc * 64 + ii] = f2bf(val); }
    for (int id = bid; id < NT1; id += nb) {
        const bool first = id < NT1; const int id2 = first ? id : id - NT1; const int nt = id2 / 16, kt = id2 % 16, n0 = nt * 64, k0 = kt * 64;
        float* tile = tileb + buf * (64 * 65);
#pragma unroll
        for (int j = 0; j < 8; ++j) { const int e = tid + 512 * j; tile[(e >> 6) * 65 + (e & 63)] = tv[j] * tn[j]; }
        __syncthreads();
        if (id + nb < NT1) tload(id + nb);
        u16* dst = first ? WinT : WoutT;
#pragma unroll
        for (int j = 0; j < 4; ++j) { const int e = tid + 512 * j, nr = e >> 5, kc = (e & 31) * 2; *(unsigned*)(dst + (size_t)(n0 + nr) * DM + k0 + kc) = cvtpk(tile[kc * 65 + nr], tile[(kc + 1) * 65 + nr]); }
        buf ^= 1;
    }
    __syncthreads();
}

__device__ __forceinline__ void phase_wout_tiles(const Params& p, int idx, int stride, unsigned char* smem) {
    const int tid = otid();
    float* tileb = (float*)smem;
    u16* WoutT = (u16*)(p.ws + WS_WOUTT);
    float tv[8]; int buf = 0;
    auto tload = [&](int id) { const int nt = id / 16, kt = id % 16, n0 = nt * 64, k0 = kt * 64;
#pragma unroll
        for (int j = 0; j < 8; ++j) { const int e = tid + 512 * j, kr = e >> 6, nc = e & 63; tv[j] = p.w_out[(size_t)(k0 + kr) * DM + n0 + nc]; } };
    if (idx < 256) tload(idx);
    __syncthreads();
    for (int id = idx; id < 256; id += stride) {
        const int nt = id / 16, kt = id % 16, n0 = nt * 64, k0 = kt * 64;
        float* tile = tileb + buf * (64 * 65);
#pragma unroll
        for (int j = 0; j < 8; ++j) { const int e = tid + 512 * j; tile[(e >> 6) * 65 + (e & 63)] = tv[j]; }
        __syncthreads();
        if (id + stride < 256) tload(id + stride);
#pragma unroll
        for (int j = 0; j < 4; ++j) { const int e = tid + 512 * j, nr = e >> 5, kc = (e & 31) * 2; *(unsigned*)(WoutT + (size_t)(n0 + nr) * DM + k0 + kc) = cvtpk(tile[kc * 65 + nr], tile[(kc + 1) * 65 + nr]); }
        buf ^= 1;
    }
    __syncthreads();
}

constexpr int PREP_TW = 0, PREP_TA = 32 * 144, PREP_LW = 2 * 32 * 144, PREP_LP = 516, PREP_LA = PREP_LW + 32 * PREP_LP * 4, PREP_END = PREP_LA + 32 * PREP_LP * 4;
struct PrepRow { float xr, xk, xv, xg; };
__device__ __forceinline__ void prep_load(PrepRow& o, const float* prow, int c) { o.xr = prow[2048 + c]; o.xk = prow[2560 + c]; o.xv = prow[3072 + c]; o.xg = prow[3584 + c]; }
__device__ __forceinline__ void phase_prep_unit(const Params& p, int u, unsigned char* smem) {
    const int c = otid(), lane = c & 63, r32 = lane & 31, hi = lane >> 5; const int w = __builtin_amdgcn_readfirstlane(c >> 6);
    const float* P = (const float*)(p.ws + WS_P);
    u16* Qb = (u16*)(p.ws + WS_QB); u16* Kb = (u16*)(p.ws + WS_KB); u16* Vb = (u16*)(p.ws + WS_VB);
    float* SR = (float*)(p.ws + WS_SR); float* SW = (float*)(p.ws + WS_SW); float* SK = (float*)(p.ws + WS_SK); float* SV = (float*)(p.ws + WS_SV);
    float* SA = (float*)(p.ws + WS_SA); float* SBb = (float*)(p.ws + WS_SB); float* SG = (float*)(p.ws + WS_SG); float* S2 = (float*)(p.ws + WS_S2);
    const bool prompt = u < 512; const int bd = u - 512;
    const int t0 = prompt ? (u & 127) * 32 : 0, n = prompt ? 32 : 8;
    const int row0 = prompt ? (u >> 7) * SEQ + t0 : NPROW + bd * 8;
    const bool has_prev_row = prompt && t0 > 0;
    {
        const int j = c & 127, tq = c >> 7, tb = tq * 8;
        if (tb < n) {
            const float mul = p.mu[2048 + j];
            float raw[8], prev;
#pragma unroll
            for (int k = 0; k < 8; ++k) raw[k] = P[(size_t)(row0 + tb + k) * NINP + 4096 + j];
            if (tb > 0 || has_prev_row) prev = P[(size_t)(row0 + tb - 1) * NINP + 4096 + j];
            else prev = prompt ? 0.f : p.state_shift[(size_t)bd * RWC + 2048 + j];
#pragma unroll
            for (int k = 0; k < 8; ++k) { const float zl = raw[k] + (prev - raw[k]) * mul; prev = raw[k];
                float val = zl; if (j < 64) { const float e2 = __expf(2.0f * zl); val = 1.0f - 2.0f / (e2 + 1.0f); }
                *(u16*)(smem + (j < 64 ? PREP_TW : PREP_TA) + (tb + k) * 144 + (j & 63) * 2) = f2bf(val); }
        }
    }
    __syncthreads();
    {
        const u16* WupT = (const u16*)(p.ws + WS_WUPT); const u16* AupT = (const u16*)(p.ws + WS_AUPT);
        float* LW = (float*)(smem + PREP_LW); float* LA = (float*)(smem + PREP_LA);
#pragma unroll
        for (int mt = 0; mt < 2; ++mt) {
            const int crow0 = (2 * w + mt) * 32;
            f32x16 accw, acca;
#pragma unroll
            for (int r = 0; r < 16; ++r) { accw[r] = 0.f; acca[r] = 0.f; }
#pragma unroll
            for (int ks = 0; ks < 4; ++ks) {
                const bf16x8 wa = *(const bf16x8*)(WupT + (crow0 + r32) * 64 + ks * 16 + hi * 8), aa = *(const bf16x8*)(AupT + (crow0 + r32) * 64 + ks * 16 + hi * 8);
                const bf16x8 tw = *(const bf16x8*)(smem + PREP_TW + r32 * 144 + ks * 32 + hi * 16), ta = *(const bf16x8*)(smem + PREP_TA + r32 * 144 + ks * 32 + hi * 16);
                accw = MFMA32(wa, tw, accw); acca = MFMA32(aa, ta, acca);
            }
#pragma unroll
            for (int g4 = 0; g4 < 4; ++g4) { const int cc = crow0 + 8 * g4 + 4 * hi;
                const f32x4 v1 = {accw[4 * g4], accw[4 * g4 + 1], accw[4 * g4 + 2], accw[4 * g4 + 3]}, v2 = {acca[4 * g4], acca[4 * g4 + 1], acca[4 * g4 + 2], acca[4 * g4 + 3]};
                *(f32x4*)(LW + r32 * PREP_LP + cc) = v1; *(f32x4*)(LA + r32 * PREP_LP + cc) = v2; }
        }
    }
    __syncthreads();
    {
        const float* LW = (const float*)(smem + PREP_LW); const float* LA = (const float*)(smem + PREP_LA);
        const float mu_r = p.mu[c], mu_k = p.mu[512 + c], mu_v = p.mu[1024 + c], mu_g = p.mu[1536 + c];
        const float w0c = p.w0[c], a0c = p.a0[c], kkc = p.k_k[c], kac = p.k_a[c], lnwc = p.ln_w[c], lnbc = p.ln_b[c], rkc = p.r_k[c];
        float pr, pk, pv, pg;
        if (has_prev_row) { const float* q = P + (size_t)(row0 - 1) * NINP + 2048; pr = q[c]; pk = q[512 + c]; pv = q[1024 + c]; pg = q[1536 + c]; }
        else if (prompt) { pr = pk = pv = pg = 0.f; }
        else { const float* q = p.state_shift + (size_t)bd * RWC; pr = q[c]; pk = q[512 + c]; pv = q[1024 + c]; pg = q[1536 + c]; }
        PrepRow cur[4], nxt[4];
#pragma unroll
        for (int e = 0; e < 4; ++e) { prep_load(cur[e], P + (size_t)(row0 + e) * NINP, c); nxt[e] = cur[e]; }
        for (int tg = 0; tg < n; tg += 4) {
            if (tg + 4 < n) {
#pragma unroll
                for (int e = 0; e < 4; ++e) prep_load(nxt[e], P + (size_t)(row0 + tg + 4 + e) * NINP, c); }
#pragma unroll
            for (int e = 0; e < 4; ++e) {
            const int t = tg + e; const int R = row0 + t;
            const float xr = cur[e].xr, xk = cur[e].xk, xv = cur[e].xv, xg = cur[e].xg;
            const float zr = xr + (pr - xr) * mu_r, zk = xk + (pk - xk) * mu_k, zv = xv + (pv - xv) * mu_v, zg = xg + (pg - xg) * mu_g;
            const float lw = LW[t * PREP_LP + c], la = LA[t * PREP_LP + c];
            const float xw = -(w0c + lw);
            const float sp = softplus_f(xw);
            const float decay = __expf(-__expf(-sp - 0.5f));
            const float alr = frcp(1.0f + __expf(-(a0c + la)));
            float kk = zk * kkc; const float ss = wave_sum(kk * kk); kk = kk * __builtin_amdgcn_rsqf(fmaxf(ss, 1e-24f));
            const float keff = zk * (1.0f + (alr - 1.0f) * kac);
            const size_t o = (size_t)R * 512 + c;
            const float bsum = wave_sum(zr * keff * rkc); const float sg = silu_f(zg);
            SR[o] = zr; SW[o] = decay; SK[o] = keff; SV[o] = zv; SA[o] = -kk; SBb[o] = kk * alr; SG[o] = lnwc * sg; S2[o] = (lnbc + bsum * zv) * sg;
            if ((prompt && t0 + t == SEQ - 1) || (!prompt && t == 7)) {
                float* sh = prompt ? p.out + OUT_SHP + (size_t)(R >> 12) * RWC : p.out + OUT_SHS + (size_t)bd * RWC;
                sh[c] = xr; sh[512 + c] = xk; sh[1024 + c] = xv; sh[1536 + c] = xg; if (c < 128) sh[2048 + c] = P[(size_t)R * NINP + 4096 + c]; }
            pr = xr; pk = xk; pv = xv; pg = xg;
            }
#pragma unroll
            for (int e = 0; e < 4; ++e) cur[e] = nxt[e];
        }
    }
    __syncthreads();
}

constexpr int SCH = 32;
constexpr int SARRF = SCH * 64 + 64;
constexpr int SBUFF = 6 * SARRF + SCH * 64;
struct ScanOps { f32x4 r, w, k, a, b; float v0, v1; };
__device__ __forceinline__ float allred16(float x) { x += dppf<0xB1>(x); x += dppf<0x4E>(x); x += dppf<0x124>(x); x += dppf<0x128>(x); return x; }
__device__ __forceinline__ void scan_load(ScanOps& o, const float* L, int t, int cg, int rowp) {
    const float* base = L + t * 64 + cg * 4;
    o.r = *(const f32x4*)(base); o.w = *(const f32x4*)(base + SARRF); o.k = *(const f32x4*)(base + 2 * SARRF);
    o.a = *(const f32x4*)(base + 4 * SARRF); o.b = *(const f32x4*)(base + 5 * SARRF);
    const float* vp = L + 3 * SARRF + t * 64 + rowp; o.v0 = vp[0]; o.v1 = vp[1];
}
__device__ __forceinline__ void scan_step(const ScanOps& o, float (&s0)[4], float (&s1)[4], float* ybuf, int t, int cg, int rowp) {
    float d0 = (s0[0] * o.a[0] + s0[1] * o.a[1]) + (s0[2] * o.a[2] + s0[3] * o.a[3]);
    float d1 = (s1[0] * o.a[0] + s1[1] * o.a[1]) + (s1[2] * o.a[2] + s1[3] * o.a[3]);
    float sw0[4], sw1[4];
#pragma unroll
    for (int e = 0; e < 4; ++e) { sw0[e] = __builtin_fmaf(s0[e], o.w[e], o.v0 * o.k[e]); sw1[e] = __builtin_fmaf(s1[e], o.w[e], o.v1 * o.k[e]); }
    d0 = allred16(d0); d1 = allred16(d1);
#pragma unroll
    for (int e = 0; e < 4; ++e) { s0[e] = __builtin_fmaf(d0, o.b[e], sw0[e]); s1[e] = __builtin_fmaf(d1, o.b[e], sw1[e]); }
    float y0 = (s0[0] * o.r[0] + s0[1] * o.r[1]) + (s0[2] * o.r[2] + s0[3] * o.r[3]);
    float y1 = (s1[0] * o.r[0] + s1[1] * o.r[1]) + (s1[2] * o.r[2] + s1[3] * o.r[3]);
    y0 = allred16(y0); y1 = allred16(y1);
    if (cg == 0) { ybuf[t * 64 + rowp] = y0; ybuf[t * 64 + rowp + 1] = y1; }
}
__device__ __forceinline__ void phase_scan(const Params& p, int bid, int nb, unsigned char* smem, int ulo, int uhi) {
    const int tid = otid(), lane = tid & 63, w = tid >> 6;
    float* LB = (float*)smem;
    const float* SRC[6] = {(const float*)(p.ws + WS_SR), (const float*)(p.ws + WS_SW), (const float*)(p.ws + WS_SK), (const float*)(p.ws + WS_SV), (const float*)(p.ws + WS_SA), (const float*)(p.ws + WS_SB)};
    const float* SG = (const float*)(p.ws + WS_SG); const float* S2 = (const float*)(p.ws + WS_S2);
    u16* O = (u16*)(p.ws + WS_O);
    const int cg = lane & 15, rowp = w * 8 + 2 * (lane >> 4);
    for (int u = ulo + bid; u < uhi; u += nb) {
        int h, row0, T; const float* sin; float* sout;
        if (u < 32) { h = u & 7; row0 = (u >> 3) * SEQ; T = SEQ; sin = nullptr; sout = p.out + OUT_WKVP + (size_t)u * 4096; }
        else { const int idx = u - 32; h = idx & 7; row0 = NPROW + (idx >> 3) * 8; T = 8; sin = p.state_wkv + (size_t)idx * 4096; sout = p.out + OUT_WKVS + (size_t)idx * 4096; }
        float s0[4], s1[4];
        if (sin) { const f32x4 a = *(const f32x4*)(sin + rowp * 64 + cg * 4), b = *(const f32x4*)(sin + (rowp + 1) * 64 + cg * 4);
#pragma unroll
            for (int e = 0; e < 4; ++e) { s0[e] = a[e]; s1[e] = b[e]; } }
        else {
#pragma unroll
            for (int e = 0; e < 4; ++e) { s0[e] = 0.f; s1[e] = 0.f; } }
        const int CH = T < SCH ? T : SCH, nch = T / CH;
        const int ptok = tid >> 4, pf4 = tid & 15; const bool pact = ptok < CH;
        f32x4 pf[6];
        if (pact) {
#pragma unroll
            for (int j = 0; j < 6; ++j) pf[j] = *(const f32x4*)(SRC[j] + (size_t)(row0 + ptok) * 512 + h * 64 + pf4 * 4); }
        __syncthreads();
        for (int ch = 0; ch < nch; ++ch) {
            float* L = LB + (ch & 1) * SBUFF; float* ybuf = L + 6 * SARRF;
            if (pact) {
#pragma unroll
                for (int j = 0; j < 6; ++j) *(f32x4*)(L + j * SARRF + ptok * 64 + pf4 * 4) = pf[j]; }
            __syncthreads();
            if (pact && ch + 1 < nch) {
#pragma unroll
                for (int j = 0; j < 6; ++j) pf[j] = *(const f32x4*)(SRC[j] + (size_t)(row0 + (ch + 1) * CH + ptok) * 512 + h * 64 + pf4 * 4); }
            ScanOps oa, ob;
            scan_load(oa, L, 0, cg, rowp);
            for (int t = 0; t < CH; t += 2) {
                scan_load(ob, L, t + 1, cg, rowp);
                scan_step(oa, s0, s1, ybuf, t, cg, rowp);
                scan_load(oa, L, t + 2, cg, rowp);
                scan_step(ob, s0, s1, ybuf, t + 1, cg, rowp);
            }
            __syncthreads();
            for (int tt = w; tt < CH; tt += 8) {
                const int R = row0 + ch * CH + tt;
                const float y = ybuf[tt * 64 + lane];
                const float mean = wave_sum(y) * (1.0f / 64.0f); const float dd = y - mean;
                const float var = wave_sum(dd * dd) * (1.0f / 64.0f);
                const size_t og = (size_t)R * 512 + h * 64 + lane;
                const float outv = dd * rsqrtf(var + 64e-5f) * SG[og] + S2[og];
                O[(size_t)R * DM + 512 + h * 64 + lane] = f2bf(outv);
            }
        }
        { f32x4 a = {s0[0], s0[1], s0[2], s0[3]}, b = {s1[0], s1[1], s1[2], s1[3]}; *(f32x4*)(sout + rowp * 64 + cg * 4) = a; *(f32x4*)(sout + (rowp + 1) * 64 + cg * 4) = b; }
    }
}

typedef __attribute__((address_space(3))) const char* lds_cptr;
typedef short v4i16_t __attribute__((ext_vector_type(4)));
__device__ __forceinline__ s16x4 vtr(lds_cptr ptr) { return __builtin_bit_cast(s16x4, __builtin_amdgcn_ds_read_tr16_b64_v4i16((__attribute__((address_space(3))) v4i16_t*)ptr)); }
__device__ __forceinline__ int crow(int r, int hi) { return (r & 3) + 8 * (r >> 2) + 4 * hi; }

__device__ __forceinline__ void sb_sub(f32x16& x, float& carry, int hi) {
    float t[16], g[4];
#pragma unroll
    for (int r = 0; r < 16; ++r) t[r] = __builtin_amdgcn_exp2f(__builtin_amdgcn_fmed3f(x[r], -3.0e38f, 30.0f));
#pragma unroll
    for (int m = 0; m < 4; ++m) { const float F1 = 1.0f + t[4 * m], F2 = __builtin_fmaf(t[4 * m + 1], F1, F1), F3 = __builtin_fmaf(t[4 * m + 2], F2, F2), F4 = __builtin_fmaf(t[4 * m + 3], F3, F3);
        g[m] = __builtin_amdgcn_rcpf(F4); t[4 * m + 1] = F2 - F1; t[4 * m + 2] = F3 - F2; t[4 * m + 3] = F4 - F3; }
    float cm[4];
#pragma unroll
    for (int m = 0; m < 4; ++m) { auto rr = __builtin_amdgcn_permlane32_swap(__float_as_uint(g[m]), __float_as_uint(g[m]), false, false);
        cm[m] = __uint_as_float(rr[0]) * __uint_as_float(rr[1]); }
    float D[5]; D[4] = carry; D[3] = cm[3] * D[4]; D[2] = cm[2] * D[3]; D[1] = cm[1] * D[2]; D[0] = cm[0] * D[1]; carry = D[0];
#pragma unroll
    for (int m = 0; m < 4; ++m) { const float gH = g[m] * D[m + 1]; const float gL = hi ? gH : D[m];
#pragma unroll
        for (int i = 0; i < 4; ++i) x[4 * m + i] = t[4 * m + i] * gL; }
}

__device__ __forceinline__ void sb_tile(lds_cptr ldsK, lds_cptr ldsV, const bf16x8 (&qr)[4], float bias2, int qrel, int lane, float& carry, f32x16 (&o)[2]) {
    const int r32 = lane & 31, hi = lane >> 5;
    const lds_cptr kp0 = ldsK + hi * 1024 + r32 * 16;
    bf16x8 kf[8];
#pragma unroll
    for (int d0 = 0; d0 < 4; ++d0) { kf[2 * d0] = *(const __attribute__((address_space(3))) bf16x8*)(kp0 + d0 * 2048); kf[2 * d0 + 1] = *(const __attribute__((address_space(3))) bf16x8*)(kp0 + d0 * 2048 + 512); }
    f32x16 C0, C1;
#pragma unroll
    for (int r = 0; r < 16; ++r) { C0[r] = bias2; C1[r] = bias2; }
#pragma unroll
    for (int d0 = 0; d0 < 4; ++d0) { C0 = MFMA32(kf[2 * d0], qr[d0], C0); C1 = MFMA32(kf[2 * d0 + 1], qr[d0], C1); }
    if (qrel >= 0) {
#pragma unroll
        for (int r = 0; r < 16; ++r) { const int kv = crow(r, hi); if (kv >= qrel) C0[r] = -INFINITY; if (kv + 32 >= qrel) C1[r] = -INFINITY; }
    }
    sb_sub(C1, carry, hi); sb_sub(C0, carry, hi);
    u32x4 pw[4];
#pragma unroll
    for (int i = 0; i < 4; ++i) { pw[0][i] = cvtpk(C0[2 * i], C0[2 * i + 1]); pw[1][i] = cvtpk(C0[8 + 2 * i], C0[8 + 2 * i + 1]); pw[2][i] = cvtpk(C1[2 * i], C1[2 * i + 1]); pw[3][i] = cvtpk(C1[8 + 2 * i], C1[8 + 2 * i + 1]); }
    const lds_cptr vp0 = ldsV + ((lane >> 4) & 1) * 32 + (lane & 3) * 8 + (4 * hi + ((lane & 15) >> 2)) * 64;
#pragma unroll
    for (int i = 0; i < 8; ++i) {
        const s16x4 lo = vtr(vp0 + ((i >> 2) * 4096 + (i & 3) * 1024)), hi4 = vtr(vp0 + ((i >> 2) * 4096 + (i & 3) * 1024 + 512));
        const bf16x8 vf = {lo[0], lo[1], lo[2], lo[3], hi4[0], hi4[1], hi4[2], hi4[3]};
        o[i >> 2] = MFMA32(__builtin_bit_cast(bf16x8, pw[i & 3]), vf, o[i >> 2]);
    }
}

constexpr int CP = 144;
constexpr int CMAT = 64 * CP;
constexpr int C_AH = 0, C_BH = CMAT, C_KH = 2 * CMAT, C_RH = 3 * CMAT, C_BBT = 4 * CMAT, C_KBT = 5 * CMAT, C_VT = 6 * CMAT,
              C_AAK = 7 * CMAT, C_ARB = 8 * CMAT, C_ARK = 9 * CMAT, C_N = 10 * CMAT;
constexpr int NPITCH = 68;
constexpr int C_RHS = C_N + 64 * NPITCH * 4;
constexpr int RPITCH = 132;
constexpr int C_GT = C_ARK;
constexpr int C_GC = C_RHS + 64 * RPITCH * 4;
constexpr int C_END = C_GC + 256;
constexpr int C_TW = C_END, C_TA = C_TW + CMAT, C_FEND = C_TA + CMAT;
constexpr int C_LWH = C_N, C_LAH = C_AAK;
constexpr int LWP = 68;
constexpr int C_W1T = C_AH, C_U0T = C_BH;

__device__ __forceinline__ void mm_tile(f32x16& acc, const unsigned char* Lp, const unsigned char* Rp, int lane) {
    const int off = (lane & 31) * CP + (lane >> 5) * 16;
#pragma unroll
    for (int ks = 0; ks < 4; ++ks) {
        const bf16x8 af = *(const bf16x8*)(Lp + off + ks * 32), bf = *(const bf16x8*)(Rp + off + ks * 32);
        acc = MFMA32(af, bf, acc);
    }
}
__device__ __forceinline__ u32x2 pack4(float a, float b, float c, float d) { u32x2 o; o.x = cvtpk(a, b); o.y = cvtpk(c, d); return o; }
__device__ __forceinline__ float sum4rows(float x) {
    auto r1 = __builtin_amdgcn_permlane16_swap(__float_as_uint(x), __float_as_uint(x), false, false);
    const float y = __uint_as_float(r1[0]) + __uint_as_float(r1[1]);
    auto r2 = __builtin_amdgcn_permlane32_swap(__float_as_uint(y), __float_as_uint(y), false, false);
    return __uint_as_float(r2[0]) + __uint_as_float(r2[1]);
}

__device__ __forceinline__ void scanc_s1_core(const Params& p, int cid, unsigned char* smem, int lane, int w, const float (&rr)[8], const float (&ww)[8], const float (&kk)[8], const float (&vv)[8], const float (&aa)[8], const float (&bb)[8]) {
    const int r32 = lane & 31, hi = lane >> 5;
    float* gt = (float*)(smem + C_GT); float* gC = (float*)(smem + C_GC); float* RHS = (float*)(smem + C_RHS); float* Np = (float*)(smem + C_N);
    {
        float g[8]; g[0] = ww[0];
#pragma unroll
        for (int j = 1; j < 8; ++j) g[j] = g[j - 1] * ww[j];
        gt[w * 64 + lane] = g[7];
        __syncthreads();
        float pre = 1.0f, tot = 1.0f;
#pragma unroll
        for (int ww2 = 0; ww2 < 8; ++ww2) { const float x = gt[ww2 * 64 + lane]; tot *= x; if (ww2 < w) pre *= x; }
        if (w == 0) gC[lane] = tot;
        u32x4 bbt, kbt, vtt;
        float bbs[8], kbs[8];
#pragma unroll
        for (int j = 0; j < 8; ++j) {
            const int t = 8 * w + j;
            const float gam = pre * g[j], gprev = j == 0 ? pre : pre * g[j - 1], inv = frcp(gam);
            const float ah = aa[j] * gprev, rh = rr[j] * gam, bhv = bb[j] * inv, khv = kk[j] * inv;
            *(u16*)(smem + C_AH + t * CP + lane * 2) = f2bf(ah); *(u16*)(smem + C_RH + t * CP + lane * 2) = f2bf(rh);
            *(u16*)(smem + C_BH + t * CP + lane * 2) = f2bf(bhv); *(u16*)(smem + C_KH + t * CP + lane * 2) = f2bf(khv);
            RHS[t * RPITCH + lane] = ah;
            bbs[j] = bhv * tot; kbs[j] = khv * tot;
        }
        bbt.x = cvtpk(bbs[0], bbs[1]); bbt.y = cvtpk(bbs[2], bbs[3]); bbt.z = cvtpk(bbs[4], bbs[5]); bbt.w = cvtpk(bbs[6], bbs[7]);
        kbt.x = cvtpk(kbs[0], kbs[1]); kbt.y = cvtpk(kbs[2], kbs[3]); kbt.z = cvtpk(kbs[4], kbs[5]); kbt.w = cvtpk(kbs[6], kbs[7]);
        vtt.x = cvtpk(vv[0], vv[1]); vtt.y = cvtpk(vv[2], vv[3]); vtt.z = cvtpk(vv[4], vv[5]); vtt.w = cvtpk(vv[6], vv[7]);
        *(u32x4*)(smem + C_BBT + lane * CP + w * 16) = bbt; *(u32x4*)(smem + C_KBT + lane * CP + w * 16) = kbt; *(u32x4*)(smem + C_VT + lane * CP + w * 16) = vtt;
    }
    __syncthreads();
    {
        const int Lt = w & 1, Rt = (w >> 1) & 1, tb = w >> 2;
        const unsigned char* Lbase = smem + (Lt ? C_KH : C_BH); const unsigned char* Rbase = smem + (Rt ? C_RH : C_AH);
        const int t = tb * 32 + r32;
#pragma unroll
        for (int ia = 0; ia < 2; ++ia) {
            f32x16 acc;
#pragma unroll
            for (int r = 0; r < 16; ++r) acc[r] = 0.f;
            if (!(ia == 1 && tb == 0)) mm_tile(acc, Lbase + ia * 32 * CP, Rbase + tb * 32 * CP, lane);
#pragma unroll
            for (int r = 0; r < 16; ++r) { const int i = ia * 32 + crow(r, hi); const bool keep = Rt ? (i <= t) : (i < t); if (!keep) acc[r] = 0.f; }
            if (Lt == 0 && Rt == 0) {
#pragma unroll
                for (int r = 0; r < 16; ++r) { const int i = ia * 32 + crow(r, hi); Np[t * NPITCH + (i & 3) * 16 + (i >> 2)] = acc[r]; }
            } else {
                unsigned char* dst = smem + (Rt == 0 ? C_AAK : (Lt == 0 ? C_ARB : C_ARK)) + t * CP;
#pragma unroll
                for (int g4 = 0; g4 < 4; ++g4) *(u32x2*)(dst + (ia * 32 + 8 * g4 + 4 * hi) * 2) = pack4(acc[4 * g4], acc[4 * g4 + 1], acc[4 * g4 + 2], acc[4 * g4 + 3]);
            }
        }
    }
    __syncthreads();
    f32x16 accY, accQ;
#pragma unroll
    for (int r = 0; r < 16; ++r) { accY[r] = 0.f; accQ[r] = 0.f; }
    const int w4 = w & 3, ab = w4 & 1, vb = w4 >> 1;
    if (w < 4) {
        f32x16 acc;
#pragma unroll
        for (int r = 0; r < 16; ++r) acc[r] = 0.f;
        mm_tile(acc, smem + C_AAK + ab * 32 * CP, smem + C_VT + vb * 32 * CP, lane);
#pragma unroll
        for (int r = 0; r < 16; ++r) RHS[(ab * 32 + crow(r, hi)) * RPITCH + 64 + vb * 32 + r32] = acc[r];
    } else {
        mm_tile(accY, smem + C_ARK + ab * 32 * CP, smem + C_VT + vb * 32 * CP, lane);
        mm_tile(accQ, smem + C_KBT + ab * 32 * CP, smem + C_VT + vb * 32 * CP, lane);
    }
    __syncthreads();
    {
        const int cl = lane >> 2, q = lane & 3, col = 16 * w + cl;
        float x[16];
#pragma unroll
        for (int j = 0; j < 16; ++j) x[j] = 0.f;
#pragma unroll
        for (int t = 0; t < 64; ++t) {
            float part = 0.f, part2 = 0.f;
            const float* nrow = Np + t * NPITCH + q * 16;
#pragma unroll
            for (int j4 = 0; j4 < (t + 15) / 16; ++j4) {
                const f32x4 nv = *(const f32x4*)(nrow + 4 * j4);
                part = __builtin_fmaf(nv[0], x[4 * j4], part); part2 = __builtin_fmaf(nv[1], x[4 * j4 + 1], part2);
                part = __builtin_fmaf(nv[2], x[4 * j4 + 2], part); part2 = __builtin_fmaf(nv[3], x[4 * j4 + 3], part2);
            }
            float tot = part + part2; tot += dppf<0xB1>(tot); tot += dppf<0x4E>(tot);
            const float xt = RHS[t * RPITCH + col] + tot;
            x[t >> 2] = (q == (t & 3)) ? xt : x[t >> 2];
        }
        unsigned char* dst = smem + (w < 4 ? C_W1T : C_U0T) + ((w & 3) * 16 + cl) * CP;
#pragma unroll
        for (int j = 0; j < 16; ++j) *(u16*)(dst + (4 * j + q) * 2) = f2bf(x[j]);
    }
    __syncthreads();
    if (w < 4) {
        const int xk = w & 1, yk = w >> 1;
        {
            f32x16 acc;
#pragma unroll
            for (int r = 0; r < 16; ++r) acc[r] = 0.f;
            mm_tile(acc, smem + C_W1T + xk * 32 * CP, smem + C_BBT + yk * 32 * CP, lane);
            const int k = yk * 32 + r32; const float gck = gC[k];
            u16* Pm = (u16*)(p.ws + WS_PM) + (size_t)cid * 4096 + k * 64;
#pragma unroll
            for (int g4 = 0; g4 < 4; ++g4) { const int kp = xk * 32 + 8 * g4 + 4 * hi; float v4[4];
#pragma unroll
                for (int e = 0; e < 4; ++e) v4[e] = acc[4 * g4 + e] + ((kp + e) == k ? gck : 0.f);
                *(u32x2*)(Pm + kp) = pack4(v4[0], v4[1], v4[2], v4[3]); }
        }
        {
            f32x16 acc;
#pragma unroll
            for (int r = 0; r < 16; ++r) acc[r] = 0.f;
            mm_tile(acc, smem + C_W1T + xk * 32 * CP, smem + C_ARB + yk * 32 * CP, lane);
            const int t = yk * 32 + r32;
            u16* Wh = (u16*)(p.ws + WS_WH) + (size_t)cid * 4096 + t * 64;
#pragma unroll
            for (int g4 = 0; g4 < 4; ++g4) { const int k0 = xk * 32 + 8 * g4 + 4 * hi; const u32x2 rh = *(const u32x2*)(smem + C_RH + t * CP + k0 * 2);
                const float r0 = __uint_as_float(rh.x << 16), r1 = __uint_as_float(rh.x & 0xffff0000u), r2 = __uint_as_float(rh.y << 16), r3 = __uint_as_float(rh.y & 0xffff0000u);
                *(u32x2*)(Wh + k0) = pack4(acc[4 * g4] + r0, acc[4 * g4 + 1] + r1, acc[4 * g4 + 2] + r2, acc[4 * g4 + 3] + r3); }
        }
    } else {
        mm_tile(accQ, smem + C_BBT + ab * 32 * CP, smem + C_U0T + vb * 32 * CP, lane);
        mm_tile(accY, smem + C_ARB + ab * 32 * CP, smem + C_U0T + vb * 32 * CP, lane);
        const int v = vb * 32 + r32;
        float* Qm = (float*)(p.ws + WS_QM) + (size_t)cid * 4096 + v * 64; u16* Y0 = (u16*)(p.ws + WS_Y0) + (size_t)cid * 4096 + v * 64;
#pragma unroll
        for (int g4 = 0; g4 < 4; ++g4) { const int a0 = ab * 32 + 8 * g4 + 4 * hi;
            const f32x4 qv = {accQ[4 * g4], accQ[4 * g4 + 1], accQ[4 * g4 + 2], accQ[4 * g4 + 3]}, yv = {accY[4 * g4], accY[4 * g4 + 1], accY[4 * g4 + 2], accY[4 * g4 + 3]};
            *(f32x4*)(Qm + a0) = qv; *(u32x2*)(Y0 + a0) = pack4(yv[0], yv[1], yv[2], yv[3]); }
    }
    __syncthreads();
}

__device__ __forceinline__ float wsum64(float x) { return sum4rows(allred16(x)); }
__device__ __forceinline__ void scanc_fused(const Params& p, int item, unsigned char* smem) {
    const int tid = otid(), lane = tid & 63, r32 = lane & 31, hi = lane >> 5; const int w = __builtin_amdgcn_readfirstlane(tid >> 6);
    const int b = item >> 7, c = (item >> 1) & 63, hq = item & 1;
    const size_t row0 = (size_t)b * SEQ + (size_t)c * 64;
    const float* P = (const float*)(p.ws + WS_P);
    unsigned* GP = (unsigned*)(p.ws + WS_SG);
    const int which = w >> 2, tt = w & 1, kt = (w >> 1) & 1;
    const bool zfirst = (c == 0 && w == 0);
    bf16x8 wf[4]; float xr[9], xk[9], xv[9], xg[9], prm[11];
#define FUSED_FETCH(h_) { const int col_ = (h_) * 64 + lane; \
        const u16* WT_ = (const u16*)(p.ws + (which ? WS_AUPT : WS_WUPT)) + (size_t)((h_) * 64 + kt * 32 + r32) * 64; \
        _Pragma("unroll") for (int ks = 0; ks < 4; ++ks) wf[ks] = *(const bf16x8*)(WT_ + ks * 16 + hi * 8); \
        _Pragma("unroll") for (int j = 0; j < 9; ++j) { const bool z = zfirst && j == 0; const float* prow = P + (row0 + 8 * w + j - 1 + (z ? 1 : 0)) * NINP + 2048 + col_; \
            xr[j] = prow[0]; xk[j] = prow[512]; xv[j] = prow[1024]; xg[j] = prow[1536]; } \
        prm[0] = p.mu[col_]; prm[1] = p.mu[512 + col_]; prm[2] = p.mu[1024 + col_]; prm[3] = p.mu[1536 + col_]; prm[4] = p.w0[col_]; prm[5] = p.a0[col_]; prm[6] = p.k_k[col_]; \
        prm[7] = p.k_a[col_]; prm[8] = p.ln_w[col_]; prm[9] = p.ln_b[col_]; prm[10] = p.r_k[col_]; }
    FUSED_FETCH(hq * 4)
    {
        const int j = tid & 127, tb = (tid >> 7) * 16;
        const float mul = p.mu[2048 + j];
        float raw[16], prev;
#pragma unroll
        for (int k = 0; k < 16; ++k) raw[k] = P[(row0 + tb + k) * NINP + 4096 + j];
        prev = (c == 0 && tb == 0) ? 0.f : P[(row0 + tb - 1) * NINP + 4096 + j];
#pragma unroll
        for (int k = 0; k < 16; ++k) { const float zl = raw[k] + (prev - raw[k]) * mul; prev = raw[k];
            float val = zl; if (j < 64) { const float e2 = __expf(2.0f * zl); val = 1.0f - 2.0f / (e2 + 1.0f); }
            *(u16*)(smem + (j < 64 ? C_TW : C_TA) + (tb + k) * CP + (j & 63) * 2) = f2bf(val); }
        if (c == 63 && hq == 0 && tb == 48) p.out[OUT_SHP + (size_t)b * RWC + 2048 + j] = raw[15];
    }
    __syncthreads();
    for (int hh = 0; hh < 4; ++hh) {
        const int h = hq * 4 + hh, col = h * 64 + lane;
        {
            const unsigned char* Tp = smem + (which ? C_TA : C_TW) + (tt * 32 + r32) * CP;
            f32x16 acc;
#pragma unroll
            for (int r = 0; r < 16; ++r) acc[r] = 0.f;
#pragma unroll
            for (int ks = 0; ks < 4; ++ks) { const bf16x8 bf = *(const bf16x8*)(Tp + ks * 32 + hi * 16); acc = MFMA32(wf[ks], bf, acc); }
            float* L = (float*)(smem + (which ? C_LAH : C_LWH)) + (tt * 32 + r32) * LWP + kt * 32;
#pragma unroll
            for (int g4 = 0; g4 < 4; ++g4) { const f32x4 v4 = {acc[4 * g4], acc[4 * g4 + 1], acc[4 * g4 + 2], acc[4 * g4 + 3]}; *(f32x4*)(L + 8 * g4 + 4 * hi) = v4; }
        }
        __syncthreads();
        float rr[8], ww[8], kk[8], vv[8], aa[8], bb[8];
        if (zfirst) { xr[0] = 0.f; xk[0] = 0.f; xv[0] = 0.f; xg[0] = 0.f; }
        {
            const float mu_r = prm[0], mu_k = prm[1], mu_v = prm[2], mu_g = prm[3], w0c = prm[4], a0c = prm[5], kkc = prm[6], kac = prm[7], lnwc = prm[8], lnbc = prm[9], rkc = prm[10];
            const float* LW = (const float*)(smem + C_LWH); const float* LA = (const float*)(smem + C_LAH);
#pragma unroll
            for (int j = 0; j < 8; ++j) {
                const int t = 8 * w + j; const size_t R = row0 + t;
                const float zr = xr[j + 1] + (xr[j] - xr[j + 1]) * mu_r, zk = xk[j + 1] + (xk[j] - xk[j + 1]) * mu_k, zv = xv[j + 1] + (xv[j] - xv[j + 1]) * mu_v, zg = xg[j + 1] + (xg[j] - xg[j + 1]) * mu_g;
                const float lw = LW[t * LWP + lane], la = LA[t * LWP + lane];
                const float decay = __expf(-0.60653066f * frcp(1.0f + __expf(-(w0c + lw))));
                const float alr = frcp(1.0f + __expf(-(a0c + la)));
                float kn = zk * kkc; const float ss = wsum64(kn * kn); kn = kn * __builtin_amdgcn_rsqf(fmaxf(ss, 1e-24f));
                const float keff = zk * (1.0f + (alr - 1.0f) * kac);
                const float bsum = wsum64(zr * keff * rkc); const float sg = silu_f(zg);
                GP[((size_t)(b * 8 + h) * SEQ + (size_t)c * 64 + t) * 64 + lane] = cvtpk(lnwc * sg, (lnbc + bsum * zv) * sg);
                rr[j] = zr; ww[j] = decay; kk[j] = keff; vv[j] = zv; aa[j] = -kn; bb[j] = kn * alr;
            }
            if (c == 63 && w == 7) { float* sh = p.out + OUT_SHP + (size_t)b * RWC; sh[col] = xr[8]; sh[512 + col] = xk[8]; sh[1024 + col] = xv[8]; sh[1536 + col] = xg[8]; }
        }
        if (hh + 1 < 4) FUSED_FETCH(h + 1)
        scanc_s1_core(p, ((b * 8 + h) << 6) + c, smem, lane, w, rr, ww, kk, vv, aa, bb);
    }
#undef FUSED_FETCH
}

__device__ __forceinline__ void scanc_stage2(const Params& p, int bh, unsigned char* smem) {
    const int tid = otid(), lane = tid & 63, r32 = lane & 31, hi = lane >> 5; const int w = __builtin_amdgcn_readfirstlane(tid >> 6);
    const int xk = w & 1, yv = (w >> 1) & 1;
    const int v = yv * 32 + r32;
    unsigned char* Sb = smem;
    __syncthreads();
    if (w < 4) {
#pragma unroll
        for (int g4 = 0; g4 < 4; ++g4) { u32x2 z = {0u, 0u}; *(u32x2*)(Sb + v * CP + (xk * 32 + 8 * g4 + 4 * hi) * 2) = z; }
    }
    const u16* PmB = (const u16*)(p.ws + WS_PM) + (size_t)bh * 64 * 4096; const float* QmB = (const float*)(p.ws + WS_QM) + (size_t)bh * 64 * 4096;
    u16* SC = (u16*)(p.ws + WS_SC) + (size_t)bh * 64 * 4096;
    bf16x8 pfA[4], pfB[4]; f32x4 qfA[4], qfB[4];
    auto s2_fetch = [&](int c, bf16x8 (&pfx)[4], f32x4 (&qfx)[4]) {
#pragma unroll
        for (int ks = 0; ks < 4; ++ks) pfx[ks] = *(const bf16x8*)(PmB + (size_t)c * 4096 + (xk * 32 + r32) * 64 + ks * 16 + hi * 8);
#pragma unroll
        for (int g4 = 0; g4 < 4; ++g4) qfx[g4] = *(const f32x4*)(QmB + (size_t)c * 4096 + v * 64 + xk * 32 + 8 * g4 + 4 * hi); };
    if (w < 4) { s2_fetch(0, pfA, qfA); s2_fetch(1, pfB, qfB); }
    f32x16 acc;
#pragma unroll
    for (int r = 0; r < 16; ++r) acc[r] = 0.f;
    __syncthreads();
    auto s2_step = [&](int c, bf16x8 (&pfx)[4], f32x4 (&qfx)[4]) {
        if (w < 4) {
#pragma unroll
            for (int g4 = 0; g4 < 4; ++g4) { const int k0 = xk * 32 + 8 * g4 + 4 * hi; *(u32x2*)(SC + (size_t)c * 4096 + v * 64 + k0) = *(const u32x2*)(Sb + v * CP + k0 * 2); }
            bf16x8 pc[4];
#pragma unroll
            for (int ks = 0; ks < 4; ++ks) pc[ks] = pfx[ks];
#pragma unroll
            for (int g4 = 0; g4 < 4; ++g4) { acc[4 * g4] = qfx[g4][0]; acc[4 * g4 + 1] = qfx[g4][1]; acc[4 * g4 + 2] = qfx[g4][2]; acc[4 * g4 + 3] = qfx[g4][3]; }
            if (c + 2 < 64) s2_fetch(c + 2, pfx, qfx);
#pragma unroll
            for (int ks = 0; ks < 4; ++ks) { const bf16x8 sf = *(const bf16x8*)(Sb + v * CP + ks * 32 + hi * 16); acc = MFMA32(pc[ks], sf, acc); }
        }
        __syncthreads();
        if (w < 4) {
#pragma unroll
            for (int g4 = 0; g4 < 4; ++g4) *(u32x2*)(Sb + v * CP + (xk * 32 + 8 * g4 + 4 * hi) * 2) = pack4(acc[4 * g4], acc[4 * g4 + 1], acc[4 * g4 + 2], acc[4 * g4 + 3]);
        }
        __syncthreads(); };
    for (int c = 0; c < 64; c += 2) { s2_step(c, pfA, qfA); s2_step(c + 1, pfB, qfB); }
    if (w < 4) {
        float* so = p.out + OUT_WKVP + (size_t)bh * 4096 + v * 64;
#pragma unroll
        for (int g4 = 0; g4 < 4; ++g4) { const f32x4 o4 = {acc[4 * g4], acc[4 * g4 + 1], acc[4 * g4 + 2], acc[4 * g4 + 3]}; *(f32x4*)(so + xk * 32 + 8 * g4 + 4 * hi) = o4; }
    }
}

struct S3Ops { u32x2 y0[4]; bf16x8 af[4], bf[4]; };
__device__ __forceinline__ void s3_load(S3Ops& o, const Params& p, int item, int gq, int tb, int vb, int r32, int hi) {
    const int cid = item * 2 + gq, v = vb * 32 + r32;
    const u16* Y0 = (const u16*)(p.ws + WS_Y0) + (size_t)cid * 4096 + v * 64;
    const u16* Wh = (const u16*)(p.ws + WS_WH) + (size_t)cid * 4096 + (tb * 32 + r32) * 64;
    const u16* SC = (const u16*)(p.ws + WS_SC) + (size_t)cid * 4096 + v * 64;
#pragma unroll
    for (int g4 = 0; g4 < 4; ++g4) o.y0[g4] = *(const u32x2*)(Y0 + tb * 32 + 8 * g4 + 4 * hi);
#pragma unroll
    for (int ks = 0; ks < 4; ++ks) { o.af[ks] = *(const bf16x8*)(Wh + ks * 16 + hi * 8); o.bf[ks] = *(const bf16x8*)(SC + ks * 16 + hi * 8); }
}
__device__ __forceinline__ void phase_stage3(const Params& p, int bid, int nb, unsigned char* smem, int nitems) {
    const int tid = otid(), lane = tid & 63, r32 = lane & 31, hi = lane >> 5; const int w = __builtin_amdgcn_readfirstlane(tid >> 6);
    const int gq = w >> 2, w4 = w & 3, tb = w4 & 1, vb = w4 >> 1;
    float* Yb = (float*)smem;
    const unsigned* GP = (const unsigned*)(p.ws + WS_SG);
    u16* O = (u16*)(p.ws + WS_O);
    S3Ops cur;
    if (bid < nitems) s3_load(cur, p, bid, gq, tb, vb, r32, hi);
    for (int item = bid; item < nitems; item += nb) {
        unsigned gp[16];
#pragma unroll
        for (int i = 0; i < 16; ++i) { const int tt = w + 8 * i; const int g = tt >> 6, t = tt & 63, cc = item * 2 + g, bh = cc >> 6, c = cc & 63;
            gp[i] = GP[((size_t)bh * SEQ + (size_t)c * 64 + t) * 64 + lane]; }
        f32x16 acc;
#pragma unroll
        for (int g4 = 0; g4 < 4; ++g4) { acc[4 * g4] = __uint_as_float(cur.y0[g4].x << 16); acc[4 * g4 + 1] = __uint_as_float(cur.y0[g4].x & 0xffff0000u); acc[4 * g4 + 2] = __uint_as_float(cur.y0[g4].y << 16); acc[4 * g4 + 3] = __uint_as_float(cur.y0[g4].y & 0xffff0000u); }
#pragma unroll
        for (int ks = 0; ks < 4; ++ks) acc = MFMA32(cur.af[ks], cur.bf[ks], acc);
        if (item + nb < nitems) s3_load(cur, p, item + nb, gq, tb, vb, r32, hi);
        __syncthreads();
        { const int v = vb * 32 + r32;
#pragma unroll
          for (int r = 0; r < 16; ++r) Yb[gq * 4096 + (tb * 32 + crow(r, hi)) * 64 + v] = acc[r]; }
        __syncthreads();
#pragma unroll
        for (int i = 0; i < 16; ++i) { const int tt = w + 8 * i; const int g = tt >> 6, t = tt & 63, cc = item * 2 + g, bh = cc >> 6, c = cc & 63, b = bh >> 3, h = bh & 7;
            const size_t R = (size_t)b * SEQ + (size_t)c * 64 + t;
            const float yy = Yb[g * 4096 + t * 64 + lane];
            const float mean = wave_sum(yy) * (1.0f / 64.0f); const float dd = yy - mean;
            const float var = wave_sum(dd * dd) * (1.0f / 64.0f);
            O[R * DM + 512 + h * 64 + lane] = f2bf(dd * rsqrtf(var + 64e-5f) * __uint_as_float(gp[i] << 16) + __uint_as_float(gp[i] & 0xffff0000u)); }
    }
}

constexpr int SG_PITCH = 68;
__device__ __forceinline__ void phase_gemm2_sample(const Params& p, int bid, int nb, unsigned char* smem) {
    const int tid = otid(), lane = tid & 63, r32 = lane & 31, hi = lane >> 5; const int w = __builtin_amdgcn_readfirstlane(tid >> 6);
    const u16* Ob = (const u16*)(p.ws + WS_O); const u16* Wt = (const u16*)(p.ws + WS_WOUTT);
    float* Part = (float*)smem;
    for (int tile = bid; tile < 256; tile += nb) {
        const int tr = tile >> 4, tc = tile & 15, R0 = NPROW + tr * 64, n0 = tc * 64, k0 = w * 128;
        const int orow = tid >> 3, oc8 = (tid & 7) * 8;
        const float* xr = p.x_sample + (size_t)(tr * 64 + orow) * DM + n0 + oc8;
        const f32x4 x0 = *(const f32x4*)(xr), x1 = *(const f32x4*)(xr + 4);
        const u16* Ap = Ob + (size_t)(R0 + r32) * DM + k0 + hi * 8; const u16* Bp = Wt + (size_t)(n0 + r32) * DM + k0 + hi * 8;
        f32x16 acc[2][2];
#pragma unroll
        for (int ia = 0; ia < 2; ++ia)
#pragma unroll
            for (int ib = 0; ib < 2; ++ib)
#pragma unroll
                for (int r = 0; r < 16; ++r) acc[ia][ib][r] = 0.f;
#pragma unroll
        for (int ks = 0; ks < 8; ++ks) {
            const bf16x8 a0 = *(const bf16x8*)(Ap + ks * 16), a1 = *(const bf16x8*)(Ap + (size_t)32 * DM + ks * 16);
            const bf16x8 b0 = *(const bf16x8*)(Bp + ks * 16), b1 = *(const bf16x8*)(Bp + (size_t)32 * DM + ks * 16);
            acc[0][0] = MFMA32(a0, b0, acc[0][0]); acc[0][1] = MFMA32(a0, b1, acc[0][1]); acc[1][0] = MFMA32(a1, b0, acc[1][0]); acc[1][1] = MFMA32(a1, b1, acc[1][1]);
        }
        __syncthreads();
#pragma unroll
        for (int ia = 0; ia < 2; ++ia)
#pragma unroll
            for (int ib = 0; ib < 2; ++ib)
#pragma unroll
                for (int r = 0; r < 16; ++r) Part[(w * 64 + ia * 32 + crow(r, hi)) * SG_PITCH + ib * 32 + r32] = acc[ia][ib][r];
        __syncthreads();
        f32x4 s0 = x0, s1 = x1;
#pragma unroll
        for (int ww = 0; ww < 8; ++ww) { const float* pp = Part + (ww * 64 + orow) * SG_PITCH + oc8; s0 += *(const f32x4*)(pp); s1 += *(const f32x4*)(pp + 4); }
        float* dst = p.out + OUT_Y + (size_t)(R0 + orow) * DM + n0 + oc8;
        *(f32x4*)(dst) = s0; *(f32x4*)(dst + 4) = s1;
    }
}
__device__ __forceinline__ void phase_norm_sample(const Params& p, int bid, int nb) {
    const int tid = otid(), lane = tid & 63, w = tid >> 6;
    if (w < 4) {
        for (int r = bid * 4 + w; r < NROWS - NPROW; r += nb * 4) {
            float* src = p.out + OUT_Y + (size_t)(NPROW + r) * DM;
            f32x4 v[4], g[4]; float ss = 0.f;
#pragma unroll
            for (int i = 0; i < 4; ++i) { v[i] = *(const f32x4*)(src + lane * 4 + i * 256); g[i] = *(const f32x4*)(p.norm_f + lane * 4 + i * 256); }
#pragma unroll
            for (int i = 0; i < 4; ++i) ss += v[i][0] * v[i][0] + v[i][1] * v[i][1] + v[i][2] * v[i][2] + v[i][3] * v[i][3];
            ss = wave_sum(ss);
            const float rs = rsqrtf(ss * (1.0f / 1024.0f) + 1e-6f);
#pragma unroll
            for (int i = 0; i < 4; ++i) *(f32x4*)(src + lane * 4 + i * 256) = v[i] * rs * g[i];
        }
    }
}

__device__ __forceinline__ void phase_attn_prompt(const Params& p, int bid, int nb, unsigned char* smem, int uhi) {
    const int tid = otid(), lane = tid & 63, r32 = lane & 31, hi = lane >> 5; const int w = __builtin_amdgcn_readfirstlane(tid >> 6);
    unsigned char* ldsK = smem; unsigned char* ldsV = smem + 8192;
    const u16* Qb = (const u16*)(p.ws + WS_QB); const u16* Kb = (const u16*)(p.ws + WS_KB); const u16* Vb = (const u16*)(p.ws + WS_VB);
    const float* P = (const float*)(p.ws + WS_P); u16* O = (u16*)(p.ws + WS_O);
    for (int u = bid; u < uhi; u += nb) {
        const int qb = 15 - (u >> 5), bh = u & 31, b = bh >> 3, h = bh & 7, q0 = qb * 256, NT = 4 * qb + 4;
        const float bias2 = p.sb_bias[h] * LOG2E;
        const u16* Qw = Qb + ((size_t)bh * SEQ + q0 + w * 32) * 64;
        bf16x8 qr[4];
#pragma unroll
        for (int d0 = 0; d0 < 4; ++d0) qr[d0] = *(const bf16x8*)(Qw + r32 * 64 + d0 * 16 + hi * 8);
        const u16* ksrc = Kb + (size_t)bh * SEQ * 64 + (size_t)lane * 64 + w * 8;
        const u16* vsrc = Vb + (size_t)bh * SEQ * 64 + (size_t)(16 * (w & 3) + (lane >> 2)) * 64 + (w >> 2) * 32 + (lane & 3) * 8;
        const int jw = 4 * qb + (w >> 1), qrel = 32 * (w & 1) + r32;
        float carry = 1.0f; f32x16 o[2];
#pragma unroll
        for (int r = 0; r < 16; ++r) { o[0][r] = 0.f; o[1][r] = 0.f; }
        u32x4 kreg = *(const u32x4*)(ksrc + (size_t)(NT - 1) * 64 * 64), vreg = *(const u32x4*)(vsrc + (size_t)(NT - 1) * 64 * 64);
        for (int j = NT - 1; j >= 0; --j) {
            *(u32x4*)(ldsK + w * 1024 + lane * 16) = kreg; *(u32x4*)(ldsV + w * 1024 + lane * 16) = vreg;
            __syncthreads();
            if (j > 0) { kreg = *(const u32x4*)(ksrc + (size_t)(j - 1) * 64 * 64); vreg = *(const u32x4*)(vsrc + (size_t)(j - 1) * 64 * 64); }
            if (j <= jw) sb_tile((lds_cptr)ldsK, (lds_cptr)ldsV, qr, bias2, j == jw ? qrel : -1, lane, carry, o);
            __syncthreads();
        }
#pragma unroll
        for (int dh = 0; dh < 2; ++dh)
#pragma unroll
            for (int r = 0; r < 16; ++r) { const int R = b * SEQ + q0 + w * 32 + crow(r, hi), dcol = h * 64 + dh * 32 + r32;
                const float g = P[(size_t)R * NINP + 1536 + dcol]; O[(size_t)R * DM + dcol] = f2bf(o[dh][r] * silu_f(g)); }
    }
}

__device__ __forceinline__ void sb_scores32(lds_cptr ldsK, const bf16x8 (&qr)[4], float bias2, int qrel, int lane, float& carry, u32x4 (&pw)[2]) {
    const int r32 = lane & 31, hi = lane >> 5;
    const lds_cptr kp0 = ldsK + hi * 512 + r32 * 16;
    f32x16 C;
#pragma unroll
    for (int r = 0; r < 16; ++r) C[r] = bias2;
#pragma unroll
    for (int d0 = 0; d0 < 4; ++d0) { const bf16x8 kf = *(const __attribute__((address_space(3))) bf16x8*)(kp0 + d0 * 1024); C = MFMA32(kf, qr[d0], C); }
    if (qrel >= 0) {
#pragma unroll
        for (int r = 0; r < 16; ++r) if (crow(r, hi) >= qrel) C[r] = -INFINITY;
    }
    sb_sub(C, carry, hi);
#pragma unroll
    for (int i = 0; i < 4; ++i) { pw[0][i] = cvtpk(C[2 * i], C[2 * i + 1]); pw[1][i] = cvtpk(C[8 + 2 * i], C[8 + 2 * i + 1]); }
}
__device__ __forceinline__ void sb_pv32(lds_cptr ldsV, const u32x4 (&pw)[2], int lane, f32x16 (&o)[2]) {
    const int hi = lane >> 5;
    const lds_cptr vp0 = ldsV + ((lane >> 4) & 1) * 32 + (lane & 3) * 8 + (4 * hi + ((lane & 15) >> 2)) * 64;
#pragma unroll
    for (int i = 0; i < 4; ++i) {
        const s16x4 lo = vtr(vp0 + ((i >> 1) * 2048 + (i & 1) * 1024)), hi4 = vtr(vp0 + ((i >> 1) * 2048 + (i & 1) * 1024 + 512));
        const bf16x8 vf = {lo[0], lo[1], lo[2], lo[3], hi4[0], hi4[1], hi4[2], hi4[3]};
        o[i >> 1] = MFMA32(__builtin_bit_cast(bf16x8, pw[i & 1]), vf, o[i >> 1]);
    }
}
__device__ __forceinline__ void phase_attn_sample(const Params& p, int bid, int nb, unsigned char* smem, int uhi) {
    const int tid = otid(), lane = tid & 63, r32 = lane & 31, hi = lane >> 5; const int w = __builtin_amdgcn_readfirstlane(tid >> 6);
    unsigned char* ldsK = smem + w * 16384; unsigned char* ldsV = ldsK + 4096; unsigned char* stg = ldsK + 8192;
    const u16* Qb = (const u16*)(p.ws + WS_QB) + (size_t)NPROW * 512; const u16* Kb = (const u16*)(p.ws + WS_KB) + (size_t)NPROW * 512; const u16* Vb = (const u16*)(p.ws + WS_VB) + (size_t)NPROW * 512;
    const float* P = (const float*)(p.ws + WS_P); u16* O = (u16*)(p.ws + WS_O);
    const int srow = lane >> 4, sp = lane & 15;
#define AS_DMA_K(kp_) { _Pragma("unroll") for (int i = 0; i < 8; ++i) __builtin_amdgcn_global_load_lds((const unsigned*)((kp_) + (size_t)(i * 4) * 512), (__attribute__((address_space(3))) unsigned*)(stg + i * 1024), 16, 0, 2); }
    for (int u_ = bid; u_ < uhi; u_ += nb) {
        const int bd = (u_ >> 8) * 32 + (u_ & 7) * 4 + ((u_ >> 6) & 3), h = (u_ >> 3) & 7, u = bd * 8 + h;
        const float bias2 = p.sb_bias[h] * LOG2E;
        const int pg_lo = p.page_table[bd * 16 + 2 * w], pg_hi = p.page_table[bd * 16 + 2 * w + 1];
        bf16x8 qr[4];
#pragma unroll
        for (int d0 = 0; d0 < 4; ++d0) qr[d0] = *(const bf16x8*)(Qb + ((size_t)u * 8 + (r32 & 7)) * 64 + d0 * 16 + hi * 8);
        float carry = 1.0f; f32x16 o[2];
#pragma unroll
        for (int r = 0; r < 16; ++r) { o[0][r] = 0.f; o[1][r] = 0.f; }
        u32x4 pw[2];
        __syncthreads();
        f32x4 vx[8];
        { const size_t rb = (size_t)pg_hi * 128 + 96;
          const float* kp = p.cache_k + ((rb + srow) * 8 + h) * 64 + sp * 4; const float* vp = p.cache_v + ((rb + srow) * 8 + h) * 64 + sp * 4;
          AS_DMA_K(kp)
#pragma unroll
          for (int i = 0; i < 8; ++i) vx[i] = __builtin_nontemporal_load((const f32x4*)(vp + (size_t)(i * 4) * 512)); }
        if (w == 7) {
#pragma unroll
            for (int c8 = 0; c8 < 4; ++c8) { const int cc = c8 * 2 + hi; u32x4 kv = {0u, 0u, 0u, 0u}; if (r32 < 8) kv = *(const u32x4*)(Kb + ((size_t)u * 8 + r32) * 64 + cc * 8); *(u32x4*)(ldsK + cc * 512 + r32 * 16) = kv; }
#pragma unroll
            for (int i = 0; i < 4; ++i) { const int row = (lane >> 2) + 16 * (i & 1), dh = i >> 1; u32x4 vv = {0u, 0u, 0u, 0u};
                if (row < 8) vv = *(const u32x4*)(Vb + ((size_t)u * 8 + row) * 64 + dh * 32 + (lane & 3) * 8);
                *(u32x4*)(ldsV + dh * 2048 + row * 64 + (lane & 3) * 16) = vv; }
            asm volatile("s_waitcnt lgkmcnt(0)" ::: "memory");
            sb_scores32((lds_cptr)ldsK, qr, bias2, r32, lane, carry, pw);
            sb_pv32((lds_cptr)ldsV, pw, lane, o);
            asm volatile("" ::: "memory");
        }
        for (int st = 7; st >= 0; --st) {
            asm volatile("s_waitcnt vmcnt(0)" ::: "memory");
#pragma unroll
            for (int i = 0; i < 8; ++i) { const int row = i * 4 + srow; const f32x4 kx = *(const f32x4*)(stg + i * 1024 + lane * 16);
                u32x2 k2; k2.x = cvtpk(kx[0], kx[1]); k2.y = cvtpk(kx[2], kx[3]);
                *(u32x2*)(ldsK + (sp >> 1) * 512 + row * 16 + (sp & 1) * 8) = k2; }
#pragma unroll
            for (int i = 0; i < 8; ++i) { const int row = i * 4 + srow; u32x2 v2; v2.x = cvtpk(vx[i][0], vx[i][1]); v2.y = cvtpk(vx[i][2], vx[i][3]);
                *(u32x2*)(ldsV + (sp >> 3) * 2048 + row * 64 + (sp & 7) * 8) = v2; }
            asm volatile("s_waitcnt lgkmcnt(0)" ::: "memory");
            if (st > 0) { const int stn = st - 1; const int pagen = (stn >> 2) ? pg_hi : pg_lo; const size_t rbn = (size_t)pagen * 128 + 32 * (stn & 3);
                const float* kpn = p.cache_k + ((rbn + srow) * 8 + h) * 64 + sp * 4; const float* vpn = p.cache_v + ((rbn + srow) * 8 + h) * 64 + sp * 4;
                AS_DMA_K(kpn)
#pragma unroll
                for (int i = 0; i < 8; ++i) vx[i] = __builtin_nontemporal_load((const f32x4*)(vpn + (size_t)(i * 4) * 512)); }
            sb_scores32((lds_cptr)ldsK, qr, bias2, -1, lane, carry, pw);
            sb_pv32((lds_cptr)ldsV, pw, lane, o);
            asm volatile("" ::: "memory");
        }
#undef AS_DMA_K
        __syncthreads();
        float* Ob = (float*)smem;
        float* Tt = (float*)(smem + 16384);
#pragma unroll
        for (int dh = 0; dh < 2; ++dh)
#pragma unroll
            for (int r = 0; r < 4; ++r) Ob[(w * 8 + 4 * hi + r) * 64 + dh * 32 + r32] = o[dh][r];
        if (r32 < 8 && hi == 0) Tt[w * 8 + r32] = carry;
        __syncthreads();
        { const int q = tid >> 6, d = tid & 63; float acc = 0.f, suf = 1.0f;
#pragma unroll
          for (int ww = 7; ww >= 0; --ww) { acc += Ob[(ww * 8 + q) * 64 + d] * suf; suf *= Tt[ww * 8 + q]; }
          const int R = NPROW + bd * 8 + q, dcol = h * 64 + d;
          const float g = P[(size_t)R * NINP + 1536 + dcol]; O[(size_t)R * DM + dcol] = f2bf(acc * silu_f(g)); }
    }
}

struct EpiIn {
    static constexpr bool PERM = false, AFTER_DRAIN = false;
    float* P; float* out; u16* Qb; u16* Kb; u16* Vb;
    __device__ __forceinline__ void operator()(const pg8::f32x4 (&acc)[2][2][4][2], const pg8::Unit& u, int wr, int wc, int fr, int fq) const {
        const int row0 = u.pm * 256 + wr * 64 + fr, colt = u.pn * 256, col0 = colt + wc * 32 + 4 * fq;
        if (colt >= 1536) {
#pragma unroll
            for (int ai = 0; ai < 2; ++ai)
#pragma unroll
                for (int m = 0; m < 4; ++m) { float* rowp = P + (size_t)(row0 + ai * 128 + m * 16) * NINP + col0;
#pragma unroll
                    for (int bj = 0; bj < 2; ++bj)
#pragma unroll
                        for (int n = 0; n < 2; ++n) *(pg8::f32x4*)(rowp + bj * 128 + n * 16) = acc[ai][bj][m][n]; }
        } else {
            const int type = colt >> 9;
            const bool prompt = u.pm < 64;
            const float sc = type == 0 ? 0.125f * LOG2E : 1.0f;
            const int c0 = (colt & 511) + wc * 32 + 4 * fq, h0 = c0 >> 6, d0 = c0 & 63, rr0 = row0 - NPROW;
            u16* b16 = Qb + (size_t)type * ((size_t)NROWS * 512) + (prompt ? ((size_t)(((row0 >> 12) * 8 + h0) * SEQ + (row0 & 4095))) * 64 + d0
                                                                          : (size_t)NPROW * 512 + ((size_t)(((rr0 >> 3) * 8 + h0) * 8 + (rr0 & 7))) * 64 + d0);
            float* o32 = out + (prompt ? OUT_KP + (size_t)(type - 1) * (OUT_VP - OUT_KP) + (size_t)row0 * 512 : OUT_KS + (size_t)(type - 1) * (OUT_VS - OUT_KS) + (size_t)rr0 * 512) + c0;
            const int rstep16 = prompt ? 64 : 512;
            const int hstep16 = prompt ? SEQ * 64 : 512;
#pragma unroll
            for (int ai = 0; ai < 2; ++ai)
#pragma unroll
                for (int m = 0; m < 4; ++m)
#pragma unroll
                    for (int bj = 0; bj < 2; ++bj)
#pragma unroll
                        for (int n = 0; n < 2; ++n) { const pg8::f32x4 v = acc[ai][bj][m][n]; const int dr = ai * 128 + m * 16;
                            u32x2 pk2; pk2.x = cvtpk(v[0] * sc, v[1] * sc); pk2.y = cvtpk(v[2] * sc, v[3] * sc);
                            *(u32x2*)(b16 + (size_t)dr * rstep16 + (size_t)(bj * 2) * hstep16 + n * 16) = pk2;
                            if (type != 0) *(pg8::f32x4*)(o32 + (size_t)dr * 512 + bj * 128 + n * 16) = v; }
        }
    }
};

struct EpiRes {
    static constexpr bool PERM = false, AFTER_DRAIN = false;
    float* C; const float* xp; const float* xs;
    __device__ __forceinline__ void operator()(const pg8::f32x4 (&acc)[2][2][4][2], const pg8::Unit& u, int wr, int wc, int fr, int fq) const {
        const int row0 = u.pm * 256 + wr * 64 + fr, col0 = u.pn * 256 + wc * 32 + 4 * fq;
#pragma unroll
        for (int ai = 0; ai < 2; ++ai)
#pragma unroll
            for (int m = 0; m < 4; ++m) { const int row = row0 + ai * 128 + m * 16; float* rowp = C + (size_t)row * DM + col0;
                const float* xr = (row < NPROW ? xp + (size_t)row * DM : xs + (size_t)(row - NPROW) * DM) + col0;
#pragma unroll
                for (int bj = 0; bj < 2; ++bj)
#pragma unroll
                    for (int n = 0; n < 2; ++n) *(pg8::f32x4*)(rowp + bj * 128 + n * 16) = acc[ai][bj][m][n] + *(const pg8::f32x4*)(xr + bj * 128 + n * 16); }
    }
};

constexpr int PANEL_CNT_WORD = 4608;
struct EpiResNorm {
    static constexpr bool PERM = false, AFTER_DRAIN = true;
    float* C; const float* xp; const float* xs; const float* gain; float* stats; unsigned* ctl;
    __device__ __forceinline__ void fused(const pg8::f32x4 (&acc)[2][2][4][2], const pg8::Unit& u, int wr, int wc, int fr, int fq, PG8_LAS unsigned char* lds, int wid, int lane) const {
        PG8_LAS float* Pt = (PG8_LAS float*)lds;
        PG8_LAS float* Sr = (PG8_LAS float*)(lds + 4096);
        const int row0 = u.pm * 256 + wr * 64 + fr, col0 = u.pn * 256 + wc * 32 + 4 * fq;
        pg8::f32x4 (&hacc)[2][2][4][2] = const_cast<pg8::f32x4 (&)[2][2][4][2]>(acc);
#pragma unroll
        for (int ai = 0; ai < 2; ++ai)
#pragma unroll
            for (int m = 0; m < 4; ++m) { const int row = row0 + ai * 128 + m * 16;
                const float* xr = (row < NPROW ? xp + (size_t)row * DM : xs + (size_t)(row - NPROW) * DM) + col0;
                float s = 0.f;
#pragma unroll
                for (int bj = 0; bj < 2; ++bj)
#pragma unroll
                    for (int n = 0; n < 2; ++n) { const pg8::f32x4 hv = acc[ai][bj][m][n] + *(const pg8::f32x4*)(xr + bj * 128 + n * 16); hacc[ai][bj][m][n] = hv; s += (hv[0] * hv[0] + hv[1] * hv[1]) + (hv[2] * hv[2] + hv[3] * hv[3]); }
                s += __shfl_xor(s, 16); s += __shfl_xor(s, 32);
                if (fq == 0) Pt[(ai * 128 + wr * 64 + m * 16 + fr) * 4 + wc] = s; }
        __syncthreads();
        float* st = stats + (size_t)u.pm * 1024;
        unsigned* cnt = ctl + PANEL_CNT_WORD + 16 * u.pm;
        const int prow = wid * 32 + (lane & 31);
        if (lane < 32) { const float t4 = (Pt[prow * 4] + Pt[prow * 4 + 1]) + (Pt[prow * 4 + 2] + Pt[prow * 4 + 3]);
            __hip_atomic_store(st + prow * 4 + u.pn, t4, __ATOMIC_RELAXED, __HIP_MEMORY_SCOPE_AGENT); }
        asm volatile("s_waitcnt vmcnt(0)" ::: "memory");
        __syncthreads();
        if (threadIdx.x == 0) {
            __hip_atomic_fetch_add(cnt, 1u, __ATOMIC_RELAXED, __HIP_MEMORY_SCOPE_AGENT);
            unsigned spins = 0;
            while (__hip_atomic_load(cnt, __ATOMIC_RELAXED, __HIP_MEMORY_SCOPE_AGENT) < 4u) { __builtin_amdgcn_s_sleep(2); if (++spins > (1u << 22)) break; }
        }
        __syncthreads();
        if (lane < 32) { float tot = 0.f;
#pragma unroll
            for (int k = 0; k < 4; ++k) tot += __hip_atomic_load(st + prow * 4 + k, __ATOMIC_RELAXED, __HIP_MEMORY_SCOPE_AGENT);
            Sr[prow] = rsqrtf(tot * (1.0f / 1024.0f) + 1e-6f); }
        __syncthreads();
#pragma unroll
        for (int ai = 0; ai < 2; ++ai)
#pragma unroll
            for (int m = 0; m < 4; ++m) { const int row = row0 + ai * 128 + m * 16; float* rowp = C + (size_t)row * DM + col0;
                const float rs = Sr[ai * 128 + wr * 64 + m * 16 + fr];
#pragma unroll
                for (int bj = 0; bj < 2; ++bj)
#pragma unroll
                    for (int n = 0; n < 2; ++n) { const pg8::f32x4 hv = hacc[ai][bj][m][n]; const pg8::f32x4 gv = *(const pg8::f32x4*)(gain + col0 + bj * 128 + n * 16);
                        *(pg8::f32x4*)(rowp + bj * 128 + n * 16) = hv * rs * gv; } }
        __syncthreads();
    }
};

__device__ __forceinline__ void phase_final(const Params& p, int bid, int nb) {
    const int tid = otid(), lane = tid & 63, w = tid >> 6;
    f32x4 g[4];
#pragma unroll
    for (int i = 0; i < 4; ++i) g[i] = *(const f32x4*)(p.norm_f + lane * 4 + i * 256);
    for (int row = bid * 8 + w; row < NROWS; row += nb * 8) {
        float* src = p.out + (size_t)row * DM;
        f32x4 v[4]; float ss = 0.f;
#pragma unroll
        for (int i = 0; i < 4; ++i) { v[i] = *(const f32x4*)(src + lane * 4 + i * 256); ss += v[i][0] * v[i][0] + v[i][1] * v[i][1] + v[i][2] * v[i][2] + v[i][3] * v[i][3]; }
        ss = wave_sum(ss);
        const float rs = rsqrtf(ss * (1.0f / 1024.0f) + 1e-6f);
#pragma unroll
        for (int i = 0; i < 4; ++i) *(f32x4*)(src + lane * 4 + i * 256) = v[i] * rs * g[i];
    }
}

struct OneUnitOrder { int pm, pn;
    __device__ __forceinline__ bool next(int i, pg8::Unit& u) const { if (i != 0) return false; u.pm = pm; u.pn = pn; return true; }
    __device__ __forceinline__ void a_ready(const pg8::Unit&) const {}
    __device__ __forceinline__ void done(const pg8::Unit&) const {} };
constexpr int LDS_MAIN = 162048;
constexpr int LDS_BYTES = LDS_MAIN + 16;
static_assert(C_FEND <= LDS_MAIN, "stage-1 LDS map");
static_assert(PREP_END <= LDS_MAIN, "prep LDS map");
constexpr int WQ_WORD = XCD_BAR_WORDS + 64;
constexpr int CTL_BYTES = 32768;
__global__ __launch_bounds__(512, 2) __attribute__((target("no-packed-fp32-ops"))) void k_mega(Params p) {
    extern __shared__ __attribute__((aligned(16))) unsigned char shm[];
    const int bid = blockIdx.x, nb = gridDim.x;
    volatile LAS unsigned* xbw = (volatile LAS unsigned*)(shm + LDS_MAIN);
    volatile LAS unsigned* slot = (volatile LAS unsigned*)(shm + LDS_MAIN + 8);
    if (threadIdx.x == 0) { xbw[0] = 0u; xbw[1] = 0u; slot[0] = 0u; slot[1] = 0u; }
    __syncthreads();
    unsigned* bar = (unsigned*)(p.ws + WS_BAR);
    XcdBarrier xb = xcd_barrier_post(bar, xbw);
#define WQ_LOOP(Q, N, ...) { unsigned nxt_ = 0u; if (threadIdx.x == 0) nxt_ = __hip_atomic_fetch_add(bar + WQ_WORD + 64 * (Q), 1u, __ATOMIC_RELAXED, __HIP_MEMORY_SCOPE_AGENT); \
      for (;;) { __syncthreads(); if (threadIdx.x == 0) slot[0] = nxt_; __syncthreads(); const int item = __builtin_amdgcn_readfirstlane((int)slot[0]); if (item >= (N)) break; \
        if (threadIdx.x == 0) nxt_ = __hip_atomic_fetch_add(bar + WQ_WORD + 64 * (Q), 1u, __ATOMIC_RELAXED, __HIP_MEMORY_SCOPE_AGENT); __VA_ARGS__; } }
    phase_prologue(p, bid, nb, shm);
    xcd_barrier(xb);
    { pg8::Gemm g{(const pg8::bf16_t*)(p.ws + WS_XB), (const pg8::bf16_t*)(p.ws + WS_WINT), NROWS, NINP, DM}; pg8::StaticOrder S; S.init(NROWS, NINP, nb, bid);
      EpiIn E{(float*)(p.ws + WS_P), p.out, (u16*)(p.ws + WS_QB), (u16*)(p.ws + WS_KB), (u16*)(p.ws + WS_VB)}; pg8::gemm_phase<EpiIn, pg8::StaticOrder, false>((PG8_LAS unsigned char*)shm, g, S, E, nullptr); }
    { const int ntiles_ = (NROWS / 256) * (NINP / 256), rounds_ = (ntiles_ + nb - 1) / nb, sbase_ = ntiles_ - (rounds_ - 1) * nb, nidle_ = nb - sbase_;
      if (nidle_ > 0) { if (bid >= sbase_) phase_wout_tiles(p, bid - sbase_, nidle_, shm); } else phase_wout_tiles(p, bid, nb, shm); }
    xcd_barrier(xb);
    if ((bid >> 6) & 1) {
        for (int it = bid; it < 768; it += nb) phase_attn_sample(p, it, 1 << 30, shm, 1024);
        for (int it = bid; it < 512; it += nb) scanc_fused(p, it, shm);
    } else {
        for (int it = bid; it < 512; it += nb) scanc_fused(p, it, shm);
        for (int it = bid; it < 768; it += nb) phase_attn_sample(p, it, 1 << 30, shm, 1024);
    }
    WQ_LOOP(7, 128, phase_prep_unit(p, item + 512, shm));
    xcd_barrier(xb);
    for (int s_ = nb - 1 - bid; s_ < 32; s_ += nb) scanc_stage2(p, s_, shm);
    for (int it = bid; it < 256; it += nb) phase_attn_prompt(p, it, 1 << 30, shm, 512);
    for (int it = bid; it < 256; it += nb) phase_attn_sample(p, it + 768, 1 << 30, shm, 1024);
    WQ_LOOP(1, 256, phase_attn_prompt(p, item + 256, 1 << 30, shm, 512));
    WQ_LOOP(3, 1024, phase_scan(p, item + 32, 1 << 30, shm, 0, 1056));
    xcd_barrier(xb);
    phase_gemm2_sample(p, bid, nb, shm);
    phase_stage3(p, bid, nb, shm, 1024);
#undef WQ_LOOP
    xcd_barrier(xb);
    phase_norm_sample(p, bid, nb);
    for (int uu = bid; uu < 256; uu += nb) {
        pg8::Gemm g{(const pg8::bf16_t*)(p.ws + WS_O), (const pg8::bf16_t*)(p.ws + WS_WOUTT), NROWS, DM, DM}; OneUnitOrder S1u; const int ix_ = uu >> 3; S1u.pm = (uu & 7) * 8 + (ix_ >> 2); S1u.pn = ix_ & 3;
        EpiResNorm E{p.out, p.x_prompt, p.x_sample, p.norm_f, (float*)(p.ws + WS_STATS), bar}; pg8::gemm_phase<EpiResNorm, OneUnitOrder, false>((PG8_LAS unsigned char*)shm, g, S1u, E, nullptr);
    }
}

extern "C" void kernel_launch(void* const* d_in, const int* in_sizes, int n_in, void* d_out, int out_size, void* d_ws, size_t ws_size, hipStream_t stream) {
    if (ws_size < WS_END) { fprintf(stderr, "kernel_launch: workspace too small (%zu < %zu)\n", ws_size, (size_t)WS_END); return; }
    static int grid = 0;
    if (!grid) {
        int dev = 0, cus = 0, per_cu = 0;
        (void)hipGetDevice(&dev); (void)hipDeviceGetAttribute(&cus, hipDeviceAttributeMultiprocessorCount, dev);
        (void)hipFuncSetAttribute((const void*)k_mega, hipFuncAttributeMaxDynamicSharedMemorySize, LDS_BYTES);
        (void)hipOccupancyMaxActiveBlocksPerMultiprocessor(&per_cu, (const void*)k_mega, 512, LDS_BYTES);
        if (per_cu < 1) { fprintf(stderr, "kernel_launch: occupancy query says %d blocks per CU\n", per_cu); per_cu = 1; }
        grid = cus > 0 ? cus : 256;
    }
    Params p{};
    p.x_prompt = (const float*)d_in[0]; p.x_sample = (const float*)d_in[1]; p.cache_k = (const float*)d_in[2]; p.cache_v = (const float*)d_in[3]; p.page_table = (const int*)d_in[4];
    p.state_wkv = (const float*)d_in[5]; p.state_shift = (const float*)d_in[6]; p.norm_in = (const float*)d_in[7]; p.w_in = (const float*)d_in[8]; p.sb_bias = (const float*)d_in[9];
    p.mu = (const float*)d_in[10]; p.w0 = (const float*)d_in[11]; p.w_up = (const float*)d_in[12]; p.a0 = (const float*)d_in[13]; p.a_up = (const float*)d_in[14];
    p.k_k = (const float*)d_in[15]; p.k_a = (const float*)d_in[16]; p.r_k = (const float*)d_in[17]; p.ln_w = (const float*)d_in[18]; p.ln_b = (const float*)d_in[19];
    p.w_out = (const float*)d_in[20]; p.norm_f = (const float*)d_in[21];
    p.out = (float*)d_out; p.ws = (unsigned char*)d_ws;
    (void)hipMemsetAsync((unsigned char*)d_ws + WS_BAR, 0, CTL_BYTES, stream);
    hipLaunchKernelGGL(k_mega, dim3(grid), dim3(512), LDS_BYTES, stream, p);
}
```

```cpp
#include <hip/hip_runtime.h>
#include <stdint.h>
#include <stdio.h>
__device__ __forceinline__ void mk_sync() { __builtin_amdgcn_fence(__ATOMIC_RELEASE, "workgroup"); __builtin_amdgcn_s_barrier(); __builtin_amdgcn_fence(__ATOMIC_ACQUIRE, "workgroup"); }
#define __syncthreads() mk_sync()
__device__ __forceinline__ void lds_sync() { asm volatile("s_waitcnt lgkmcnt(0)\n\ts_barrier" ::: "memory"); }
namespace pg8 {
#define PG8_LAS __attribute__((address_space(3)))
typedef unsigned short bf16_t;
typedef short bf16x8 __attribute__((ext_vector_type(8)));
typedef float f32x4 __attribute__((ext_vector_type(4)));
typedef unsigned u32x4 __attribute__((ext_vector_type(4)));
constexpr int BM = 256, BK = 64, HALF = 128, HTB = HALF * BK * 2  , STAGE_BYTES = 8 * HTB, NXCD = 8, WGM = 8;

__host__ __device__ __forceinline__ int lds_byte(int r, int c) { const int st = (r >> 4) * 2 + (c >> 5), rr = r & 15, cc = c & 31, ob = rr * 64 + cc * 2; return st * 1024 + (ob ^ (((ob >> 9) & 1) << 5)); }
__host__ __device__ __forceinline__ void stage_rc(int b, int& R, int& C) { const int st = b / 1024, sb = b % 1024, swz = sb ^ (((sb >> 9) & 1) << 5); R = (st >> 1) * 16 + swz / 64; C = (st & 1) * 32 + (swz % 64) / 2; }
__host__ __device__ __forceinline__ int perm32(int rho) { const int n = rho >> 4, i = rho & 15; return 8 * (i >> 2) + 4 * n + (i & 3); }

struct Unit { int pm, pn; };
struct Gemm { const bf16_t* A; const bf16_t* Bt; int M, N, K; };

struct StaticOrder {
    int nM, nN, nwg, G, c;
    __host__ __device__ __forceinline__ void init(int M, int N, int G_, int c_) { nM = M / BM; nN = N / BM; nwg = nM * nN; G = G_; c = c_; }
    __host__ __device__ __forceinline__ bool next(int i, Unit& u) const {
        const long L = (long)i * G + c; if (L >= nwg) return false;
        int wgid = (int)L; { const int q = nwg / NXCD, r = nwg % NXCD, xcd = wgid % NXCD, off = wgid / NXCD; wgid = (xcd < r ? xcd * (q + 1) : r * (q + 1) + (xcd - r) * q) + off; }
        const int nig = WGM * nN, gid = wgid / nig, fm = gid * WGM, gsz = (nM - fm) < WGM ? (nM - fm) : WGM;
        u.pm = fm + ((wgid % nig) % gsz); u.pn = (wgid % nig) / gsz; return true;
    }
    __device__ __forceinline__ void a_ready(const Unit&) const {}
    __device__ __forceinline__ void done(const Unit&) const {}
};
struct CountedOrder : StaticOrder {
    const unsigned* ready; unsigned need; unsigned* tmo;
    __device__ __forceinline__ void a_ready(const Unit& u) const {
        if (threadIdx.x < 64) {
            const unsigned long long t0 = __builtin_amdgcn_s_memrealtime(); unsigned polls = 0;
            while ((unsigned)__builtin_amdgcn_readfirstlane(__hip_atomic_load(ready + 64 * u.pm, __ATOMIC_RELAXED, __HIP_MEMORY_SCOPE_AGENT)) < need) {
                if ((++polls & 255u) == 0u && __builtin_amdgcn_readfirstlane(__hip_atomic_load(tmo, __ATOMIC_RELAXED, __HIP_MEMORY_SCOPE_AGENT)) != 0u) break;
                if (__builtin_amdgcn_s_memrealtime() - t0 > 2000000ull) {
                    if (threadIdx.x == 0) { unsigned expect = 0u; __hip_atomic_compare_exchange_strong(tmo + 1, &expect, 0x600u | (unsigned)(u.pm & 0xff), __ATOMIC_RELAXED, __ATOMIC_RELAXED, __HIP_MEMORY_SCOPE_AGENT); __hip_atomic_store(tmo, 1u, __ATOMIC_RELAXED, __HIP_MEMORY_SCOPE_AGENT); }
                    break; }
                __builtin_amdgcn_s_sleep(2); }
            __builtin_amdgcn_fence(__ATOMIC_ACQUIRE, "agent");
            asm volatile("s_waitcnt vmcnt(0)" ::: "memory");
        }
#if !defined(BROKEN_HOOK_NO_BARRIER)
        asm volatile("" ::: "memory"); __builtin_amdgcn_s_barrier(); asm volatile("" ::: "memory");
#endif
    }
};

__device__ __forceinline__ unsigned cvt_pk_bf16(float lo, float hi) { unsigned r; asm volatile("v_cvt_pk_bf16_f32 %0, %1, %2" : "=v"(r) : "v"(lo), "v"(hi)); return r; }
typedef float f32x2 __attribute__((ext_vector_type(2)));
__device__ __forceinline__ f32x2 gelu_pk(f32x2 v) {
    const f32x2 av = __builtin_elementwise_abs(v), d = av * 0.2316418882f + 1.0f;
    f32x2 t; t.x = __builtin_amdgcn_rcpf(d.x); t.y = __builtin_amdgcn_rcpf(d.y);
    f32x2 q = t * 0.5307027145f + (-0.7265760135f); q = q * t + 0.7107068705f; q = q * t + (-0.142248368f); q = q * t + 0.127414796f; q = q * t;
    const f32x2 s = (v * v) * (-0.72134752044f);
    f32x2 e; e.x = __builtin_amdgcn_exp2f(s.x); e.y = __builtin_amdgcn_exp2f(s.y);
    const f32x2 m = v * (q * e), r = v - m;
    f32x2 o; o.x = v.x < 0.f ? m.x : r.x; o.y = v.y < 0.f ? m.y : r.y; return o;
}

struct EpiF32 {
    static constexpr bool PERM = false, AFTER_DRAIN = false;
    float* C; int ldc; const float* bias;
    __device__ __forceinline__ void operator()(const f32x4 (&acc)[2][2][4][2], const Unit& u, int wr, int wc, int fr, int fq) const {
        const int row0 = u.pm * BM + wr * 64 + fr, col0 = u.pn * BM + wc * 32 + 4 * fq;
        f32x4 bv[2][2];
#pragma unroll
        for (int bj = 0; bj < 2; ++bj)
#pragma unroll
            for (int n = 0; n < 2; ++n) bv[bj][n] = bias ? *(const f32x4*)(bias + col0 + bj * HALF + n * 16) : (f32x4){0.f, 0.f, 0.f, 0.f};
#pragma unroll
        for (int ai = 0; ai < 2; ++ai)
#pragma unroll
            for (int m = 0; m < 4; ++m) { float* rowp = C + (size_t)(row0 + ai * HALF + m * 16) * ldc + col0;
#pragma unroll
                for (int bj = 0; bj < 2; ++bj)
#pragma unroll
                    for (int n = 0; n < 2; ++n) *(f32x4*)(rowp + bj * HALF + n * 16) = acc[ai][bj][m][n] + bv[bj][n]; }
    }
};
template <class Epi, class Sched, bool STAMP = false>
__device__ __forceinline__ void gemm_phase(PG8_LAS unsigned char* lds, const Gemm g, const Sched& S, const Epi& E, unsigned long long* stamps) {
    int tid_ = threadIdx.x; asm volatile("" : "+v"(tid_));
    const int tid = tid_, wid = __builtin_amdgcn_readfirstlane(tid >> 6), lane = tid & 63, wr = wid >> 2, wc = wid & 3, fr = lane & 15, fq = lane >> 4;
    const int K = g.K, nt = K / BK;
    int ts_lo = 0, ts_hi = 0, nts = 0; const unsigned long long rt_entry = STAMP ? (unsigned long long)wall_clock64() : 0ull;
#define PG8_STAMP() do { if (STAMP && wid == 0 && nts < 64) { const unsigned long long _c = (unsigned long long)clock64(); \
        ts_lo = (lane == nts) ? (int)(unsigned)_c : ts_lo; ts_hi = (lane == nts) ? (int)(unsigned)(_c >> 32) : ts_hi; ++nts; } } while (0)
    PG8_STAMP();
    unsigned voffA[2], voffB[2];
#pragma unroll
    for (int i = 0; i < 2; ++i) { int R, C; stage_rc(tid * 16 + i * 8192, R, C); const int Rb = Epi::PERM ? ((R & ~31) + perm32(R & 31)) : R;
        voffA[i] = (unsigned)(R * K + C) * 2u; voffB[i] = (unsigned)(Rb * K + C) * 2u; }
    const size_t kstep = (size_t)(BK * 2);
    const size_t hstep = (size_t)HALF * K * 2;
    const size_t tstep = 2 * hstep;
    const unsigned ldsw = (unsigned)wid * 1024u;
    const int aoff = lds_byte(wr * 64 + fr, fq * 8), boff = lds_byte(wc * 32 + fr, fq * 8);
#define PG8_SA(b, h) (((b) * 2 + (h)) * HTB)
#define PG8_SB(b, h) ((4 + (b) * 2 + (h)) * HTB)
#define PG8_STAGE(bufoff, gbase, voff) do { _Pragma("unroll") for (int _i = 0; _i < 2; ++_i) \
        __builtin_amdgcn_global_load_lds((const unsigned*)((const char*)(gbase) + (voff)[_i]), (PG8_LAS unsigned*)(lds + (bufoff) + ldsw + _i * 8192), 16, 0, 0); } while (0)
#define PG8_LDA(dst, b, h) do { _Pragma("unroll") for (int m = 0; m < 4; ++m) _Pragma("unroll") for (int k = 0; k < 2; ++k) dst[m][k] = *(const PG8_LAS bf16x8*)(lds + PG8_SA(b, h) + aoff + m * 2048 + k * 1024); } while (0)
#define PG8_LDB(dst, b, h) do { _Pragma("unroll") for (int n = 0; n < 2; ++n) _Pragma("unroll") for (int k = 0; k < 2; ++k) dst[n][k] = *(const PG8_LAS bf16x8*)(lds + PG8_SB(b, h) + boff + n * 2048 + k * 1024); } while (0)
#define PG8_MMA(ai, bj, At, Bt) do { __builtin_amdgcn_s_setprio(1); _Pragma("unroll") for (int m = 0; m < 4; ++m) _Pragma("unroll") for (int n = 0; n < 2; ++n) _Pragma("unroll") for (int k = 0; k < 2; ++k) \
        acc[ai][bj][m][n] = __builtin_amdgcn_mfma_f32_16x16x32_bf16(Bt[n][k], At[m][k], acc[ai][bj][m][n], 0, 0, 0); __builtin_amdgcn_s_setprio(0); } while (0)
#define PG8_WAIT_V(n) asm volatile("s_waitcnt vmcnt(" #n ")" ::: "memory")
#define PG8_WAIT_L(n) asm volatile("s_waitcnt lgkmcnt(" #n ")" ::: "memory")
#define PG8_BAR __builtin_amdgcn_s_barrier()
#define PG8_SCHED __builtin_amdgcn_sched_barrier(0)
    Unit cur, nxt; int ui = 0;
    if (!S.next(0, cur)) return;
    f32x4 acc[2][2][4][2];
#pragma unroll
    for (int a = 0; a < 2; ++a)
#pragma unroll
        for (int b = 0; b < 2; ++b)
#pragma unroll
            for (int m = 0; m < 4; ++m)
#pragma unroll
                for (int n = 0; n < 2; ++n) acc[a][b][m][n] = (f32x4){0.f, 0.f, 0.f, 0.f};
    bf16x8 At[4][2], B0[2][2], B1[2][2];
    const char* cA = (const char*)g.A + (size_t)cur.pm * tstep; const char* cB = (const char*)g.Bt + (size_t)cur.pn * tstep;
    S.a_ready(cur);
    PG8_STAGE(PG8_SB(0, 0), cB, voffB); PG8_STAGE(PG8_SA(0, 0), cA, voffA); PG8_STAGE(PG8_SB(0, 1), cB + hstep, voffB); PG8_STAGE(PG8_SA(0, 1), cA + hstep, voffA);
    if (wr == 1) PG8_BAR;
    PG8_WAIT_V(4); PG8_BAR;
    PG8_STAGE(PG8_SB(1, 0), cB + kstep, voffB); PG8_STAGE(PG8_SA(1, 0), cA + kstep, voffA); PG8_STAGE(PG8_SB(1, 1), cB + hstep + kstep, voffB);
    PG8_WAIT_V(6); PG8_BAR;
    PG8_STAMP();
    for (;;) {
        const bool has_next = S.next(ui + 1, nxt);
        const char* nA = has_next ? (const char*)g.A + (size_t)nxt.pm * tstep : cA; const char* nB = has_next ? (const char*)g.Bt + (size_t)nxt.pn * tstep : cB;
        for (int t = 0; t < nt; t += 2) {
            const bool last = (t == nt - 2);
            const char* a1 = cA + (size_t)(t + 1) * kstep;
            const char* a2 = last ? nA : cA + (size_t)(t + 2) * kstep; const char* b2 = last ? nB : cB + (size_t)(t + 2) * kstep;
            const char* a3 = a2 + kstep; const char* b3 = b2 + kstep;
            if (last && has_next) S.a_ready(nxt);
            PG8_LDB(B0, 0, 0); PG8_SCHED; PG8_LDA(At, 0, 0); PG8_STAGE(PG8_SA(1, 1), a1 + hstep, voffA);
            PG8_WAIT_L(8); PG8_BAR; PG8_WAIT_L(0); PG8_MMA(0, 0, At, B0); PG8_BAR; PG8_SCHED;
            PG8_LDB(B1, 0, 1); PG8_STAGE(PG8_SB(0, 0), b2, voffB);
            PG8_BAR; PG8_WAIT_L(0); PG8_MMA(0, 1, At, B1); PG8_BAR;
            PG8_LDA(At, 0, 1); PG8_STAGE(PG8_SA(0, 0), a2, voffA);
            PG8_BAR; PG8_WAIT_L(0); PG8_MMA(1, 0, At, B0); PG8_BAR; PG8_SCHED;
            PG8_STAGE(PG8_SB(0, 1), b2 + hstep, voffB);
            PG8_WAIT_V(6); PG8_BAR; PG8_MMA(1, 1, At, B1); PG8_BAR;
            PG8_LDB(B0, 1, 0); PG8_SCHED; PG8_LDA(At, 1, 0); PG8_STAGE(PG8_SA(0, 1), a2 + hstep, voffA);
            PG8_WAIT_L(8); PG8_BAR; PG8_WAIT_L(0); PG8_MMA(0, 0, At, B0); PG8_BAR; PG8_SCHED;
            PG8_LDB(B1, 1, 1); PG8_STAGE(PG8_SB(1, 0), b3, voffB);
            PG8_BAR; PG8_WAIT_L(0); PG8_MMA(0, 1, At, B1); PG8_BAR;
            PG8_LDA(At, 1, 1); PG8_STAGE(PG8_SA(1, 0), a3, voffA);
            PG8_BAR; PG8_WAIT_L(0); PG8_MMA(1, 0, At, B0); PG8_BAR; PG8_SCHED;
            PG8_STAGE(PG8_SB(1, 1), b3 + hstep, voffB);
            PG8_WAIT_V(6); PG8_BAR; PG8_MMA(1, 1, At, B1); PG8_BAR;
        }
        PG8_STAMP();
        if constexpr (!Epi::AFTER_DRAIN) { E(acc, cur, wr, wc, fr, fq); S.done(cur); }
        PG8_STAMP();
        if (!has_next) break;
#pragma unroll
        for (int a = 0; a < 2; ++a)
#pragma unroll
            for (int b = 0; b < 2; ++b)
#pragma unroll
                for (int m = 0; m < 4; ++m)
#pragma unroll
                    for (int n = 0; n < 2; ++n) acc[a][b][m][n] = (f32x4){0.f, 0.f, 0.f, 0.f};
        cur = nxt; cA = nA; cB = nB; ++ui;
    }
    PG8_WAIT_V(0);
    if (wr == 0) PG8_BAR;
    PG8_BAR;
    if constexpr (Epi::AFTER_DRAIN) { E.fused(acc, cur, wr, wc, fr, fq, lds, wid, lane); S.done(cur); }
    PG8_STAMP();
    if (STAMP && wid == 0) { stamps[lane] = lane < nts ? (((unsigned long long)(unsigned)ts_hi << 32) | (unsigned)ts_lo) : 0ull;
        if (lane == 62) stamps[62] = rt_entry; if (lane == 63) stamps[63] = (unsigned long long)wall_clock64(); }
#undef PG8_STAMP
#undef PG8_SA
#undef PG8_SB
#undef PG8_STAGE
#undef PG8_LDA
#undef PG8_LDB
#undef PG8_MMA
#undef PG8_WAIT_V
#undef PG8_WAIT_L
#undef PG8_BAR
#undef PG8_SCHED
}
}

#define XB_TMO      128
#define XB_XCNT(j)  (256  + 64 * (j))
#define XB_XSUB(j)  (1280 + 64 * (j))
#define XB_XGEN(j)  (2304 + 64 * (j))
#define XB_TOP      3328
#define XB_TOPGEN   3392
#define XCD_BAR_WORDS 3456
#define XB_SPIN_CAP (1u << 18)
#define LAS __attribute__((address_space(3)))

__device__ __forceinline__ unsigned xb_ld(unsigned* p)              { return __hip_atomic_load(p, __ATOMIC_RELAXED, __HIP_MEMORY_SCOPE_AGENT); }
__device__ __forceinline__ unsigned xb_add(unsigned* p, unsigned v) { return __hip_atomic_fetch_add(p, v, __ATOMIC_RELAXED, __HIP_MEMORY_SCOPE_AGENT); }
__device__ __forceinline__ unsigned xb_xcc_id() { return (unsigned)__builtin_amdgcn_s_getreg((3 << 11) | 20) & 0xFu; }
#define XB_SPIN(cond, bar) do { unsigned _sp = 0; while (cond) { __builtin_amdgcn_s_sleep(1); \
    if ((++_sp & 255u) == 0u) { if (xb_ld(&(bar)[XB_TMO])) break; if (_sp > XB_SPIN_CAP) { atomicAdd(&(bar)[XB_TMO], 1u); break; } } } } while (0)

struct XcdBarrier {
    unsigned* bar; unsigned x;
    volatile LAS unsigned* st;
};

__device__ __forceinline__ XcdBarrier xcd_barrier_post(unsigned* bar, volatile LAS unsigned* st) {
    XcdBarrier b; b.bar = bar; b.x = xb_xcc_id(); b.st = st;
    if (threadIdx.x == 0) (void)xb_add(&bar[XB_XCNT(b.x)], 1u);
    return b;
}
__device__ __forceinline__ void xcd_barrier_complete(unsigned* bar, unsigned x, unsigned& nloc, unsigned& nx) {
    const unsigned G = gridDim.x * gridDim.y * gridDim.z;
    unsigned sum, cnt, mine, sp = 0u;
    for (;;) {
        sum = 0u; cnt = 0u; mine = 0u;
#pragma unroll
        for (unsigned j = 0; j < 16; ++j) { const unsigned c = xb_ld(&bar[XB_XCNT(j)]); sum += c; cnt += (c > 0u) ? 1u : 0u; mine = (j == x) ? c : mine; }
        if (sum == G) break;
        __builtin_amdgcn_s_sleep(1);
        if ((++sp & 255u) == 0u) { if (xb_ld(&bar[XB_TMO])) break; if (sp > XB_SPIN_CAP) { atomicAdd(&bar[XB_TMO], 1u); break; } }
    }
    nloc = mine > 0u ? mine : 1u; nx = cnt > 0u ? cnt : 1u;
}

__device__ __forceinline__ void xcd_barrier(const XcdBarrier& b) {
    asm volatile("s_waitcnt vmcnt(0)" ::: "memory");
    __syncthreads();
    if (threadIdx.x == 0) {
        unsigned* bar = b.bar;
        __builtin_amdgcn_s_waitcnt(0);
        unsigned nloc = b.st[0], nx = b.st[1];
        if (nloc == 0u) { xcd_barrier_complete(bar, b.x, nloc, nx); b.st[0] = nloc; b.st[1] = nx; }
        const unsigned old = xb_add(&bar[XB_XSUB(b.x)], 1u);
        const unsigned gen = old / nloc;
        if (old + 1u == (gen + 1u) * nloc) {
            __builtin_amdgcn_fence(__ATOMIC_RELEASE, "agent");
            asm volatile("s_waitcnt vmcnt(0)" ::: "memory");
            const unsigned og = xb_add(&bar[XB_TOP], 1u);
            const unsigned tg = og / nx;
            if (og + 1u == (tg + 1u) * nx) xb_add(&bar[XB_TOPGEN], 1u);
            else XB_SPIN(xb_ld(&bar[XB_TOPGEN]) == tg, bar);
            __builtin_amdgcn_fence(__ATOMIC_ACQUIRE, "agent");
            xb_add(&bar[XB_XGEN(b.x)], 1u);
            asm volatile("s_waitcnt vmcnt(0)" ::: "memory");
        } else {
            XB_SPIN(xb_ld(&bar[XB_XGEN(b.x)]) == gen, bar);
            __builtin_amdgcn_fence(__ATOMIC_ACQUIRE, "agent");
            asm volatile("s_waitcnt vmcnt(0)" ::: "memory");
        }
    }
    __syncthreads();
}

typedef unsigned short u16;
typedef short bf16x8 __attribute__((ext_vector_type(8)));
typedef short s16x4 __attribute__((ext_vector_type(4)));
typedef float f32x16 __attribute__((ext_vector_type(16)));
typedef float f32x4 __attribute__((ext_vector_type(4)));
typedef unsigned u32x4 __attribute__((ext_vector_type(4)));
typedef unsigned u32x2 __attribute__((ext_vector_type(2)));

constexpr int NROWS = 17408, NPROW = 16384, DM = 1024, NIN = 4224, NINP = 4352, SEQ = 4096;
constexpr int RWC = 2176;
constexpr size_t OUT_Y = 0, OUT_KP = 17825792, OUT_VP = 26214400, OUT_WKVP = 34603008, OUT_SHP = 34734080,
                 OUT_KS = 34742784, OUT_VS = 35267072, OUT_WKVS = 35791360, OUT_SHS = 39985664;
constexpr size_t WS_BAR = 0;
constexpr size_t WS_XB = 32768;
constexpr size_t WS_WINT = WS_XB + (size_t)NROWS * DM * 2;
constexpr size_t WS_WOUTT = WS_WINT + (size_t)NINP * DM * 2;
constexpr size_t WS_P = WS_WOUTT + (size_t)DM * DM * 2;
constexpr size_t WS_QB = WS_P + (size_t)NROWS * NINP * 4;
constexpr size_t WS_KB = WS_QB + (size_t)NROWS * 512 * 2;
constexpr size_t WS_VB = WS_KB + (size_t)NROWS * 512 * 2;
constexpr size_t WS_SR = WS_VB + (size_t)NROWS * 512 * 2;
constexpr size_t SARR = (size_t)NROWS * 512 * 4;
constexpr size_t WS_SW = WS_SR + SARR, WS_SK = WS_SW + SARR, WS_SV = WS_SK + SARR, WS_SA = WS_SV + SARR, WS_SB = WS_SA + SARR, WS_SG = WS_SB + SARR, WS_S2 = WS_SG + SARR;
constexpr size_t WS_O = WS_S2 + SARR;
constexpr size_t WS_PM = WS_O + (size_t)NROWS * DM * 2;
constexpr size_t WS_QM = WS_PM + (size_t)2048 * 4096 * 2;
constexpr size_t WS_WH = WS_QM + (size_t)2048 * 4096 * 4;
constexpr size_t WS_Y0 = WS_WH + (size_t)2048 * 4096 * 2;
constexpr size_t WS_SC = WS_Y0 + (size_t)2048 * 4096 * 4;
constexpr size_t WS_WUPT = WS_SC + (size_t)2048 * 4096 * 2;
constexpr size_t WS_AUPT = WS_WUPT + 65536;
constexpr size_t WS_STATS = WS_AUPT + 65536;
constexpr size_t WS_END = WS_STATS + (size_t)68 * 1024 * 4;

struct Params {
    const float* x_prompt; const float* x_sample; const float* cache_k; const float* cache_v; const int* page_table;
    const float* state_wkv; const float* state_shift; const float* norm_in; const float* w_in; const float* sb_bias;
    const float* mu; const float* w0; const float* w_up; const float* a0; const float* a_up; const float* k_k; const float* k_a;
    const float* r_k; const float* ln_w; const float* ln_b; const float* w_out; const float* norm_f;
    float* out; unsigned char* ws;
};

#define LOG2E 1.4426950408889634f
#define MFMA32(a, b, c) __builtin_amdgcn_mfma_f32_32x32x16_bf16(a, b, c, 0, 0, 0)

typedef float f32x2_t __attribute__((ext_vector_type(2)));
typedef __bf16 bf16x2_t __attribute__((ext_vector_type(2)));
__device__ __forceinline__ unsigned cvtpk(float lo, float hi) { const f32x2_t v = {lo, hi}; return __builtin_bit_cast(unsigned, __builtin_convertvector(v, bf16x2_t)); }
__device__ __forceinline__ u16 f2bf(float f) { return (u16)(cvtpk(f, 0.f) & 0xffffu); }
template <int CTRL> __device__ __forceinline__ float dppf(float x) { return __builtin_bit_cast(float, __builtin_amdgcn_update_dpp(0, __builtin_bit_cast(int, x), CTRL, 0xf, 0xf, true)); }
__device__ __forceinline__ float reduce8(float x) { x += dppf<0xB1>(x); x += dppf<0x4E>(x); x += dppf<0x141>(x); return x; }
__device__ __forceinline__ float wave_sum(float x) {
    x += dppf<0xB1>(x); x += dppf<0x4E>(x); x += dppf<0x124>(x); x += dppf<0x128>(x);
    auto r1 = __builtin_amdgcn_permlane16_swap(__float_as_uint(x), __float_as_uint(x), false, false);
    const float y = __uint_as_float(r1[0]) + __uint_as_float(r1[1]);
    auto r2 = __builtin_amdgcn_permlane32_swap(__float_as_uint(y), __float_as_uint(y), false, false);
    return __uint_as_float(r2[0]) + __uint_as_float(r2[1]); }
__device__ __forceinline__ int otid() { int t = threadIdx.x; asm volatile("" : "+v"(t)); return t; }
__device__ __forceinline__ float frcp(float x) { return __builtin_amdgcn_rcpf(x); }
__device__ __forceinline__ float silu_f(float g) { return g * frcp(1.0f + __expf(-g)); }
__device__ __forceinline__ float softplus_f(float x) { return fmaxf(x, 0.f) + __logf(1.0f + __expf(-fabsf(x))); }

__device__ __forceinline__ void phase_prologue(const Params& p, int bid, int nb, unsigned char* smem) {
    const int tid = otid(), lane = tid & 63, w = tid >> 6;
    u16* Xb = (u16*)(p.ws + WS_XB);
    u16* WupT = (u16*)(p.ws + WS_WUPT); u16* AupT = (u16*)(p.ws + WS_AUPT);
    const int e0 = bid * 512 + tid; float up0 = 0.f;
    if (e0 < 65536) { const int which = e0 >> 15, idx = e0 & 32767, cc = idx >> 6, ii = idx & 63; up0 = (which ? p.a_up : p.w_up)[ii * 512 + cc]; }
    float* tileb = (float*)smem;
    u16* WinT = (u16*)(p.ws + WS_WINT); u16* WoutT = (u16*)(p.ws + WS_WOUTT);
    const int NT1 = (NINP / 64) * 16, NT2 = 16 * 16;
    float tv[8], tn[8]; int buf = 0;
    auto tload = [&](int id) {
        const bool first = id < NT1; const int id2 = first ? id : id - NT1; const int nt = id2 / 16, kt = id2 % 16, n0 = nt * 64, k0 = kt * 64;
#pragma unroll
        for (int j = 0; j < 8; ++j) { const int e = tid + 512 * j, kr = e >> 6, nc = e & 63;
            if (first) { tv[j] = (n0 + nc < NIN) ? p.w_in[(size_t)(k0 + kr) * NIN + n0 + nc] : 0.f; tn[j] = p.norm_in[k0 + kr]; }
            else { tv[j] = p.w_out[(size_t)(k0 + kr) * DM + n0 + nc]; tn[j] = 1.0f; } } };
    if (bid < NT1) tload(bid);
    constexpr int NR = 5;
    for (int row = bid * 8 + w; row < NROWS; row += nb * 8 * NR) {
        f32x4 v[NR][4];
#pragma unroll
        for (int k = 0; k < NR; ++k) { const int rk = row + k * nb * 8;
            if (rk < NROWS) { const float* src = rk < NPROW ? p.x_prompt + (size_t)rk * DM : p.x_sample + (size_t)(rk - NPROW) * DM;
#pragma unroll
                for (int i = 0; i < 4; ++i) v[k][i] = *(const f32x4*)(src + lane * 4 + i * 256); }
            else {
#pragma unroll
                for (int i = 0; i < 4; ++i) { const f32x4 z = {0.f, 0.f, 0.f, 0.f}; v[k][i] = z; } } }
#pragma unroll
        for (int k = 0; k < NR; ++k) { const int rk = row + k * nb * 8;
            float ss = 0.f;
#pragma unroll
            for (int i = 0; i < 4; ++i) ss += v[k][i][0] * v[k][i][0] + v[k][i][1] * v[k][i][1] + v[k][i][2] * v[k][i][2] + v[k][i][3] * v[k][i][3];
            ss = wave_sum(ss);
            const float rs = rsqrtf(ss * (1.0f / 1024.0f) + 1e-6f);
            if (rk < NROWS) {
#pragma unroll
                for (int i = 0; i < 4; ++i) { u32x2 o; o.x = cvtpk(v[k][i][0] * rs, v[k][i][1] * rs); o.y = cvtpk(v[k][i][2] * rs, v[k][i][3] * rs); *(u32x2*)(Xb + (size_t)rk * DM + lane * 4 + i * 256) = o; } } }
    }
    if (e0 < 65536) { const int which = e0 >> 15, idx = e0 & 32767, cc = idx >> 6, ii = idx & 63; (which ? AupT : WupT)[cc * 64 + ii] = f2bf(up0); }
    for (int e = e0 + nb * 512; e < 65536; e += nb * 512) { const int which = e >> 15, idx = e & 32767, cc = idx >> 6, ii = idx & 63;
        const float val = (which ? p.a_up : p.w_up)[ii * 512 + cc]; (which ? AupT : WupT)[cc * 64 + ii] = f2bf(val); }
    for (int id = bid; id < NT1; id += nb) {
        const bool first = id < NT1; const int id2 = first ? id : id - NT1; const int nt = id2 / 16, kt = id2 % 16, n0 = nt * 64, k0 = kt * 64;
        float* tile = tileb + buf * (64 * 65);
#pragma unroll
        for (int j = 0; j < 8; ++j) { const int e = tid + 512 * j; tile[(e >> 6) * 65 + (e & 63)] = tv[j] * tn[j]; }
        lds_sync();
        if (id + nb < NT1) tload(id + nb);
        u16* dst = first ? WinT : WoutT;
#pragma unroll
        for (int j = 0; j < 4; ++j) { const int e = tid + 512 * j, nr = e >> 5, kc = (e & 31) * 2; *(unsigned*)(dst + (size_t)(n0 + nr) * DM + k0 + kc) = cvtpk(tile[kc * 65 + nr], tile[(kc + 1) * 65 + nr]); }
        buf ^= 1;
    }
    __syncthreads();
}

__device__ __forceinline__ void phase_wout_tiles(const Params& p, int idx, int stride, unsigned char* smem) {
    const int tid = otid();
    float* tileb = (float*)smem;
    u16* WoutT = (u16*)(p.ws + WS_WOUTT);
    float tv[8]; int buf = 0;
    auto tload = [&](int id) { const int nt = id / 16, kt = id % 16, n0 = nt * 64, k0 = kt * 64;
#pragma unroll
        for (int j = 0; j < 8; ++j) { const int e = tid + 512 * j, kr = e >> 6, nc = e & 63; tv[j] = p.w_out[(size_t)(k0 + kr) * DM + n0 + nc]; } };
    if (idx < 256) tload(idx);
    __syncthreads();
    for (int id = idx; id < 256; id += stride) {
        const int nt = id / 16, kt = id % 16, n0 = nt * 64, k0 = kt * 64;
        float* tile = tileb + buf * (64 * 65);
#pragma unroll
        for (int j = 0; j < 8; ++j) { const int e = tid + 512 * j; tile[(e >> 6) * 65 + (e & 63)] = tv[j]; }
        lds_sync();
        if (id + stride < 256) tload(id + stride);
#pragma unroll
        for (int j = 0; j < 4; ++j) { const int e = tid + 512 * j, nr = e >> 5, kc = (e & 31) * 2; *(unsigned*)(WoutT + (size_t)(n0 + nr) * DM + k0 + kc) = cvtpk(tile[kc * 65 + nr], tile[(kc + 1) * 65 + nr]); }
        buf ^= 1;
    }
    __syncthreads();
}

constexpr int PREP_TW = 0, PREP_TA = 32 * 144, PREP_LW = 2 * 32 * 144, PREP_LP = 516, PREP_LA = PREP_LW + 32 * PREP_LP * 4, PREP_END = PREP_LA + 32 * PREP_LP * 4;
struct PrepRow { float xr, xk, xv, xg; };
__device__ __forceinline__ void prep_load(PrepRow& o, const float* prow, int c) { o.xr = prow[2048 + c]; o.xk = prow[2560 + c]; o.xv = prow[3072 + c]; o.xg = prow[3584 + c]; }
__device__ __forceinline__ void phase_prep_unit(const Params& p, int u, unsigned char* smem) {
    const int c = otid(), lane = c & 63, r32 = lane & 31, hi = lane >> 5; const int w = __builtin_amdgcn_readfirstlane(c >> 6);
    const float* P = (const float*)(p.ws + WS_P);
    u16* Qb = (u16*)(p.ws + WS_QB); u16* Kb = (u16*)(p.ws + WS_KB); u16* Vb = (u16*)(p.ws + WS_VB);
    float* SR = (float*)(p.ws + WS_SR); float* SW = (float*)(p.ws + WS_SW); float* SK = (float*)(p.ws + WS_SK); float* SV = (float*)(p.ws + WS_SV);
    float* SA = (float*)(p.ws + WS_SA); float* SBb = (float*)(p.ws + WS_SB); float* SG = (float*)(p.ws + WS_SG); float* S2 = (float*)(p.ws + WS_S2);
    constexpr bool prompt = false; const int bd = u - 512;
    const int t0 = prompt ? (u & 127) * 32 : 0, n = prompt ? 32 : 8;
    const int row0 = prompt ? (u >> 7) * SEQ + t0 : NPROW + bd * 8;
    const bool has_prev_row = prompt && t0 > 0;
    {
        const int j = c & 127, tq = c >> 7, tb = tq * 8;
        if (tb < n) {
            const float mul = p.mu[2048 + j];
            float raw[8], prev;
#pragma unroll
            for (int k = 0; k < 8; ++k) raw[k] = P[(size_t)(row0 + tb + k) * NINP + 4096 + j];
            if (tb > 0 || has_prev_row) prev = P[(size_t)(row0 + tb - 1) * NINP + 4096 + j];
            else prev = prompt ? 0.f : p.state_shift[(size_t)bd * RWC + 2048 + j];
#pragma unroll
            for (int k = 0; k < 8; ++k) { const float zl = raw[k] + (prev - raw[k]) * mul; prev = raw[k];
                float val = zl; if (j < 64) { const float e2 = __expf(2.0f * zl); val = 1.0f - 2.0f / (e2 + 1.0f); }
                *(u16*)(smem + (j < 64 ? PREP_TW : PREP_TA) + (tb + k) * 144 + (j & 63) * 2) = f2bf(val); }
        }
    }
    __syncthreads();
    {
        const u16* WupT = (const u16*)(p.ws + WS_WUPT); const u16* AupT = (const u16*)(p.ws + WS_AUPT);
        float* LW = (float*)(smem + PREP_LW); float* LA = (float*)(smem + PREP_LA);
#pragma unroll
        for (int mt = 0; mt < 2; ++mt) {
            const int crow0 = (2 * w + mt) * 32;
            f32x16 accw, acca;
#pragma unroll
            for (int r = 0; r < 16; ++r) { accw[r] = 0.f; acca[r] = 0.f; }
#pragma unroll
            for (int ks = 0; ks < 4; ++ks) {
                const bf16x8 wa = *(const bf16x8*)(WupT + (crow0 + r32) * 64 + ks * 16 + hi * 8), aa = *(const bf16x8*)(AupT + (crow0 + r32) * 64 + ks * 16 + hi * 8);
                const bf16x8 tw = *(const bf16x8*)(smem + PREP_TW + r32 * 144 + ks * 32 + hi * 16), ta = *(const bf16x8*)(smem + PREP_TA + r32 * 144 + ks * 32 + hi * 16);
                accw = MFMA32(wa, tw, accw); acca = MFMA32(aa, ta, acca);
            }
#pragma unroll
            for (int g4 = 0; g4 < 4; ++g4) { const int cc = crow0 + 8 * g4 + 4 * hi;
                const f32x4 v1 = {accw[4 * g4], accw[4 * g4 + 1], accw[4 * g4 + 2], accw[4 * g4 + 3]}, v2 = {acca[4 * g4], acca[4 * g4 + 1], acca[4 * g4 + 2], acca[4 * g4 + 3]};
                *(f32x4*)(LW + r32 * PREP_LP + cc) = v1; *(f32x4*)(LA + r32 * PREP_LP + cc) = v2; }
        }
    }
    __syncthreads();
    {
        const float* LW = (const float*)(smem + PREP_LW); const float* LA = (const float*)(smem + PREP_LA);
        const float mu_r = p.mu[c], mu_k = p.mu[512 + c], mu_v = p.mu[1024 + c], mu_g = p.mu[1536 + c];
        const float w0c = p.w0[c], a0c = p.a0[c], kkc = p.k_k[c], kac = p.k_a[c], lnwc = p.ln_w[c], lnbc = p.ln_b[c], rkc = p.r_k[c];
        float pr, pk, pv, pg;
        if (has_prev_row) { const float* q = P + (size_t)(row0 - 1) * NINP + 2048; pr = q[c]; pk = q[512 + c]; pv = q[1024 + c]; pg = q[1536 + c]; }
        else if (prompt) { pr = pk = pv = pg = 0.f; }
        else { const float* q = p.state_shift + (size_t)bd * RWC; pr = q[c]; pk = q[512 + c]; pv = q[1024 + c]; pg = q[1536 + c]; }
        PrepRow cur[4], nxt[4];
#pragma unroll
        for (int e = 0; e < 4; ++e) { prep_load(cur[e], P + (size_t)(row0 + e) * NINP, c); nxt[e] = cur[e]; }
        for (int tg = 0; tg < n; tg += 4) {
            if (tg + 4 < n) {
#pragma unroll
                for (int e = 0; e < 4; ++e) prep_load(nxt[e], P + (size_t)(row0 + tg + 4 + e) * NINP, c); }
#pragma unroll
            for (int e = 0; e < 4; ++e) {
            const int t = tg + e; const int R = row0 + t;
            const float xr = cur[e].xr, xk = cur[e].xk, xv = cur[e].xv, xg = cur[e].xg;
            const float zr = xr + (pr - xr) * mu_r, zk = xk + (pk - xk) * mu_k, zv = xv + (pv - xv) * mu_v, zg = xg + (pg - xg) * mu_g;
            const float lw = LW[t * PREP_LP + c], la = LA[t * PREP_LP + c];
            const float xw = -(w0c + lw);
            const float sp = softplus_f(xw);
            const float decay = __expf(-__expf(-sp - 0.5f));
            const float alr = frcp(1.0f + __expf(-(a0c + la)));
            float kk = zk * kkc; const float ss = wave_sum(kk * kk); kk = kk * __builtin_amdgcn_rsqf(fmaxf(ss, 1e-24f));
            const float keff = zk * (1.0f + (alr - 1.0f) * kac);
            const size_t o = (size_t)R * 512 + c;
            const float bsum = wave_sum(zr * keff * rkc); const float sg = silu_f(zg);
            SR[o] = zr; SW[o] = decay; SK[o] = keff; SV[o] = zv; SA[o] = -kk; SBb[o] = kk * alr; SG[o] = lnwc * sg; S2[o] = (lnbc + bsum * zv) * sg;
            if ((prompt && t0 + t == SEQ - 1) || (!prompt && t == 7)) {
                float* sh = prompt ? p.out + OUT_SHP + (size_t)(R >> 12) * RWC : p.out + OUT_SHS + (size_t)bd * RWC;
                sh[c] = xr; sh[512 + c] = xk; sh[1024 + c] = xv; sh[1536 + c] = xg; if (c < 128) sh[2048 + c] = P[(size_t)R * NINP + 4096 + c]; }
            pr = xr; pk = xk; pv = xv; pg = xg;
            }
#pragma unroll
            for (int e = 0; e < 4; ++e) cur[e] = nxt[e];
        }
    }
    __syncthreads();
}

constexpr int SCH = 32;
constexpr int SARRF = SCH * 64 + 64;
constexpr int SBUFF = 6 * SARRF + SCH * 64;
struct ScanOps { f32x4 r, w, k, a, b; float v0, v1; };
__device__ __forceinline__ float allred16(float x) { x += dppf<0xB1>(x); x += dppf<0x4E>(x); x += dppf<0x124>(x); x += dppf<0x128>(x); return x; }
__device__ __forceinline__ void scan_load(ScanOps& o, const float* L, int t, int cg, int rowp) {
    const float* base = L + t * 64 + cg * 4;
    o.r = *(const f32x4*)(base); o.w = *(const f32x4*)(base + SARRF); o.k = *(const f32x4*)(base + 2 * SARRF);
    o.a = *(const f32x4*)(base + 4 * SARRF); o.b = *(const f32x4*)(base + 5 * SARRF);
    const float* vp = L + 3 * SARRF + t * 64 + rowp; o.v0 = vp[0]; o.v1 = vp[1];
}
__device__ __forceinline__ void scan_step(const ScanOps& o, float (&s0)[4], float (&s1)[4], float* ybuf, int t, int cg, int rowp) {
    float d0 = (s0[0] * o.a[0] + s0[1] * o.a[1]) + (s0[2] * o.a[2] + s0[3] * o.a[3]);
    float d1 = (s1[0] * o.a[0] + s1[1] * o.a[1]) + (s1[2] * o.a[2] + s1[3] * o.a[3]);
    float sw0[4], sw1[4];
#pragma unroll
    for (int e = 0; e < 4; ++e) { sw0[e] = __builtin_fmaf(s0[e], o.w[e], o.v0 * o.k[e]); sw1[e] = __builtin_fmaf(s1[e], o.w[e], o.v1 * o.k[e]); }
    d0 = allred16(d0); d1 = allred16(d1);
#pragma unroll
    for (int e = 0; e < 4; ++e) { s0[e] = __builtin_fmaf(d0, o.b[e], sw0[e]); s1[e] = __builtin_fmaf(d1, o.b[e], sw1[e]); }
    float y0 = (s0[0] * o.r[0] + s0[1] * o.r[1]) + (s0[2] * o.r[2] + s0[3] * o.r[3]);
    float y1 = (s1[0] * o.r[0] + s1[1] * o.r[1]) + (s1[2] * o.r[2] + s1[3] * o.r[3]);
    y0 = allred16(y0); y1 = allred16(y1);
    if (cg == 0) { ybuf[t * 64 + rowp] = y0; ybuf[t * 64 + rowp + 1] = y1; }
}
__device__ __forceinline__ void phase_scan(const Params& p, int bid, int nb, unsigned char* smem, int ulo, int uhi) {
    const int tid = otid(), lane = tid & 63, w = tid >> 6;
    float* LB = (float*)smem;
    const float* SRC[6] = {(const float*)(p.ws + WS_SR), (const float*)(p.ws + WS_SW), (const float*)(p.ws + WS_SK), (const float*)(p.ws + WS_SV), (const float*)(p.ws + WS_SA), (const float*)(p.ws + WS_SB)};
    const float* SG = (const float*)(p.ws + WS_SG); const float* S2 = (const float*)(p.ws + WS_S2);
    u16* O = (u16*)(p.ws + WS_O);
    const int cg = lane & 15, rowp = w * 8 + 2 * (lane >> 4);
    for (int u = ulo + bid; u < uhi; u += nb) {
        int h, row0, T; const float* sin; float* sout;
        if (u < 32) { h = u & 7; row0 = (u >> 3) * SEQ; T = SEQ; sin = nullptr; sout = p.out + OUT_WKVP + (size_t)u * 4096; }
        else { const int idx = u - 32; h = idx & 7; row0 = NPROW + (idx >> 3) * 8; T = 8; sin = p.state_wkv + (size_t)idx * 4096; sout = p.out + OUT_WKVS + (size_t)idx * 4096; }
        float s0[4], s1[4];
        if (sin) { const f32x4 a = *(const f32x4*)(sin + rowp * 64 + cg * 4), b = *(const f32x4*)(sin + (rowp + 1) * 64 + cg * 4);
#pragma unroll
            for (int e = 0; e < 4; ++e) { s0[e] = a[e]; s1[e] = b[e]; } }
        else {
#pragma unroll
            for (int e = 0; e < 4; ++e) { s0[e] = 0.f; s1[e] = 0.f; } }
        const int CH = T < SCH ? T : SCH, nch = T / CH;
        const int ptok = tid >> 4, pf4 = tid & 15; const bool pact = ptok < CH;
        f32x4 pf[6];
        if (pact) {
#pragma unroll
            for (int j = 0; j < 6; ++j) pf[j] = *(const f32x4*)(SRC[j] + (size_t)(row0 + ptok) * 512 + h * 64 + pf4 * 4); }
        __syncthreads();
        for (int ch = 0; ch < nch; ++ch) {
            float* L = LB + (ch & 1) * SBUFF; float* ybuf = L + 6 * SARRF;
            if (pact) {
#pragma unroll
                for (int j = 0; j < 6; ++j) *(f32x4*)(L + j * SARRF + ptok * 64 + pf4 * 4) = pf[j]; }
            __syncthreads();
            if (pact && ch + 1 < nch) {
#pragma unroll
                for (int j = 0; j < 6; ++j) pf[j] = *(const f32x4*)(SRC[j] + (size_t)(row0 + (ch + 1) * CH + ptok) * 512 + h * 64 + pf4 * 4); }
            ScanOps oa, ob;
            scan_load(oa, L, 0, cg, rowp);
            for (int t = 0; t < CH; t += 2) {
                scan_load(ob, L, t + 1, cg, rowp);
                scan_step(oa, s0, s1, ybuf, t, cg, rowp);
                scan_load(oa, L, t + 2, cg, rowp);
                scan_step(ob, s0, s1, ybuf, t + 1, cg, rowp);
            }
            __syncthreads();
            for (int tt = w; tt < CH; tt += 8) {
                const int R = row0 + ch * CH + tt;
                const float y = ybuf[tt * 64 + lane];
                const float mean = wave_sum(y) * (1.0f / 64.0f); const float dd = y - mean;
                const float var = wave_sum(dd * dd) * (1.0f / 64.0f);
                const size_t og = (size_t)R * 512 + h * 64 + lane;
                const float outv = dd * rsqrtf(var + 64e-5f) * SG[og] + S2[og];
                O[(size_t)R * DM + 512 + h * 64 + lane] = f2bf(outv);
            }
        }
        { f32x4 a = {s0[0], s0[1], s0[2], s0[3]}, b = {s1[0], s1[1], s1[2], s1[3]}; *(f32x4*)(sout + rowp * 64 + cg * 4) = a; *(f32x4*)(sout + (rowp + 1) * 64 + cg * 4) = b; }
    }
}

typedef __attribute__((address_space(3))) const char* lds_cptr;
typedef short v4i16_t __attribute__((ext_vector_type(4)));
__device__ __forceinline__ s16x4 vtr(lds_cptr ptr) { return __builtin_bit_cast(s16x4, __builtin_amdgcn_ds_read_tr16_b64_v4i16((__attribute__((address_space(3))) v4i16_t*)ptr)); }
__device__ __forceinline__ int crow(int r, int hi) { return (r & 3) + 8 * (r >> 2) + 4 * hi; }

__device__ __forceinline__ void sb_sub(f32x16& x, float& carry, int hi) {
    float t[16], g[4];
#pragma unroll
    for (int r = 0; r < 16; ++r) t[r] = __builtin_amdgcn_exp2f(__builtin_amdgcn_fmed3f(x[r], -3.0e38f, 30.0f));
#pragma unroll
    for (int m = 0; m < 4; ++m) { const float F1 = 1.0f + t[4 * m], F2 = __builtin_fmaf(t[4 * m + 1], F1, F1), F3 = __builtin_fmaf(t[4 * m + 2], F2, F2), F4 = __builtin_fmaf(t[4 * m + 3], F3, F3);
        g[m] = __builtin_amdgcn_rcpf(F4); t[4 * m + 1] = F2 - F1; t[4 * m + 2] = F3 - F2; t[4 * m + 3] = F4 - F3; }
    float cm[4];
#pragma unroll
    for (int m = 0; m < 4; ++m) { auto rr = __builtin_amdgcn_permlane32_swap(__float_as_uint(g[m]), __float_as_uint(g[m]), false, false);
        cm[m] = __uint_as_float(rr[0]) * __uint_as_float(rr[1]); }
    float D[5]; D[4] = carry; D[3] = cm[3] * D[4]; D[2] = cm[2] * D[3]; D[1] = cm[1] * D[2]; D[0] = cm[0] * D[1]; carry = D[0];
#pragma unroll
    for (int m = 0; m < 4; ++m) { const float gH = g[m] * D[m + 1]; const float gL = hi ? gH : D[m];
#pragma unroll
        for (int i = 0; i < 4; ++i) x[4 * m + i] = t[4 * m + i] * gL; }
}

__device__ __forceinline__ void sb_tile(lds_cptr ldsK, lds_cptr ldsV, const bf16x8 (&qr)[4], float bias2, int qrel, int lane, float& carry, f32x16 (&o)[2]) {
    const int r32 = lane & 31, hi = lane >> 5;
    const lds_cptr kp0 = ldsK + hi * 1024 + r32 * 16;
    bf16x8 kf[8];
#pragma unroll
    for (int d0 = 0; d0 < 4; ++d0) { kf[2 * d0] = *(const __attribute__((address_space(3))) bf16x8*)(kp0 + d0 * 2048); kf[2 * d0 + 1] = *(const __attribute__((address_space(3))) bf16x8*)(kp0 + d0 * 2048 + 512); }
    f32x16 C0, C1;
#pragma unroll
    for (int r = 0; r < 16; ++r) { C0[r] = bias2; C1[r] = bias2; }
#pragma unroll
    for (int d0 = 0; d0 < 4; ++d0) { C0 = MFMA32(kf[2 * d0], qr[d0], C0); C1 = MFMA32(kf[2 * d0 + 1], qr[d0], C1); }
    if (qrel >= 0) {
#pragma unroll
        for (int r = 0; r < 16; ++r) { const int kv = crow(r, hi); if (kv >= qrel) C0[r] = -INFINITY; if (kv + 32 >= qrel) C1[r] = -INFINITY; }
    }
    sb_sub(C1, carry, hi); sb_sub(C0, carry, hi);
    u32x4 pw[4];
#pragma unroll
    for (int i = 0; i < 4; ++i) { pw[0][i] = cvtpk(C0[2 * i], C0[2 * i + 1]); pw[1][i] = cvtpk(C0[8 + 2 * i], C0[8 + 2 * i + 1]); pw[2][i] = cvtpk(C1[2 * i], C1[2 * i + 1]); pw[3][i] = cvtpk(C1[8 + 2 * i], C1[8 + 2 * i + 1]); }
    const lds_cptr vp0 = ldsV + ((lane >> 4) & 1) * 32 + (lane & 3) * 8 + (4 * hi + ((lane & 15) >> 2)) * 64;
#pragma unroll
    for (int i = 0; i < 8; ++i) {
        const s16x4 lo = vtr(vp0 + ((i >> 2) * 4096 + (i & 3) * 1024)), hi4 = vtr(vp0 + ((i >> 2) * 4096 + (i & 3) * 1024 + 512));
        const bf16x8 vf = {lo[0], lo[1], lo[2], lo[3], hi4[0], hi4[1], hi4[2], hi4[3]};
        o[i >> 2] = MFMA32(__builtin_bit_cast(bf16x8, pw[i & 3]), vf, o[i >> 2]);
    }
}

constexpr int CP = 144;
constexpr int CMAT = 64 * CP;
constexpr int C_AH = 0, C_BH = CMAT, C_KH = 2 * CMAT, C_RH = 3 * CMAT, C_BBT = 4 * CMAT, C_KBT = 5 * CMAT, C_VT = 6 * CMAT,
              C_AAK = 7 * CMAT, C_ARB = 8 * CMAT, C_ARK = 9 * CMAT, C_N = 10 * CMAT;
constexpr int NPITCH = 68;
constexpr int C_RHS = C_N + 64 * NPITCH * 4;
constexpr int RPITCH = 132;
constexpr int C_GT = C_ARK;
constexpr int C_GC = C_RHS + 64 * RPITCH * 4;
constexpr int C_END = C_GC + 256;
constexpr int C_TW = C_END, C_TA = C_TW + CMAT, C_FEND = C_TA + CMAT;
constexpr int C_LWH = C_N, C_LAH = C_AAK;
constexpr int LWP = 68;
constexpr int C_W1T = C_AH, C_U0T = C_BH;
constexpr int C_MINV = C_KH, MINVP = 20;

__device__ __forceinline__ void mm_tile(f32x16& acc, const unsigned char* Lp, const unsigned char* Rp, int lane) {
    const int off = (lane & 31) * CP + (lane >> 5) * 16;
#pragma unroll
    for (int ks = 0; ks < 4; ++ks) {
        const bf16x8 af = *(const bf16x8*)(Lp + off + ks * 32), bf = *(const bf16x8*)(Rp + off + ks * 32);
        acc = MFMA32(af, bf, acc);
    }
}
__device__ __forceinline__ u32x2 pack4(float a, float b, float c, float d) { u32x2 o; o.x = cvtpk(a, b); o.y = cvtpk(c, d); return o; }
__device__ __forceinline__ float sum4rows(float x) {
    auto r1 = __builtin_amdgcn_permlane16_swap(__float_as_uint(x), __float_as_uint(x), false, false);
    const float y = __uint_as_float(r1[0]) + __uint_as_float(r1[1]);
    auto r2 = __builtin_amdgcn_permlane32_swap(__float_as_uint(y), __float_as_uint(y), false, false);
    return __uint_as_float(r2[0]) + __uint_as_float(r2[1]);
}

__device__ __forceinline__ void scanc_s1_core(const Params& p, int cid, unsigned char* smem, int lane, int w, const float (&rr)[8], const float (&ww)[8], const float (&kk)[8], const float (&vv)[8], const float (&aa)[8], const float (&bb)[8]) {
    const int r32 = lane & 31, hi = lane >> 5;
    float* gt = (float*)(smem + C_GT); float* gC = (float*)(smem + C_GC); float* RHS = (float*)(smem + C_RHS); float* Np = (float*)(smem + C_N);
    {
        float g[8]; g[0] = ww[0];
#pragma unroll
        for (int j = 1; j < 8; ++j) g[j] = g[j - 1] * ww[j];
        gt[w * 64 + lane] = g[7];
        lds_sync();
        float pre = 1.0f, tot = 1.0f;
#pragma unroll
        for (int ww2 = 0; ww2 < 8; ++ww2) { const float x = gt[ww2 * 64 + lane]; tot *= x; if (ww2 < w) pre *= x; }
        if (w == 0) gC[lane] = tot;
        u32x4 bbt, kbt, vtt;
        float bbs[8], kbs[8];
#pragma unroll
        for (int j = 0; j < 8; ++j) {
            const int t = 8 * w + j;
            const float gam = pre * g[j], gprev = j == 0 ? pre : pre * g[j - 1], inv = frcp(gam);
            const float ah = aa[j] * gprev, rh = rr[j] * gam, bhv = bb[j] * inv, khv = kk[j] * inv;
            *(u16*)(smem + C_AH + t * CP + lane * 2) = f2bf(ah); *(u16*)(smem + C_RH + t * CP + lane * 2) = f2bf(rh);
            *(u16*)(smem + C_BH + t * CP + lane * 2) = f2bf(bhv); *(u16*)(smem + C_KH + t * CP + lane * 2) = f2bf(khv);
            RHS[t * RPITCH + lane] = ah;
            bbs[j] = bhv * tot; kbs[j] = khv * tot;
        }
        bbt.x = cvtpk(bbs[0], bbs[1]); bbt.y = cvtpk(bbs[2], bbs[3]); bbt.z = cvtpk(bbs[4], bbs[5]); bbt.w = cvtpk(bbs[6], bbs[7]);
        kbt.x = cvtpk(kbs[0], kbs[1]); kbt.y = cvtpk(kbs[2], kbs[3]); kbt.z = cvtpk(kbs[4], kbs[5]); kbt.w = cvtpk(kbs[6], kbs[7]);
        vtt.x = cvtpk(vv[0], vv[1]); vtt.y = cvtpk(vv[2], vv[3]); vtt.z = cvtpk(vv[4], vv[5]); vtt.w = cvtpk(vv[6], vv[7]);
        *(u32x4*)(smem + C_BBT + lane * CP + w * 16) = bbt; *(u32x4*)(smem + C_KBT + lane * CP + w * 16) = kbt; *(u32x4*)(smem + C_VT + lane * CP + w * 16) = vtt;
    }
    lds_sync();
    {
        const int Lt = w & 1, Rt = (w >> 1) & 1, tb = w >> 2;
        const unsigned char* Lbase = smem + (Lt ? C_KH : C_BH); const unsigned char* Rbase = smem + (Rt ? C_RH : C_AH);
        const int t = tb * 32 + r32;
#pragma unroll
        for (int ia = 0; ia < 2; ++ia) {
            f32x16 acc;
#pragma unroll
            for (int r = 0; r < 16; ++r) acc[r] = 0.f;
            if (!(ia == 1 && tb == 0)) mm_tile(acc, Lbase + ia * 32 * CP, Rbase + tb * 32 * CP, lane);
#pragma unroll
            for (int r = 0; r < 16; ++r) { const int i = ia * 32 + crow(r, hi); const bool keep = Rt ? (i <= t) : (i < t); if (!keep) acc[r] = 0.f; }
            if (Lt == 0 && Rt == 0) {
#pragma unroll
                for (int r = 0; r < 16; ++r) { const int i = ia * 32 + crow(r, hi); Np[t * NPITCH + (i & 3) * 16 + (i >> 2)] = acc[r]; }
            } else {
                unsigned char* dst = smem + (Rt == 0 ? C_AAK : (Lt == 0 ? C_ARB : C_ARK)) + t * CP;
#pragma unroll
                for (int g4 = 0; g4 < 4; ++g4) *(u32x2*)(dst + (ia * 32 + 8 * g4 + 4 * hi) * 2) = pack4(acc[4 * g4], acc[4 * g4 + 1], acc[4 * g4 + 2], acc[4 * g4 + 3]);
            }
        }
    }
    lds_sync();
    f32x16 accY, accQ;
#pragma unroll
    for (int r = 0; r < 16; ++r) { accY[r] = 0.f; accQ[r] = 0.f; }
    const int w4 = w & 3, ab = w4 & 1, vb = w4 >> 1;
    if (w < 4) {
        f32x16 acc;
#pragma unroll
        for (int r = 0; r < 16; ++r) acc[r] = 0.f;
        mm_tile(acc, smem + C_AAK + ab * 32 * CP, smem + C_VT + vb * 32 * CP, lane);
#pragma unroll
        for (int r = 0; r < 16; ++r) RHS[(ab * 32 + crow(r, hi)) * RPITCH + 64 + vb * 32 + r32] = acc[r];
        {
            const int j = lane & 15; float mcol[16];
            const float* Nb = Np + (16 * w) * NPITCH + 4 * w;
#pragma unroll
            for (int t = 0; t < 16; ++t) {
                float s = (t == j) ? 1.0f : 0.0f;
#pragma unroll
                for (int q = 0; q < 4; ++q) if (q < t) { const f32x4 nv = *(const f32x4*)(Nb + t * NPITCH + q * 16);
#pragma unroll
                    for (int jj = 0; jj < 4; ++jj) if (4 * jj + q < t) s = __builtin_fmaf(nv[jj], mcol[4 * jj + q], s); }
                mcol[t] = s;
            }
            float* Mi = (float*)(smem + C_MINV) + w * 16 * MINVP;
            if (lane < 16) {
#pragma unroll
                for (int t = 0; t < 16; ++t) Mi[t * MINVP + j] = mcol[t]; }
        }
    } else {
        mm_tile(accY, smem + C_ARK + ab * 32 * CP, smem + C_VT + vb * 32 * CP, lane);
        mm_tile(accQ, smem + C_KBT + ab * 32 * CP, smem + C_VT + vb * 32 * CP, lane);
    }
    lds_sync();
    {
        const int c = lane & 15, g = lane >> 4;
        const float* Mi = (const float*)(smem + C_MINV);
        f32x4 X[4];
#pragma unroll
        for (int b = 0; b < 4; ++b) {
            f32x4 acc;
#pragma unroll
            for (int r = 0; r < 4; ++r) acc[r] = RHS[(16 * b + 4 * g + r) * RPITCH + 16 * w + c];
#pragma unroll
            for (int a = 0; a < 4; ++a) if (a < b) {
#pragma unroll
                for (int r = 0; r < 4; ++r) { const float nv = Np[(16 * b + c) * NPITCH + r * 16 + 4 * a + g];
                    acc = __builtin_amdgcn_mfma_f32_16x16x4f32(nv, X[a][r], acc, 0, 0, 0); } }
            const f32x4 mv = *(const f32x4*)(Mi + (b * 16 + c) * MINVP + 4 * g);
            f32x4 xb = {0.f, 0.f, 0.f, 0.f};
#pragma unroll
            for (int r = 0; r < 4; ++r) xb = __builtin_amdgcn_mfma_f32_16x16x4f32(mv[r], acc[r], xb, 0, 0, 0);
            X[b] = xb;
        }
        unsigned char* dst = smem + (w < 4 ? C_W1T : C_U0T) + ((w & 3) * 16 + c) * CP;
#pragma unroll
        for (int b = 0; b < 4; ++b) *(u32x2*)(dst + (16 * b + 4 * g) * 2) = pack4(X[b][0], X[b][1], X[b][2], X[b][3]);
    }
    lds_sync();
    if (w < 4) {
        const int xk = w & 1, yk = w >> 1;
        {
            f32x16 acc;
#pragma unroll
            for (int r = 0; r < 16; ++r) acc[r] = 0.f;
            mm_tile(acc, smem + C_W1T + xk * 32 * CP, smem + C_BBT + yk * 32 * CP, lane);
            const int k = yk * 32 + r32; const float gck = gC[k];
            u16* Pm = (u16*)(p.ws + WS_PM) + (size_t)cid * 4096 + k * 64;
#pragma unroll
            for (int g4 = 0; g4 < 4; ++g4) { const int kp = xk * 32 + 8 * g4 + 4 * hi; float v4[4];
#pragma unroll
                for (int e = 0; e < 4; ++e) v4[e] = acc[4 * g4 + e] + ((kp + e) == k ? gck : 0.f);
                *(u32x2*)(Pm + kp) = pack4(v4[0], v4[1], v4[2], v4[3]); }
        }
        {
            f32x16 acc;
#pragma unroll
            for (int r = 0; r < 16; ++r) acc[r] = 0.f;
            mm_tile(acc, smem + C_W1T + xk * 32 * CP, smem + C_ARB + yk * 32 * CP, lane);
            const int t = yk * 32 + r32;
            u16* Wh = (u16*)(p.ws + WS_WH) + (size_t)cid * 4096 + t * 64;
#pragma unroll
            for (int g4 = 0; g4 < 4; ++g4) { const int k0 = xk * 32 + 8 * g4 + 4 * hi; const u32x2 rh = *(const u32x2*)(smem + C_RH + t * CP + k0 * 2);
                const float r0 = __uint_as_float(rh.x << 16), r1 = __uint_as_float(rh.x & 0xffff0000u), r2 = __uint_as_float(rh.y << 16), r3 = __uint_as_float(rh.y & 0xffff0000u);
                *(u32x2*)(Wh + k0) = pack4(acc[4 * g4] + r0, acc[4 * g4 + 1] + r1, acc[4 * g4 + 2] + r2, acc[4 * g4 + 3] + r3); }
        }
    } else {
        mm_tile(accQ, smem + C_BBT + ab * 32 * CP, smem + C_U0T + vb * 32 * CP, lane);
        mm_tile(accY, smem + C_ARB + ab * 32 * CP, smem + C_U0T + vb * 32 * CP, lane);
        const int v = vb * 32 + r32;
        float* Qm = (float*)(p.ws + WS_QM) + (size_t)cid * 4096 + v * 64; u16* Y0 = (u16*)(p.ws + WS_Y0) + (size_t)cid * 4096 + v * 64;
#pragma unroll
        for (int g4 = 0; g4 < 4; ++g4) { const int a0 = ab * 32 + 8 * g4 + 4 * hi;
            const f32x4 qv = {accQ[4 * g4], accQ[4 * g4 + 1], accQ[4 * g4 + 2], accQ[4 * g4 + 3]}, yv = {accY[4 * g4], accY[4 * g4 + 1], accY[4 * g4 + 2], accY[4 * g4 + 3]};
            *(f32x4*)(Qm + a0) = qv; *(u32x2*)(Y0 + a0) = pack4(yv[0], yv[1], yv[2], yv[3]); }
    }
    lds_sync();
}

__device__ __forceinline__ float wsum64(float x) { return sum4rows(allred16(x)); }
__device__ __forceinline__ void scanc_fused(const Params& p, int item, unsigned char* smem) {
    const int tid = otid(), lane = tid & 63, r32 = lane & 31, hi = lane >> 5; const int w = __builtin_amdgcn_readfirstlane(tid >> 6);
    const int b = item >> 7, c = (item >> 1) & 63, hq = item & 1;
    const size_t row0 = (size_t)b * SEQ + (size_t)c * 64;
    const float* P = (const float*)(p.ws + WS_P);
    unsigned* GP = (unsigned*)(p.ws + WS_SG);
    const int which = w >> 2, tt = w & 1, kt = (w >> 1) & 1;
    const bool zfirst = (c == 0 && w == 0);
    bf16x8 wf[4]; float xr[9], xk[9], xv[9], xg[9], prm[11];
#define FUSED_FETCH(h_) { const int col_ = (h_) * 64 + lane; \
        const u16* WT_ = (const u16*)(p.ws + (which ? WS_AUPT : WS_WUPT)) + (size_t)((h_) * 64 + kt * 32 + r32) * 64; \
        _Pragma("unroll") for (int ks = 0; ks < 4; ++ks) wf[ks] = *(const bf16x8*)(WT_ + ks * 16 + hi * 8); \
        _Pragma("unroll") for (int j = 0; j < 9; ++j) { const bool z = zfirst && j == 0; const float* prow = P + (row0 + 8 * w + j - 1 + (z ? 1 : 0)) * NINP + 2048 + col_; \
            xr[j] = prow[0]; xk[j] = prow[512]; xv[j] = prow[1024]; xg[j] = prow[1536]; } \
        prm[0] = p.mu[col_]; prm[1] = p.mu[512 + col_]; prm[2] = p.mu[1024 + col_]; prm[3] = p.mu[1536 + col_]; prm[4] = p.w0[col_]; prm[5] = p.a0[col_]; prm[6] = p.k_k[col_]; \
        prm[7] = p.k_a[col_]; prm[8] = p.ln_w[col_]; prm[9] = p.ln_b[col_]; prm[10] = p.r_k[col_]; }
    FUSED_FETCH(hq * 4)
    {
        const int j = tid & 127, tb = (tid >> 7) * 16;
        const float mul = p.mu[2048 + j];
        float raw[16], prev;
#pragma unroll
        for (int k = 0; k < 16; ++k) raw[k] = P[(row0 + tb + k) * NINP + 4096 + j];
        prev = (c == 0 && tb == 0) ? 0.f : P[(row0 + tb - 1) * NINP + 4096 + j];
#pragma unroll
        for (int k = 0; k < 16; ++k) { const float zl = raw[k] + (prev - raw[k]) * mul; prev = raw[k];
            float val = zl; if (j < 64) { const float e2 = __expf(2.0f * zl); val = 1.0f - 2.0f / (e2 + 1.0f); }
            *(u16*)(smem + (j < 64 ? C_TW : C_TA) + (tb + k) * CP + (j & 63) * 2) = f2bf(val); }
        if (c == 63 && hq == 0 && tb == 48) p.out[OUT_SHP + (size_t)b * RWC + 2048 + j] = raw[15];
    }
    lds_sync();
    for (int hh = 0; hh < 4; ++hh) {
        const int h = hq * 4 + hh, col = h * 64 + lane;
        {
            const unsigned char* Tp = smem + (which ? C_TA : C_TW) + (tt * 32 + r32) * CP;
            f32x16 acc;
#pragma unroll
            for (int r = 0; r < 16; ++r) acc[r] = 0.f;
#pragma unroll
            for (int ks = 0; ks < 4; ++ks) { const bf16x8 bf = *(const bf16x8*)(Tp + ks * 32 + hi * 16); acc = MFMA32(wf[ks], bf, acc); }
            float* L = (float*)(smem + (which ? C_LAH : C_LWH)) + (tt * 32 + r32) * LWP + kt * 32;
#pragma unroll
            for (int g4 = 0; g4 < 4; ++g4) { const f32x4 v4 = {acc[4 * g4], acc[4 * g4 + 1], acc[4 * g4 + 2], acc[4 * g4 + 3]}; *(f32x4*)(L + 8 * g4 + 4 * hi) = v4; }
        }
        lds_sync();
        float rr[8], ww[8], kk[8], vv[8], aa[8], bb[8];
        if (zfirst) { xr[0] = 0.f; xk[0] = 0.f; xv[0] = 0.f; xg[0] = 0.f; }
        {
            const float mu_r = prm[0], mu_k = prm[1], mu_v = prm[2], mu_g = prm[3], w0c = prm[4], a0c = prm[5], kkc = prm[6], kac = prm[7], lnwc = prm[8], lnbc = prm[9], rkc = prm[10];
            const float* LW = (const float*)(smem + C_LWH); const float* LA = (const float*)(smem + C_LAH);
#pragma unroll
            for (int j = 0; j < 8; ++j) {
                const int t = 8 * w + j; const size_t R = row0 + t;
                const float zr = xr[j + 1] + (xr[j] - xr[j + 1]) * mu_r, zk = xk[j + 1] + (xk[j] - xk[j + 1]) * mu_k, zv = xv[j + 1] + (xv[j] - xv[j + 1]) * mu_v, zg = xg[j + 1] + (xg[j] - xg[j + 1]) * mu_g;
                const float lw = LW[t * LWP + lane], la = LA[t * LWP + lane];
                const float decay = __expf(-0.60653066f * frcp(1.0f + __expf(-(w0c + lw))));
                const float alr = frcp(1.0f + __expf(-(a0c + la)));
                float kn = zk * kkc; const float ss = wsum64(kn * kn); kn = kn * __builtin_amdgcn_rsqf(fmaxf(ss, 1e-24f));
                const float keff = zk * (1.0f + (alr - 1.0f) * kac);
                const float bsum = wsum64(zr * keff * rkc); const float sg = silu_f(zg);
                GP[((size_t)(b * 8 + h) * SEQ + (size_t)c * 64 + t) * 64 + lane] = cvtpk(lnwc * sg, (lnbc + bsum * zv) * sg);
                rr[j] = zr; ww[j] = decay; kk[j] = keff; vv[j] = zv; aa[j] = -kn; bb[j] = kn * alr;
            }
            if (c == 63 && w == 7) { float* sh = p.out + OUT_SHP + (size_t)b * RWC; sh[col] = xr[8]; sh[512 + col] = xk[8]; sh[1024 + col] = xv[8]; sh[1536 + col] = xg[8]; }
        }
        if (hh + 1 < 4) FUSED_FETCH(h + 1)
        scanc_s1_core(p, ((b * 8 + h) << 6) + c, smem, lane, w, rr, ww, kk, vv, aa, bb);
    }
#undef FUSED_FETCH
}

__device__ __forceinline__ void scanc_stage2(const Params& p, int bh, unsigned char* smem) {
    const int tid = otid(), lane = tid & 63, r32 = lane & 31, hi = lane >> 5; const int w = __builtin_amdgcn_readfirstlane(tid >> 6);
    const int xk = w & 1, yv = (w >> 1) & 1;
    const int v = yv * 32 + r32;
    unsigned char* Sb = smem;
    lds_sync();
    if (w < 4) {
#pragma unroll
        for (int g4 = 0; g4 < 4; ++g4) { u32x2 z = {0u, 0u}; *(u32x2*)(Sb + v * CP + (xk * 32 + 8 * g4 + 4 * hi) * 2) = z; }
    }
    const u16* PmB = (const u16*)(p.ws + WS_PM) + (size_t)bh * 64 * 4096; const float* QmB = (const float*)(p.ws + WS_QM) + (size_t)bh * 64 * 4096;
    u16* SC = (u16*)(p.ws + WS_SC) + (size_t)bh * 64 * 4096;
    bf16x8 pfA[4], pfB[4], pfC[4], pfD[4]; f32x4 qfA[4], qfB[4], qfC[4], qfD[4];
    auto s2_fetch = [&](int c, bf16x8 (&pfx)[4], f32x4 (&qfx)[4]) {
#pragma unroll
        for (int ks = 0; ks < 4; ++ks) pfx[ks] = *(const bf16x8*)(PmB + (size_t)c * 4096 + (xk * 32 + r32) * 64 + ks * 16 + hi * 8);
#pragma unroll
        for (int g4 = 0; g4 < 4; ++g4) qfx[g4] = *(const f32x4*)(QmB + (size_t)c * 4096 + v * 64 + xk * 32 + 8 * g4 + 4 * hi); };
    if (w < 4) { s2_fetch(0, pfA, qfA); s2_fetch(1, pfB, qfB); s2_fetch(2, pfC, qfC); s2_fetch(3, pfD, qfD); }
    f32x16 acc;
#pragma unroll
    for (int r = 0; r < 16; ++r) acc[r] = 0.f;
    lds_sync();
    auto s2_step = [&](int c, bf16x8 (&pfx)[4], f32x4 (&qfx)[4]) {
#pragma unroll
        for (int g4 = 0; g4 < 4; ++g4) { const int k0 = xk * 32 + 8 * g4 + 4 * hi; *(u32x2*)(SC + (size_t)c * 4096 + v * 64 + k0) = *(const u32x2*)(Sb + v * CP + k0 * 2); }
#pragma unroll
        for (int g4 = 0; g4 < 4; ++g4) { acc[4 * g4] = qfx[g4][0]; acc[4 * g4 + 1] = qfx[g4][1]; acc[4 * g4 + 2] = qfx[g4][2]; acc[4 * g4 + 3] = qfx[g4][3]; }
#pragma unroll
        for (int ks = 0; ks < 4; ++ks) { const bf16x8 sf = *(const bf16x8*)(Sb + v * CP + ks * 32 + hi * 16); acc = MFMA32(pfx[ks], sf, acc); }
        s2_fetch(c + 4 < 64 ? c + 4 : 63, pfx, qfx);
        lds_sync();
#pragma unroll
        for (int g4 = 0; g4 < 4; ++g4) *(u32x2*)(Sb + v * CP + (xk * 32 + 8 * g4 + 4 * hi) * 2) = pack4(acc[4 * g4], acc[4 * g4 + 1], acc[4 * g4 + 2], acc[4 * g4 + 3]);
        lds_sync(); };
    if (w < 4) { for (int c = 0; c < 64; c += 4) { s2_step(c, pfA, qfA); s2_step(c + 1, pfB, qfB); s2_step(c + 2, pfC, qfC); s2_step(c + 3, pfD, qfD); } }
    else { for (int i = 0; i < 128; ++i) lds_sync(); }
    if (w < 4) {
        float* so = p.out + OUT_WKVP + (size_t)bh * 4096 + v * 64;
#pragma unroll
        for (int g4 = 0; g4 < 4; ++g4) { const f32x4 o4 = {acc[4 * g4], acc[4 * g4 + 1], acc[4 * g4 + 2], acc[4 * g4 + 3]}; *(f32x4*)(so + xk * 32 + 8 * g4 + 4 * hi) = o4; }
    }
}

struct S3Ops { u32x2 y0[4]; bf16x8 af[4], bf[4]; };
__device__ __forceinline__ void s3_load(S3Ops& o, const Params& p, int item, int gq, int tb, int vb, int r32, int hi) {
    const int cid = item * 2 + gq, v = vb * 32 + r32;
    const u16* Y0 = (const u16*)(p.ws + WS_Y0) + (size_t)cid * 4096 + v * 64;
    const u16* Wh = (const u16*)(p.ws + WS_WH) + (size_t)cid * 4096 + (tb * 32 + r32) * 64;
    const u16* SC = (const u16*)(p.ws + WS_SC) + (size_t)cid * 4096 + v * 64;
#pragma unroll
    for (int g4 = 0; g4 < 4; ++g4) o.y0[g4] = *(const u32x2*)(Y0 + tb * 32 + 8 * g4 + 4 * hi);
#pragma unroll
    for (int ks = 0; ks < 4; ++ks) { o.af[ks] = *(const bf16x8*)(Wh + ks * 16 + hi * 8); o.bf[ks] = *(const bf16x8*)(SC + ks * 16 + hi * 8); }
}
__device__ __forceinline__ void phase_stage3(const Params& p, int bid, int nb, unsigned char* smem, int nitems) {
    const int tid = otid(), lane = tid & 63, r32 = lane & 31, hi = lane >> 5; const int w = __builtin_amdgcn_readfirstlane(tid >> 6);
    const int gq = w >> 2, w4 = w & 3, tb = w4 & 1, vb = w4 >> 1;
    float* Yb = (float*)smem;
    const unsigned* GP = (const unsigned*)(p.ws + WS_SG);
    u16* O = (u16*)(p.ws + WS_O);
    S3Ops cur;
    if (bid < nitems) s3_load(cur, p, bid, gq, tb, vb, r32, hi);
    for (int item = bid; item < nitems; item += nb) {
        unsigned gp[16];
#pragma unroll
        for (int i = 0; i < 16; ++i) { const int tt = w + 8 * i; const int g = tt >> 6, t = tt & 63, cc = item * 2 + g, bh = cc >> 6, c = cc & 63;
            gp[i] = GP[((size_t)bh * SEQ + (size_t)c * 64 + t) * 64 + lane]; }
        f32x16 acc;
#pragma unroll
        for (int g4 = 0; g4 < 4; ++g4) { acc[4 * g4] = __uint_as_float(cur.y0[g4].x << 16); acc[4 * g4 + 1] = __uint_as_float(cur.y0[g4].x & 0xffff0000u); acc[4 * g4 + 2] = __uint_as_float(cur.y0[g4].y << 16); acc[4 * g4 + 3] = __uint_as_float(cur.y0[g4].y & 0xffff0000u); }
#pragma unroll
        for (int ks = 0; ks < 4; ++ks) acc = MFMA32(cur.af[ks], cur.bf[ks], acc);
        if (item + nb < nitems) s3_load(cur, p, item + nb, gq, tb, vb, r32, hi);
        lds_sync();
        { const int v = vb * 32 + r32;
#pragma unroll
          for (int r = 0; r < 16; ++r) Yb[gq * 4096 + (tb * 32 + crow(r, hi)) * 64 + v] = acc[r]; }
        lds_sync();
#pragma unroll
        for (int i = 0; i < 16; ++i) { const int tt = w + 8 * i; const int g = tt >> 6, t = tt & 63, cc = item * 2 + g, bh = cc >> 6, c = cc & 63, b = bh >> 3, h = bh & 7;
            const size_t R = (size_t)b * SEQ + (size_t)c * 64 + t;
            const float yy = Yb[g * 4096 + t * 64 + lane];
            const float mean = wave_sum(yy) * (1.0f / 64.0f); const float dd = yy - mean;
            const float var = wave_sum(dd * dd) * (1.0f / 64.0f);
            O[R * DM + 512 + h * 64 + lane] = f2bf(dd * rsqrtf(var + 64e-5f) * __uint_as_float(gp[i] << 16) + __uint_as_float(gp[i] & 0xffff0000u)); }
    }
}

constexpr int SG_PITCH = 68;
__device__ __forceinline__ void phase_gemm2_sample(const Params& p, int bid, int nb, unsigned char* smem) {
    const int tid = otid(), lane = tid & 63, r32 = lane & 31, hi = lane >> 5; const int w = __builtin_amdgcn_readfirstlane(tid >> 6);
    const u16* Ob = (const u16*)(p.ws + WS_O); const u16* Wt = (const u16*)(p.ws + WS_WOUTT);
    float* Part = (float*)smem;
    for (int tile = bid; tile < 256; tile += nb) {
        const int tr = tile >> 4, tc = tile & 15, R0 = NPROW + tr * 64, n0 = tc * 64, k0 = w * 128;
        const int orow = tid >> 3, oc8 = (tid & 7) * 8;
        const float* xr = p.x_sample + (size_t)(tr * 64 + orow) * DM + n0 + oc8;
        const f32x4 x0 = *(const f32x4*)(xr), x1 = *(const f32x4*)(xr + 4);
        const u16* Ap = Ob + (size_t)(R0 + r32) * DM + k0 + hi * 8; const u16* Bp = Wt + (size_t)(n0 + r32) * DM + k0 + hi * 8;
        f32x16 acc[2][2];
#pragma unroll
        for (int ia = 0; ia < 2; ++ia)
#pragma unroll
            for (int ib = 0; ib < 2; ++ib)
#pragma unroll
                for (int r = 0; r < 16; ++r) acc[ia][ib][r] = 0.f;
#pragma unroll
        for (int ks = 0; ks < 8; ++ks) {
            const bf16x8 a0 = *(const bf16x8*)(Ap + ks * 16), a1 = *(const bf16x8*)(Ap + (size_t)32 * DM + ks * 16);
            const bf16x8 b0 = *(const bf16x8*)(Bp + ks * 16), b1 = *(const bf16x8*)(Bp + (size_t)32 * DM + ks * 16);
            acc[0][0] = MFMA32(a0, b0, acc[0][0]); acc[0][1] = MFMA32(a0, b1, acc[0][1]); acc[1][0] = MFMA32(a1, b0, acc[1][0]); acc[1][1] = MFMA32(a1, b1, acc[1][1]);
        }
        __syncthreads();
#pragma unroll
        for (int ia = 0; ia < 2; ++ia)
#pragma unroll
            for (int ib = 0; ib < 2; ++ib)
#pragma unroll
                for (int r = 0; r < 16; ++r) Part[(w * 64 + ia * 32 + crow(r, hi)) * SG_PITCH + ib * 32 + r32] = acc[ia][ib][r];
        __syncthreads();
        f32x4 s0 = x0, s1 = x1;
#pragma unroll
        for (int ww = 0; ww < 8; ++ww) { const float* pp = Part + (ww * 64 + orow) * SG_PITCH + oc8; s0 += *(const f32x4*)(pp); s1 += *(const f32x4*)(pp + 4); }
        float* dst = p.out + OUT_Y + (size_t)(R0 + orow) * DM + n0 + oc8;
        *(f32x4*)(dst) = s0; *(f32x4*)(dst + 4) = s1;
    }
}
__device__ __forceinline__ void phase_norm_sample(const Params& p, int bid, int nb) {
    const int tid = otid(), lane = tid & 63, w = tid >> 6;
    if (w < 4) {
        for (int r = bid * 4 + w; r < NROWS - NPROW; r += nb * 4) {
            float* src = p.out + OUT_Y + (size_t)(NPROW + r) * DM;
            f32x4 v[4], g[4]; float ss = 0.f;
#pragma unroll
            for (int i = 0; i < 4; ++i) { v[i] = *(const f32x4*)(src + lane * 4 + i * 256); g[i] = *(const f32x4*)(p.norm_f + lane * 4 + i * 256); }
#pragma unroll
            for (int i = 0; i < 4; ++i) ss += v[i][0] * v[i][0] + v[i][1] * v[i][1] + v[i][2] * v[i][2] + v[i][3] * v[i][3];
            ss = wave_sum(ss);
            const float rs = rsqrtf(ss * (1.0f / 1024.0f) + 1e-6f);
#pragma unroll
            for (int i = 0; i < 4; ++i) *(f32x4*)(src + lane * 4 + i * 256) = v[i] * rs * g[i];
        }
    }
}

#define AP_SBAR() __builtin_amdgcn_sched_barrier(0)
#define AP_PIN(x) asm volatile("" : "+v"(x))
#define AP_KLD(d0) (*(const __attribute__((address_space(3))) bf16x8*)(kp + (d0) * 2048))
__device__ __forceinline__ bf16x8 ap_vld(lds_cptr vp, int dh, int k) {
    const s16x4 lo = vtr(vp + (dh * 4096 + k * 1024)), hi4 = vtr(vp + (dh * 4096 + k * 1024 + 512));
    const bf16x8 vf = {lo[0], lo[1], lo[2], lo[3], hi4[0], hi4[1], hi4[2], hi4[3]}; return vf;
}
__device__ __forceinline__ void ap_qk_half(lds_cptr kp, const bf16x8 (&qr)[4], float bias2, f32x16& S) {
#pragma unroll
    for (int r = 0; r < 16; ++r) S[r] = bias2;
#pragma unroll
    for (int d0 = 0; d0 < 4; ++d0) { const bf16x8 kf = AP_KLD(d0); S = MFMA32(kf, qr[d0], S); }
}
__device__ __forceinline__ void ap_soft_half(f32x16& S, int qm, int hi, float& carry, u32x4 (&pw)[2]) {
    if (qm < 64) {
#pragma unroll
        for (int r = 0; r < 16; ++r) if (crow(r, hi) >= qm) S[r] = -INFINITY;
    }
    sb_sub(S, carry, hi);
#pragma unroll
    for (int i = 0; i < 4; ++i) { pw[0][i] = cvtpk(S[2 * i], S[2 * i + 1]); pw[1][i] = cvtpk(S[8 + 2 * i], S[8 + 2 * i + 1]); }
}
__device__ __forceinline__ void ap_pv_half(lds_cptr vp, const u32x4 (&pw)[2], f32x16 (&o)[2]) {
#pragma unroll
    for (int dh = 0; dh < 2; ++dh)
#pragma unroll
        for (int k = 0; k < 2; ++k) { const bf16x8 vf = ap_vld(vp, dh, k); o[dh] = MFMA32(__builtin_bit_cast(bf16x8, pw[k]), vf, o[dh]); }
}
__device__ __forceinline__ void ap_hot_half(lds_cptr kp, lds_cptr vp, const bf16x8 (&qr)[4], float bias2, int hi, float& carry, f32x16& S, u32x4 (&pw)[2], f32x16 (&o)[2]) {
    float t[16], g[4], D[5];
    bf16x8 kfA, kfB, vfA, vfB;
#define AP_E(m) { _Pragma("unroll") for (int i_ = 0; i_ < 4; ++i_) { t[4 * (m) + i_] = __builtin_amdgcn_exp2f(__builtin_amdgcn_fmed3f(S[4 * (m) + i_], -3.0e38f, 30.0f)); AP_PIN(t[4 * (m) + i_]); } }
#define AP_F(m) { const float F1_ = 1.0f + t[4 * (m)], F2_ = __builtin_fmaf(t[4 * (m) + 1], F1_, F1_), F3_ = __builtin_fmaf(t[4 * (m) + 2], F2_, F2_), F4_ = __builtin_fmaf(t[4 * (m) + 3], F3_, F3_); \
        g[m] = __builtin_amdgcn_rcpf(F4_); t[4 * (m) + 1] = F2_ - F1_; t[4 * (m) + 2] = F3_ - F2_; t[4 * (m) + 3] = F4_ - F3_; AP_PIN(g[m]); AP_PIN(t[4 * (m) + 1]); AP_PIN(t[4 * (m) + 2]); AP_PIN(t[4 * (m) + 3]); }
#define AP_P() { float cm_[4]; _Pragma("unroll") for (int m_ = 0; m_ < 4; ++m_) { auto rr_ = __builtin_amdgcn_permlane32_swap(__float_as_uint(g[m_]), __float_as_uint(g[m_]), false, false); \
            cm_[m_] = __uint_as_float(rr_[0]) * __uint_as_float(rr_[1]); } \
        D[4] = carry; D[3] = cm_[3] * D[4]; D[2] = cm_[2] * D[3]; D[1] = cm_[1] * D[2]; D[0] = cm_[0] * D[1]; carry = D[0]; AP_PIN(D[0]); AP_PIN(D[1]); AP_PIN(D[2]); AP_PIN(D[3]); }
#define AP_W(m) { const float gH_ = g[m] * D[(m) + 1]; const float gL_ = hi ? gH_ : D[m]; _Pragma("unroll") for (int i_ = 0; i_ < 4; ++i_) { t[4 * (m) + i_] *= gL_; AP_PIN(t[4 * (m) + i_]); } }
    vfA = ap_vld(vp, 0, 0); vfB = ap_vld(vp, 0, 1); AP_E(0)
    AP_SBAR();
    o[0] = MFMA32(__builtin_bit_cast(bf16x8, pw[0]), vfA, o[0]); vfA = ap_vld(vp, 1, 0); AP_E(1)
    AP_SBAR();
    o[0] = MFMA32(__builtin_bit_cast(bf16x8, pw[1]), vfB, o[0]); vfB = ap_vld(vp, 1, 1); AP_E(2)
    AP_SBAR();
    o[1] = MFMA32(__builtin_bit_cast(bf16x8, pw[0]), vfA, o[1]); kfA = AP_KLD(0); AP_E(3)
    AP_SBAR();
    o[1] = MFMA32(__builtin_bit_cast(bf16x8, pw[1]), vfB, o[1]); kfB = AP_KLD(1); AP_F(0) AP_F(1)
#pragma unroll
    for (int r = 0; r < 16; ++r) S[r] = bias2;
    AP_SBAR();
    S = MFMA32(kfA, qr[0], S); kfA = AP_KLD(2); AP_F(2) AP_F(3)
    AP_SBAR();
    S = MFMA32(kfB, qr[1], S); kfB = AP_KLD(3); AP_P()
    AP_SBAR();
    S = MFMA32(kfA, qr[2], S); AP_W(0) AP_W(1) AP_W(2) AP_W(3)
    AP_SBAR();
    S = MFMA32(kfB, qr[3], S);
#pragma unroll
    for (int i = 0; i < 4; ++i) { pw[0][i] = cvtpk(t[2 * i], t[2 * i + 1]); pw[1][i] = cvtpk(t[8 + 2 * i], t[8 + 2 * i + 1]); }
    AP_PIN(pw[0]); AP_PIN(pw[1]);
    AP_SBAR();
#undef AP_E
#undef AP_F
#undef AP_P
#undef AP_W
}
__device__ __forceinline__ void phase_attn_prompt(const Params& p, int bid, int nb, unsigned char* smem, int uhi) {
    const int tid = otid(), lane = tid & 63, r32 = lane & 31, hi = lane >> 5; const int w = __builtin_amdgcn_readfirstlane(tid >> 6);
    const u16* Qb = (const u16*)(p.ws + WS_QB); const u16* Kb = (const u16*)(p.ws + WS_KB); const u16* Vb = (const u16*)(p.ws + WS_VB);
    const float* P = (const float*)(p.ws + WS_P); u16* O = (u16*)(p.ws + WS_O);
    const int koff = hi * 1024 + r32 * 16, voff = 8192 + ((lane >> 4) & 1) * 32 + (lane & 3) * 8 + (4 * hi + ((lane & 15) >> 2)) * 64;
    if (w >= 4) __builtin_amdgcn_s_setprio(1);
    for (int u = bid; u < uhi; u += nb) {
        const int qb = 15 - (u >> 5), bh = u & 31, b = bh >> 3, h = bh & 7, q0 = qb * 256, NT = 4 * qb + 4;
        const float bias2 = p.sb_bias[h] * LOG2E;
        const u16* Qw = Qb + ((size_t)bh * SEQ + q0 + w * 32) * 64;
        bf16x8 qr[4];
#pragma unroll
        for (int d0 = 0; d0 < 4; ++d0) qr[d0] = *(const bf16x8*)(Qw + r32 * 64 + d0 * 16 + hi * 8);
        const u16* ksrc = Kb + (size_t)bh * SEQ * 64 + (size_t)lane * 64 + w * 8;
        const u16* vsrc = Vb + (size_t)bh * SEQ * 64 + (size_t)(16 * (w & 3) + (lane >> 2)) * 64 + (w >> 2) * 32 + (lane & 3) * 8;
        const int jw = 4 * qb + (w >> 1), qrel = 32 * (w & 1) + r32;
        float carry = 1.0f; f32x16 o[2];
#pragma unroll
        for (int r = 0; r < 16; ++r) { o[0][r] = 0.f; o[1][r] = 0.f; }
        u32x4 kreg = *(const u32x4*)(ksrc + (size_t)(NT - 1) * 64 * 64), vreg = *(const u32x4*)(vsrc + (size_t)(NT - 1) * 64 * 64);
        __syncthreads();
        { unsigned char* sl = smem + ((NT - 1) & 3) * 16384; *(u32x4*)(sl + w * 1024 + lane * 16) = kreg; *(u32x4*)(sl + 8192 + w * 1024 + lane * 16) = vreg; }
        kreg = *(const u32x4*)(ksrc + (size_t)(NT - 2) * 64 * 64); vreg = *(const u32x4*)(vsrc + (size_t)(NT - 2) * 64 * 64);
        __syncthreads();
        f32x16 S; u32x4 pw[2];
        if (jw == NT - 1) ap_qk_half((lds_cptr)(smem + ((NT - 1) & 3) * 16384 + koff + 512), qr, bias2, S);
        for (int j = NT - 1; j >= 0; --j) {
            if (j > 0) { unsigned char* sl = smem + ((j - 1) & 3) * 16384; *(u32x4*)(sl + w * 1024 + lane * 16) = kreg; *(u32x4*)(sl + 8192 + w * 1024 + lane * 16) = vreg; }
            __syncthreads();
            if (j > 1) { kreg = *(const u32x4*)(ksrc + (size_t)(j - 2) * 64 * 64); vreg = *(const u32x4*)(vsrc + (size_t)(j - 2) * 64 * 64); }
            const lds_cptr sC = (lds_cptr)(smem + (j & 3) * 16384), sN = (lds_cptr)(smem + ((j - 1) & 3) * 16384), sP = (lds_cptr)(smem + ((j + 1) & 3) * 16384);
            if (j < jw) {
                ap_hot_half(sC + koff, sP + voff, qr, bias2, hi, carry, S, pw, o);
                if (j >= 1) ap_hot_half(sN + koff + 512, sC + voff + 2048, qr, bias2, hi, carry, S, pw, o);
                else { ap_pv_half(sC + voff + 2048, pw, o); ap_soft_half(S, 64, hi, carry, pw); ap_pv_half(sC + voff, pw, o); }
            } else if (j == jw) {
                ap_soft_half(S, qrel - 32, hi, carry, pw); ap_qk_half(sC + koff, qr, bias2, S);
                ap_pv_half(sC + voff + 2048, pw, o); ap_soft_half(S, qrel, hi, carry, pw);
                if (j >= 1) ap_qk_half(sN + koff + 512, qr, bias2, S); else ap_pv_half(sC + voff, pw, o);
            } else if (j == jw + 1) ap_qk_half(sN + koff + 512, qr, bias2, S);
        }
#pragma unroll
        for (int dh = 0; dh < 2; ++dh)
#pragma unroll
            for (int r = 0; r < 16; ++r) { const int R = b * SEQ + q0 + w * 32 + crow(r, hi), dcol = h * 64 + dh * 32 + r32;
                const float g = P[(size_t)R * NINP + 1536 + dcol]; O[(size_t)R * DM + dcol] = f2bf(o[dh][r] * silu_f(g)); }
    }
    __builtin_amdgcn_s_setprio(0);
}

__device__ __forceinline__ void sb_scores32(lds_cptr ldsK, const bf16x8 (&qr)[4], float bias2, int qrel, int lane, float& carry, u32x4 (&pw)[2]) {
    const int r32 = lane & 31, hi = lane >> 5;
    const lds_cptr kp0 = ldsK + hi * 512 + r32 * 16;
    f32x16 C;
#pragma unroll
    for (int r = 0; r < 16; ++r) C[r] = bias2;
#pragma unroll
    for (int d0 = 0; d0 < 4; ++d0) { const bf16x8 kf = *(const __attribute__((address_space(3))) bf16x8*)(kp0 + d0 * 1024); C = MFMA32(kf, qr[d0], C); }
    if (qrel >= 0) {
#pragma unroll
        for (int r = 0; r < 16; ++r) if (crow(r, hi) >= qrel) C[r] = -INFINITY;
    }
    sb_sub(C, carry, hi);
#pragma unroll
    for (int i = 0; i < 4; ++i) { pw[0][i] = cvtpk(C[2 * i], C[2 * i + 1]); pw[1][i] = cvtpk(C[8 + 2 * i], C[8 + 2 * i + 1]); }
}
__device__ __forceinline__ void sb_pv32(lds_cptr ldsV, const u32x4 (&pw)[2], int lane, f32x16 (&o)[2]) {
    const int hi = lane >> 5;
    const lds_cptr vp0 = ldsV + ((lane >> 4) & 1) * 32 + (lane & 3) * 8 + (4 * hi + ((lane & 15) >> 2)) * 64;
#pragma unroll
    for (int i = 0; i < 4; ++i) {
        const s16x4 lo = vtr(vp0 + ((i >> 1) * 2048 + (i & 1) * 1024)), hi4 = vtr(vp0 + ((i >> 1) * 2048 + (i & 1) * 1024 + 512));
        const bf16x8 vf = {lo[0], lo[1], lo[2], lo[3], hi4[0], hi4[1], hi4[2], hi4[3]};
        o[i >> 1] = MFMA32(__builtin_bit_cast(bf16x8, pw[i & 1]), vf, o[i >> 1]);
    }
}
__device__ __forceinline__ void phase_attn_sample(const Params& p, int bid, int nb, unsigned char* smem, int uhi) {
    const int tid = otid(), lane = tid & 63, r32 = lane & 31, hi = lane >> 5; const int w = __builtin_amdgcn_readfirstlane(tid >> 6);
    unsigned char* ldsK = smem + w * 16384; unsigned char* ldsV = ldsK + 4096; unsigned char* stg = ldsK + 8192;
    const u16* Qb = (const u16*)(p.ws + WS_QB) + (size_t)NPROW * 512; const u16* Kb = (const u16*)(p.ws + WS_KB) + (size_t)NPROW * 512; const u16* Vb = (const u16*)(p.ws + WS_VB) + (size_t)NPROW * 512;
    const float* P = (const float*)(p.ws + WS_P); u16* O = (u16*)(p.ws + WS_O);
    const int srow = lane >> 4, sp = lane & 15;
#define AS_DMA_K(kp_) { _Pragma("unroll") for (int i = 0; i < 8; ++i) __builtin_amdgcn_global_load_lds((const unsigned*)((kp_) + (size_t)(i * 4) * 512), (__attribute__((address_space(3))) unsigned*)(stg + i * 1024), 16, 0, 2); }
    int npg_lo = 0, npg_hi = 0;
    if (bid < uhi) { const int bd0 = (bid >> 8) * 32 + (bid & 7) * 4 + ((bid >> 6) & 3); npg_lo = p.page_table[bd0 * 16 + 2 * w]; npg_hi = p.page_table[bd0 * 16 + 2 * w + 1]; }
    for (int u_ = bid; u_ < uhi; u_ += nb) {
        const int bd = (u_ >> 8) * 32 + (u_ & 7) * 4 + ((u_ >> 6) & 3), h = (u_ >> 3) & 7, u = bd * 8 + h;
        const float bias2 = p.sb_bias[h] * LOG2E;
        const int pg_lo = npg_lo, pg_hi = npg_hi;
        if (u_ + nb < uhi && u_ + nb > 0) { const int un_ = u_ + nb; const int bdn = (un_ >> 8) * 32 + (un_ & 7) * 4 + ((un_ >> 6) & 3); npg_lo = p.page_table[bdn * 16 + 2 * w]; npg_hi = p.page_table[bdn * 16 + 2 * w + 1]; }
        const float gate = P[(size_t)(NPROW + bd * 8 + (tid >> 6)) * NINP + 1536 + h * 64 + (tid & 63)];
        bf16x8 qr[4];
#pragma unroll
        for (int d0 = 0; d0 < 4; ++d0) qr[d0] = *(const bf16x8*)(Qb + ((size_t)u * 8 + (r32 & 7)) * 64 + d0 * 16 + hi * 8);
        float carry = 1.0f; f32x16 o[2];
#pragma unroll
        for (int r = 0; r < 16; ++r) { o[0][r] = 0.f; o[1][r] = 0.f; }
        u32x4 pw[2];
        __syncthreads();
        f32x4 vx[8];
        { const size_t rb = (size_t)pg_hi * 128 + 96;
          const float* kp = p.cache_k + ((rb + srow) * 8 + h) * 64 + sp * 4; const float* vp = p.cache_v + ((rb + srow) * 8 + h) * 64 + sp * 4;
          AS_DMA_K(kp)
#pragma unroll
          for (int i = 0; i < 8; ++i) vx[i] = __builtin_nontemporal_load((const f32x4*)(vp + (size_t)(i * 4) * 512)); }
        if (w == 7) {
#pragma unroll
            for (int c8 = 0; c8 < 4; ++c8) { const int cc = c8 * 2 + hi; u32x4 kv = {0u, 0u, 0u, 0u}; if (r32 < 8) kv = *(const u32x4*)(Kb + ((size_t)u * 8 + r32) * 64 + cc * 8); *(u32x4*)(ldsK + cc * 512 + r32 * 16) = kv; }
#pragma unroll
            for (int i = 0; i < 4; ++i) { const int row = (lane >> 2) + 16 * (i & 1), dh = i >> 1; u32x4 vv = {0u, 0u, 0u, 0u};
                if (row < 8) vv = *(const u32x4*)(Vb + ((size_t)u * 8 + row) * 64 + dh * 32 + (lane & 3) * 8);
                *(u32x4*)(ldsV + dh * 2048 + row * 64 + (lane & 3) * 16) = vv; }
            asm volatile("s_waitcnt lgkmcnt(0)" ::: "memory");
            sb_scores32((lds_cptr)ldsK, qr, bias2, r32, lane, carry, pw);
            sb_pv32((lds_cptr)ldsV, pw, lane, o);
            asm volatile("" ::: "memory");
        }
        for (int st = 7; st >= 0; --st) {
            asm volatile("s_waitcnt vmcnt(0)" ::: "memory");
#pragma unroll
            for (int i = 0; i < 8; ++i) { const int row = i * 4 + srow; const f32x4 kx = *(const f32x4*)(stg + i * 1024 + lane * 16);
                u32x2 k2; k2.x = cvtpk(kx[0], kx[1]); k2.y = cvtpk(kx[2], kx[3]);
                *(u32x2*)(ldsK + (sp >> 1) * 512 + row * 16 + (sp & 1) * 8) = k2; }
#pragma unroll
            for (int i = 0; i < 8; ++i) { const int row = i * 4 + srow; u32x2 v2; v2.x = cvtpk(vx[i][0], vx[i][1]); v2.y = cvtpk(vx[i][2], vx[i][3]);
                *(u32x2*)(ldsV + (sp >> 3) * 2048 + row * 64 + (sp & 7) * 8) = v2; }
            asm volatile("s_waitcnt lgkmcnt(0)" ::: "memory");
            if (st > 0) { const int stn = st - 1; const int pagen = (stn >> 2) ? pg_hi : pg_lo; const size_t rbn = (size_t)pagen * 128 + 32 * (stn & 3);
                const float* kpn = p.cache_k + ((rbn + srow) * 8 + h) * 64 + sp * 4; const float* vpn = p.cache_v + ((rbn + srow) * 8 + h) * 64 + sp * 4;
                AS_DMA_K(kpn)
#pragma unroll
                for (int i = 0; i < 8; ++i) vx[i] = __builtin_nontemporal_load((const f32x4*)(vpn + (size_t)(i * 4) * 512)); }
            sb_scores32((lds_cptr)ldsK, qr, bias2, -1, lane, carry, pw);
            sb_pv32((lds_cptr)ldsV, pw, lane, o);
            asm volatile("" ::: "memory");
        }
#undef AS_DMA_K
        __syncthreads();
        float* Ob = (float*)smem;
        float* Tt = (float*)(smem + 16384);
#pragma unroll
        for (int dh = 0; dh < 2; ++dh)
#pragma unroll
            for (int r = 0; r < 4; ++r) Ob[(w * 8 + 4 * hi + r) * 64 + dh * 32 + r32] = o[dh][r];
        if (r32 < 8 && hi == 0) Tt[w * 8 + r32] = carry;
        __syncthreads();
        { const int q = tid >> 6, d = tid & 63; float acc = 0.f, suf = 1.0f;
#pragma unroll
          for (int ww = 7; ww >= 0; --ww) { acc += Ob[(ww * 8 + q) * 64 + d] * suf; suf *= Tt[ww * 8 + q]; }
          const int R = NPROW + bd * 8 + q, dcol = h * 64 + d;
          O[(size_t)R * DM + dcol] = f2bf(acc * silu_f(gate)); }
    }
}

struct EpiIn {
    static constexpr bool PERM = false, AFTER_DRAIN = false;
    float* P; float* out; u16* Qb; u16* Kb; u16* Vb;
    __device__ __forceinline__ void operator()(const pg8::f32x4 (&acc)[2][2][4][2], const pg8::Unit& u, int wr, int wc, int fr, int fq) const {
        const int row0 = u.pm * 256 + wr * 64 + fr, colt = u.pn * 256, col0 = colt + wc * 32 + 4 * fq;
        if (colt >= 1536) {
#pragma unroll
            for (int ai = 0; ai < 2; ++ai)
#pragma unroll
                for (int m = 0; m < 4; ++m) { float* rowp = P + (size_t)(row0 + ai * 128 + m * 16) * NINP + col0;
#pragma unroll
                    for (int bj = 0; bj < 2; ++bj)
#pragma unroll
                        for (int n = 0; n < 2; ++n) *(pg8::f32x4*)(rowp + bj * 128 + n * 16) = acc[ai][bj][m][n]; }
        } else {
            const int type = colt >> 9;
            const bool prompt = u.pm < 64;
            const float sc = type == 0 ? 0.125f * LOG2E : 1.0f;
            const int c0 = (colt & 511) + wc * 32 + 4 * fq, h0 = c0 >> 6, d0 = c0 & 63, rr0 = row0 - NPROW;
            u16* b16 = Qb + (size_t)type * ((size_t)NROWS * 512) + (prompt ? ((size_t)(((row0 >> 12) * 8 + h0) * SEQ + (row0 & 4095))) * 64 + d0
                                                                          : (size_t)NPROW * 512 + ((size_t)(((rr0 >> 3) * 8 + h0) * 8 + (rr0 & 7))) * 64 + d0);
            float* o32 = out + (prompt ? OUT_KP + (size_t)(type - 1) * (OUT_VP - OUT_KP) + (size_t)row0 * 512 : OUT_KS + (size_t)(type - 1) * (OUT_VS - OUT_KS) + (size_t)rr0 * 512) + c0;
            const int rstep16 = prompt ? 64 : 512;
            const int hstep16 = prompt ? SEQ * 64 : 512;
#pragma unroll
            for (int ai = 0; ai < 2; ++ai)
#pragma unroll
                for (int m = 0; m < 4; ++m)
#pragma unroll
                    for (int bj = 0; bj < 2; ++bj)
#pragma unroll
                        for (int n = 0; n < 2; ++n) { const pg8::f32x4 v = acc[ai][bj][m][n]; const int dr = ai * 128 + m * 16;
                            u32x2 pk2; pk2.x = cvtpk(v[0] * sc, v[1] * sc); pk2.y = cvtpk(v[2] * sc, v[3] * sc);
                            *(u32x2*)(b16 + (size_t)dr * rstep16 + (size_t)(bj * 2) * hstep16 + n * 16) = pk2;
                            if (type != 0) *(pg8::f32x4*)(o32 + (size_t)dr * 512 + bj * 128 + n * 16) = v; }
        }
    }
};

struct EpiRes {
    static constexpr bool PERM = false, AFTER_DRAIN = false;
    float* C; const float* xp; const float* xs;
    __device__ __forceinline__ void operator()(const pg8::f32x4 (&acc)[2][2][4][2], const pg8::Unit& u, int wr, int wc, int fr, int fq) const {
        const int row0 = u.pm * 256 + wr * 64 + fr, col0 = u.pn * 256 + wc * 32 + 4 * fq;
#pragma unroll
        for (int ai = 0; ai < 2; ++ai)
#pragma unroll
            for (int m = 0; m < 4; ++m) { const int row = row0 + ai * 128 + m * 16; float* rowp = C + (size_t)row * DM + col0;
                const float* xr = (row < NPROW ? xp + (size_t)row * DM : xs + (size_t)(row - NPROW) * DM) + col0;
#pragma unroll
                for (int bj = 0; bj < 2; ++bj)
#pragma unroll
                    for (int n = 0; n < 2; ++n) *(pg8::f32x4*)(rowp + bj * 128 + n * 16) = acc[ai][bj][m][n] + *(const pg8::f32x4*)(xr + bj * 128 + n * 16); }
    }
};

constexpr int PANEL_CNT_WORD = 4608;
struct EpiResNorm {
    static constexpr bool PERM = false, AFTER_DRAIN = true;
    float* C; const float* xp; const float* xs; const float* gain; float* stats; unsigned* ctl;
    __device__ __forceinline__ void fused(const pg8::f32x4 (&acc)[2][2][4][2], const pg8::Unit& u, int wr, int wc, int fr, int fq, PG8_LAS unsigned char* lds, int wid, int lane) const {
        PG8_LAS float* Pt = (PG8_LAS float*)lds;
        PG8_LAS float* Sr = (PG8_LAS float*)(lds + 4096);
        const int row0 = u.pm * 256 + wr * 64 + fr, col0 = u.pn * 256 + wc * 32 + 4 * fq;
        pg8::f32x4 (&hacc)[2][2][4][2] = const_cast<pg8::f32x4 (&)[2][2][4][2]>(acc);
#pragma unroll
        for (int ai = 0; ai < 2; ++ai)
#pragma unroll
            for (int m = 0; m < 4; ++m) { const int row = row0 + ai * 128 + m * 16;
                const float* xr = (row < NPROW ? xp + (size_t)row * DM : xs + (size_t)(row - NPROW) * DM) + col0;
                float s = 0.f;
#pragma unroll
                for (int bj = 0; bj < 2; ++bj)
#pragma unroll
                    for (int n = 0; n < 2; ++n) { const pg8::f32x4 hv = acc[ai][bj][m][n] + *(const pg8::f32x4*)(xr + bj * 128 + n * 16); hacc[ai][bj][m][n] = hv; s += (hv[0] * hv[0] + hv[1] * hv[1]) + (hv[2] * hv[2] + hv[3] * hv[3]); }
                s += __shfl_xor(s, 16); s += __shfl_xor(s, 32);
                if (fq == 0) Pt[(ai * 128 + wr * 64 + m * 16 + fr) * 4 + wc] = s; }
        __syncthreads();
        float* st = stats + (size_t)u.pm * 1024;
        unsigned* cnt = ctl + PANEL_CNT_WORD + 16 * u.pm;
        const int prow = wid * 32 + (lane & 31);
        if (lane < 32) { const float t4 = (Pt[prow * 4] + Pt[prow * 4 + 1]) + (Pt[prow * 4 + 2] + Pt[prow * 4 + 3]);
            __hip_atomic_store(st + prow * 4 + u.pn, t4, __ATOMIC_RELAXED, __HIP_MEMORY_SCOPE_AGENT); }
        asm volatile("s_waitcnt vmcnt(0)" ::: "memory");
        __syncthreads();
        if (threadIdx.x == 0) {
            __hip_atomic_fetch_add(cnt, 1u, __ATOMIC_RELAXED, __HIP_MEMORY_SCOPE_AGENT);
            unsigned spins = 0;
            while (__hip_atomic_load(cnt, __ATOMIC_RELAXED, __HIP_MEMORY_SCOPE_AGENT) < 4u) { __builtin_amdgcn_s_sleep(2); if (++spins > (1u << 22)) break; }
        }
        __syncthreads();
        if (lane < 32) { float tot = 0.f;
#pragma unroll
            for (int k = 0; k < 4; ++k) tot += __hip_atomic_load(st + prow * 4 + k, __ATOMIC_RELAXED, __HIP_MEMORY_SCOPE_AGENT);
            Sr[prow] = rsqrtf(tot * (1.0f / 1024.0f) + 1e-6f); }
        __syncthreads();
#pragma unroll
        for (int ai = 0; ai < 2; ++ai)
#pragma unroll
            for (int m = 0; m < 4; ++m) { const int row = row0 + ai * 128 + m * 16; float* rowp = C + (size_t)row * DM + col0;
                const float rs = Sr[ai * 128 + wr * 64 + m * 16 + fr];
#pragma unroll
                for (int bj = 0; bj < 2; ++bj)
#pragma unroll
                    for (int n = 0; n < 2; ++n) { const pg8::f32x4 hv = hacc[ai][bj][m][n]; const pg8::f32x4 gv = *(const pg8::f32x4*)(gain + col0 + bj * 128 + n * 16);
                        *(pg8::f32x4*)(rowp + bj * 128 + n * 16) = hv * rs * gv; } }
        __syncthreads();
    }
};

__device__ __forceinline__ void phase_final(const Params& p, int bid, int nb) {
    const int tid = otid(), lane = tid & 63, w = tid >> 6;
    f32x4 g[4];
#pragma unroll
    for (int i = 0; i < 4; ++i) g[i] = *(const f32x4*)(p.norm_f + lane * 4 + i * 256);
    for (int row = bid * 8 + w; row < NROWS; row += nb * 8) {
        float* src = p.out + (size_t)row * DM;
        f32x4 v[4]; float ss = 0.f;
#pragma unroll
        for (int i = 0; i < 4; ++i) { v[i] = *(const f32x4*)(src + lane * 4 + i * 256); ss += v[i][0] * v[i][0] + v[i][1] * v[i][1] + v[i][2] * v[i][2] + v[i][3] * v[i][3]; }
        ss = wave_sum(ss);
        const float rs = rsqrtf(ss * (1.0f / 1024.0f) + 1e-6f);
#pragma unroll
        for (int i = 0; i < 4; ++i) *(f32x4*)(src + lane * 4 + i * 256) = v[i] * rs * g[i];
    }
}

struct OneUnitOrder { int pm, pn;
    __device__ __forceinline__ bool next(int i, pg8::Unit& u) const { if (i != 0) return false; u.pm = pm; u.pn = pn; return true; }
    __device__ __forceinline__ void a_ready(const pg8::Unit&) const {}
    __device__ __forceinline__ void done(const pg8::Unit&) const {} };
constexpr int LDS_MAIN = 162048;
constexpr int LDS_BYTES = LDS_MAIN + 16;
static_assert(C_FEND <= LDS_MAIN, "stage-1 LDS map");
static_assert(PREP_END <= LDS_MAIN, "prep LDS map");
constexpr int WQ_WORD = XCD_BAR_WORDS + 64;
constexpr int CTL_BYTES = 32768;
__global__ __launch_bounds__(512, 2) __attribute__((target("no-packed-fp32-ops"))) void k_mega(Params p) {
    extern __shared__ __attribute__((aligned(16))) unsigned char shm[];
    const int bid = blockIdx.x, nb = gridDim.x;
    volatile LAS unsigned* xbw = (volatile LAS unsigned*)(shm + LDS_MAIN);
    volatile LAS unsigned* slot = (volatile LAS unsigned*)(shm + LDS_MAIN + 8);
    if (threadIdx.x == 0) { xbw[0] = 0u; xbw[1] = 0u; slot[0] = 0u; slot[1] = 0u; }
    __syncthreads();
    unsigned* bar = (unsigned*)(p.ws + WS_BAR);
    XcdBarrier xb = xcd_barrier_post(bar, xbw);
#define WQ_LOOP(Q, N, ...) { unsigned nxt_ = 0u; if (threadIdx.x == 0) nxt_ = __hip_atomic_fetch_add(bar + WQ_WORD + 64 * (Q), 1u, __ATOMIC_RELAXED, __HIP_MEMORY_SCOPE_AGENT); \
      for (;;) { __syncthreads(); if (threadIdx.x == 0) slot[0] = nxt_; __syncthreads(); const int item = __builtin_amdgcn_readfirstlane((int)slot[0]); if (item >= (N)) break; \
        if (threadIdx.x == 0) nxt_ = __hip_atomic_fetch_add(bar + WQ_WORD + 64 * (Q), 1u, __ATOMIC_RELAXED, __HIP_MEMORY_SCOPE_AGENT); __VA_ARGS__; } }
    phase_prologue(p, bid, nb, shm);
    xcd_barrier(xb);
    { pg8::Gemm g{(const pg8::bf16_t*)(p.ws + WS_XB), (const pg8::bf16_t*)(p.ws + WS_WINT), NROWS, NINP, DM}; pg8::StaticOrder S; S.init(NROWS, NINP, nb, bid);
      EpiIn E{(float*)(p.ws + WS_P), p.out, (u16*)(p.ws + WS_QB), (u16*)(p.ws + WS_KB), (u16*)(p.ws + WS_VB)}; pg8::gemm_phase<EpiIn, pg8::StaticOrder, false>((PG8_LAS unsigned char*)shm, g, S, E, nullptr); }
    { const int ntiles_ = (NROWS / 256) * (NINP / 256), rounds_ = (ntiles_ + nb - 1) / nb, sbase_ = ntiles_ - (rounds_ - 1) * nb, nidle_ = nb - sbase_;
      if (nidle_ > 0) { if (bid >= sbase_) phase_wout_tiles(p, bid - sbase_, nidle_, shm); } else phase_wout_tiles(p, bid, nb, shm); }
    xcd_barrier(xb);
    if ((bid >> 6) & 1) {
        phase_attn_sample(p, bid, nb, shm, 768);
        for (int it = bid; it < 512; it += nb) scanc_fused(p, it, shm);
    } else {
        for (int it = bid; it < 512; it += nb) scanc_fused(p, it, shm);
        phase_attn_sample(p, bid, nb, shm, 768);
    }
    WQ_LOOP(7, 128, phase_prep_unit(p, item + 512, shm));
    xcd_barrier(xb);
    for (int s_ = nb - 1 - bid; s_ < 32; s_ += nb) scanc_stage2(p, s_, shm);
    { int it_static = bid; bool sample_done = false, primed = false; unsigned nxt_ = 0u;
      for (;;) {
        int unit;
        if (it_static < 256) { unit = it_static; it_static += nb; }
        else {
            if (!sample_done) { for (int it = bid; it < 256; it += nb) phase_attn_sample(p, it + 768, 1 << 30, shm, 1024); sample_done = true; }
            if (!primed) { if (threadIdx.x == 0) nxt_ = __hip_atomic_fetch_add(bar + WQ_WORD + 64 * 1, 1u, __ATOMIC_RELAXED, __HIP_MEMORY_SCOPE_AGENT); primed = true; }
            __syncthreads(); if (threadIdx.x == 0) slot[0] = nxt_; __syncthreads();
            const int item = __builtin_amdgcn_readfirstlane((int)slot[0]); if (item >= 256) break;
            if (threadIdx.x == 0) nxt_ = __hip_atomic_fetch_add(bar + WQ_WORD + 64 * 1, 1u, __ATOMIC_RELAXED, __HIP_MEMORY_SCOPE_AGENT);
            unit = item + 256;
        }
        phase_attn_prompt(p, unit, 1 << 30, shm, 512);
      } }
    WQ_LOOP(3, 1024, phase_scan(p, item + 32, 1 << 30, shm, 0, 1056));
    xcd_barrier(xb);
    phase_gemm2_sample(p, bid, nb, shm);
    phase_stage3(p, bid, nb, shm, 1024);
#undef WQ_LOOP
    xcd_barrier(xb);
    phase_norm_sample(p, bid, nb);
    for (int uu = bid; uu < 256; uu += nb) {
        pg8::Gemm g{(const pg8::bf16_t*)(p.ws + WS_O), (const pg8::bf16_t*)(p.ws + WS_WOUTT), NROWS, DM, DM}; OneUnitOrder S1u; const int ix_ = uu >> 3; S1u.pm = (uu & 7) * 8 + (ix_ >> 2); S1u.pn = ix_ & 3;
        EpiResNorm E{p.out, p.x_prompt, p.x_sample, p.norm_f, (float*)(p.ws + WS_STATS), bar}; pg8::gemm_phase<EpiResNorm, OneUnitOrder, false>((PG8_LAS unsigned char*)shm, g, S1u, E, nullptr);
    }
}

extern "C" void kernel_launch(void* const* d_in, const int* in_sizes, int n_in, void* d_out, int out_size, void* d_ws, size_t ws_size, hipStream_t stream) {
    if (ws_size < WS_END) { fprintf(stderr, "kernel_launch: workspace too small (%zu < %zu)\n", ws_size, (size_t)WS_END); return; }
    static int grid = 0;
    if (!grid) {
        int dev = 0, cus = 0, per_cu = 0;
        (void)hipGetDevice(&dev); (void)hipDeviceGetAttribute(&cus, hipDeviceAttributeMultiprocessorCount, dev);
        (void)hipFuncSetAttribute((const void*)k_mega, hipFuncAttributeMaxDynamicSharedMemorySize, LDS_BYTES);
        (void)hipOccupancyMaxActiveBlocksPerMultiprocessor(&per_cu, (const void*)k_mega, 512, LDS_BYTES);
        if (per_cu < 1) { fprintf(stderr, "kernel_launch: occupancy query says %d blocks per CU\n", per_cu); per_cu = 1; }
        grid = cus > 0 ? cus : 256;
    }
    Params p{};
    p.x_prompt = (const float*)d_in[0]; p.x_sample = (const float*)d_in[1]; p.cache_k = (const float*)d_in[2]; p.cache_v = (const float*)d_in[3]; p.page_table = (const int*)d_in[4];
    p.state_wkv = (const float*)d_in[5]; p.state_shift = (const float*)d_in[6]; p.norm_in = (const float*)d_in[7]; p.w_in = (const float*)d_in[8]; p.sb_bias = (const float*)d_in[9];
    p.mu = (const float*)d_in[10]; p.w0 = (const float*)d_in[11]; p.w_up = (const float*)d_in[12]; p.a0 = (const float*)d_in[13]; p.a_up = (const float*)d_in[14];
    p.k_k = (const float*)d_in[15]; p.k_a = (const float*)d_in[16]; p.r_k = (const float*)d_in[17]; p.ln_w = (const float*)d_in[18]; p.ln_b = (const float*)d_in[19];
    p.w_out = (const float*)d_in[20]; p.norm_f = (const float*)d_in[21];
    p.out = (float*)d_out; p.ws = (unsigned char*)d_ws;
    (void)hipMemsetAsync((unsigned char*)d_ws + WS_BAR, 0, CTL_BYTES, stream);
    hipLaunchKernelGGL(k_mega, dim3(grid), dim3(512), LDS_BYTES, stream, p);
}
```
